# Optimizing an MI355X kernel written in HIP

```python
import math
import jax
import jax.numpy as jnp
from jax import lax
import numpy as np

D_MODEL = 4096
BATCH = 8
SEQ = 2048
DEPTH = 1
DEC_BATCH = 32
DEC_SEQ = 64
PAST_LEN = 1024

CHUNK = 64
QBLK = 128
HEAD_DIM = 128
N_HEADS_A = D_MODEL // (2 * HEAD_DIM)
N_KV_A = 4
IDX_HEADS = 16
IDX_DIM = 64
TOPK_MAX = 256
N_HEADS_B = D_MODEL // (2 * HEAD_DIM)
DK_B = HEAD_DIM
DV_B = HEAD_DIM
CONV_B = 4
FFN_CONV = 3
D_FF = 11008
N_BUCKETS = 32
MAX_DIST = 128
EPS = 1e-5
ALPHA = (2 * DEPTH) ** 0.25
OUT_INIT = (8 * DEPTH) ** -0.25

W_A = N_HEADS_A * HEAD_DIM
W_B = N_HEADS_B * DV_B
KV_W = N_KV_A * HEAD_DIM
IQ_W = IDX_HEADS * IDX_DIM
C_QKV = 2 * N_HEADS_B * DK_B + N_HEADS_B * DV_B
COL_SIZES = (W_A, KV_W, KV_W, IQ_W, IDX_DIM, IDX_HEADS, C_QKV, W_B, N_HEADS_B, N_HEADS_B)
N_IN = sum(COL_SIZES)
IDX_SCALE = (IDX_HEADS ** -0.5) * (IDX_DIM ** -0.5)

kernel_name = "hybrid_dsa_gdn_stream_step"


def split_cols(h, sizes):
    idx = np.cumsum(np.array(sizes))[:-1].tolist()
    return jnp.split(h, idx, axis=-1)


def layer_norm(x, g, b):
    xf = x.astype(jnp.float32)
    mu = jnp.mean(xf, axis=-1, keepdims=True)
    xc = xf - mu
    var = jnp.mean(xc * xc, axis=-1, keepdims=True)
    return (xc * lax.rsqrt(var + EPS) * g + b).astype(x.dtype)


def l2norm(x):
    xf = x.astype(jnp.float32)
    return xf * lax.rsqrt(jnp.sum(xf * xf, axis=-1, keepdims=True) + 1e-6)


def causal_dwconv(x, prev, w, bias):
    width = w.shape[0]
    t = x.shape[1]
    xp = jnp.concatenate([prev.astype(x.dtype), x], axis=1)
    y = bias
    for j in range(width):
        y = y + xp[:, j:j + t] * w[j]
    return y, xp[:, xp.shape[1] - (width - 1):]


def t5_bucket(rel):
    half = N_BUCKETS // 2
    max_exact = half // 2
    side = jnp.where(rel > 0, half, 0)
    n = jnp.abs(rel)
    nf = jnp.maximum(n, 1).astype(jnp.float32)
    large = max_exact + (jnp.log(nf / max_exact) / math.log(MAX_DIST / max_exact)
                         * (half - max_exact)).astype(jnp.int32)
    large = jnp.minimum(large, half - 1)
    return side + jnp.where(n < max_exact, n, large)


def dsa_block(q, iq, iw, q_pos, k_all, v_all, ik_all, top_k, rel_bias):
    b, t, h, hd = q.shape
    n_len = k_all.shape[1]
    k_pos = jnp.arange(n_len, dtype=jnp.int32)
    s_idx = jnp.einsum("bthd,bsd->bths", iq, ik_all).astype(jnp.float32)
    index = jnp.einsum("bths,bth->bts", jax.nn.relu(s_idx), iw.astype(jnp.float32) * IDX_SCALE)
    limit = (q_pos // CHUNK + 1) * CHUNK
    admissible = k_pos[None, :] < limit[:, None]
    index = jnp.where(admissible[None], index, -jnp.inf)
    _, sel = lax.top_k(index, top_k)
    valid = sel < limit[None, :, None]
    gather = jax.vmap(lambda kv, ii: kv[ii])
    k_sel = gather(k_all, sel)
    v_sel = gather(v_all, sel)
    qg = q.reshape(b, t, N_KV_A, h // N_KV_A, hd)
    logits = jnp.einsum("btngd,btsnd->btngs", qg, k_sel).astype(jnp.float32) * (hd ** -0.5)
    bias = rel_bias[t5_bucket(sel - q_pos[None, :, None])].astype(jnp.float32)
    bias = jnp.transpose(bias.reshape(b, t, top_k, N_KV_A, h // N_KV_A), (0, 1, 3, 4, 2))
    logits = jnp.where(valid[:, :, None, None, :], logits + bias, -jnp.inf)
    p = jax.nn.softmax(logits, axis=-1).astype(v_sel.dtype)
    out = jnp.einsum("btngs,btsnd->btngd", p, v_sel)
    return out.reshape(b, t, h * hd)


def gated_delta_chunked(q, k, v, g, beta, s0, chunk):
    b, t, h, dk = q.shape
    dv = v.shape[-1]
    n = t // chunk

    def blk(a):
        return jnp.swapaxes(a.reshape(b, n, chunk, h, *a.shape[3:]), 2, 3)

    q, k, v = blk(q), blk(k), blk(v.astype(jnp.float32))
    g, beta = blk(g), blk(beta)
    G = jnp.cumsum(g, axis=-1)
    tri = jnp.tril(jnp.ones((chunk, chunk), bool))
    strict = jnp.tril(jnp.ones((chunk, chunk), bool), -1)
    dmask = jnp.exp(jnp.where(tri, G[..., :, None] - G[..., None, :], -jnp.inf))
    kb = k * beta[..., None]
    lmat = jnp.where(strict, jnp.einsum("bnhid,bnhjd->bnhij", kb, k) * dmask, 0.0)
    a_mat = lmat + jnp.eye(chunk, dtype=jnp.float32)
    rhs = jnp.concatenate([v * beta[..., None], kb * jnp.exp(G)[..., None]], axis=-1)
    sol = lax.linalg.triangular_solve(a_mat, rhs, left_side=True, lower=True, unit_diagonal=True)
    u, w = sol[..., :dv], sol[..., dv:]
    qk = jnp.where(tri, jnp.einsum("bnhid,bnhjd->bnhij", q, k) * dmask, 0.0)
    q_dec = q * jnp.exp(G)[..., None]
    k_dec = k * jnp.exp(G[..., -1:] - G)[..., None]
    g_last = jnp.exp(G[..., -1])

    def step(S, xs):
        u_c, w_c, qk_c, qd_c, kd_c, gl_c = xs
        v_new = u_c - jnp.einsum("bhcd,bhde->bhce", w_c, S)
        o = jnp.einsum("bhcd,bhde->bhce", qd_c, S) + jnp.einsum("bhij,bhje->bhie", qk_c, v_new)
        S = S * gl_c[..., None, None] + jnp.einsum("bhcd,bhce->bhde", kd_c, v_new)
        return S, o

    xs = tuple(jnp.moveaxis(a, 1, 0) for a in (u, w, qk, q_dec, k_dec, g_last))
    s_fin, o = lax.scan(step, s0.astype(jnp.float32), xs)
    o = jnp.transpose(o, (1, 0, 3, 2, 4)).reshape(b, t, h, dv)
    return o, s_fin


def encoder_layer(x, cache_k, cache_v, cache_ik, s_delta, conv_prev, ffn_prev,
                  w_in, conv_qkv_w, conv_qkv_b, a_log, dt_bias, delta_norm_g, rel_bias, w_o,
                  ln1_g, ln1_b, w_ffn_up, ffn_conv_w, ffn_conv_b, w_ffn_down, ln2_g, ln2_b):
    b, t, _ = x.shape
    past = cache_k.shape[1]
    h = x @ w_in
    q_a, k_a, v_a, iq, ik, iw, qkv_b, z_b, beta_in, a_in = split_cols(h, COL_SIZES)

    q_a = q_a.reshape(b, t, N_HEADS_A, HEAD_DIM)
    k_new = k_a.reshape(b, t, N_KV_A, HEAD_DIM)
    v_new = v_a.reshape(b, t, N_KV_A, HEAD_DIM)
    iq = iq.reshape(b, t, IDX_HEADS, IDX_DIM)
    k_all = jnp.concatenate([cache_k.astype(x.dtype), k_new], axis=1)
    v_all = jnp.concatenate([cache_v.astype(x.dtype), v_new], axis=1)
    ik_all = jnp.concatenate([cache_ik.astype(x.dtype), ik], axis=1)
    top_k = min(TOPK_MAX, (past + t) // 4)
    q_pos = past + jnp.arange(t, dtype=jnp.int32)
    if t > QBLK and t % QBLK == 0:
        nb = t // QBLK

        def to_blocks(a):
            return jnp.moveaxis(a.reshape(b, nb, QBLK, *a.shape[2:]), 1, 0)

        blocks = (to_blocks(q_a), to_blocks(iq), to_blocks(iw), q_pos.reshape(nb, QBLK))
        out_a = lax.map(lambda args: dsa_block(args[0], args[1], args[2], args[3],
                                               k_all, v_all, ik_all, top_k, rel_bias), blocks)
        out_a = jnp.moveaxis(out_a, 0, 1).reshape(b, t, W_A)
    else:
        out_a = dsa_block(q_a, iq, iw, q_pos, k_all, v_all, ik_all, top_k, rel_bias)

    conv_out, conv_state = causal_dwconv(qkv_b, conv_prev, conv_qkv_w, conv_qkv_b)
    conv_out = jax.nn.silu(conv_out)
    q_b, k_b, v_b = split_cols(conv_out, (N_HEADS_B * DK_B, N_HEADS_B * DK_B, N_HEADS_B * DV_B))
    q_b = l2norm(q_b.reshape(b, t, N_HEADS_B, DK_B)) * (DK_B ** -0.5)
    k_b = l2norm(k_b.reshape(b, t, N_HEADS_B, DK_B))
    v_b = v_b.reshape(b, t, N_HEADS_B, DV_B)
    beta = jax.nn.sigmoid(beta_in.astype(jnp.float32))
    g = -jnp.exp(a_log.astype(jnp.float32)) * jax.nn.softplus(a_in.astype(jnp.float32) + dt_bias)
    chunk = CHUNK if t % CHUNK == 0 else t
    o_b, s_new = gated_delta_chunked(q_b, k_b, v_b, g, beta, s_delta, chunk)
    o_b = o_b * lax.rsqrt(jnp.mean(o_b * o_b, axis=-1, keepdims=True) + EPS) * delta_norm_g
    o_b = o_b * jax.nn.silu(z_b.astype(jnp.float32).reshape(b, t, N_HEADS_B, DV_B))
    o_b = o_b.reshape(b, t, W_B).astype(x.dtype)

    mix = jnp.concatenate([out_a, o_b], axis=-1) @ w_o
    x1 = layer_norm(ALPHA * x + mix, ln1_g, ln1_b)

    up = x1 @ w_ffn_up
    up_c, ffn_state = causal_dwconv(up, ffn_prev, ffn_conv_w, ffn_conv_b)
    gate, val = jnp.split(up_c, 2, axis=-1)
    ffn = (jax.nn.silu(gate) * val) @ w_ffn_down
    y = layer_norm(ALPHA * x1 + ffn, ln2_g, ln2_b)
    return y, (k_new, v_new, ik, s_new.astype(s_delta.dtype), conv_state, ffn_state)


def setup_inputs(seed: int = 0) -> dict:
    key = jax.random.key(seed)
    ks = jax.random.split(key, 26)
    f32 = jnp.float32

    def nrm(k, shape, scale):
        return jax.random.normal(k, shape, f32) * scale

    dt = jnp.exp(jax.random.uniform(ks[13], (DEPTH, N_HEADS_B), f32,
                                    math.log(1e-3), math.log(1e-1)))
    return {
        "x_prompt": nrm(ks[0], (BATCH, SEQ, D_MODEL), 1.0),
        "x_sample": nrm(ks[1], (DEC_BATCH, DEC_SEQ, D_MODEL), 1.0),
        "cache_attn_k": nrm(ks[2], (DEPTH, DEC_BATCH, PAST_LEN, N_KV_A, HEAD_DIM), 1.0),
        "cache_attn_v": nrm(ks[3], (DEPTH, DEC_BATCH, PAST_LEN, N_KV_A, HEAD_DIM), 1.0),
        "cache_idx_k": nrm(ks[4], (DEPTH, DEC_BATCH, PAST_LEN, IDX_DIM), 1.0),
        "state_delta": nrm(ks[5], (DEPTH, DEC_BATCH, N_HEADS_B, DK_B, DV_B), 0.1),
        "state_conv_qkv": nrm(ks[6], (DEPTH, DEC_BATCH, CONV_B - 1, C_QKV), 1.0),
        "state_ffn_conv": nrm(ks[7], (DEPTH, DEC_BATCH, FFN_CONV - 1, 2 * D_FF), 1.0),
        "ln_in_g": 1.0 + nrm(ks[8], (D_MODEL,), 0.01),
        "ln_in_b": nrm(ks[9], (D_MODEL,), 0.01),
        "w_in": nrm(ks[10], (DEPTH, D_MODEL, N_IN), D_MODEL ** -0.5),
        "conv_qkv_w": nrm(ks[11], (DEPTH, CONV_B, C_QKV), CONV_B ** -0.5),
        "conv_qkv_b": nrm(ks[12], (DEPTH, C_QKV), 0.01),
        "a_log": jnp.log(jax.random.uniform(ks[14], (DEPTH, N_HEADS_B), f32, 1.0, 16.0)),
        "dt_bias": dt + jnp.log(-jnp.expm1(-dt)),
        "delta_norm_g": 1.0 + nrm(ks[15], (DEPTH, DV_B), 0.01),
        "rel_bias": nrm(ks[16], (N_BUCKETS, N_HEADS_A), 0.1),
        "w_o": nrm(ks[17], (DEPTH, W_A + W_B, D_MODEL), (W_A + W_B) ** -0.5 * OUT_INIT),
        "ln1_g": 1.0 + nrm(ks[18], (DEPTH, D_MODEL), 0.01),
        "ln1_b": nrm(ks[19], (DEPTH, D_MODEL), 0.01),
        "w_ffn_up": nrm(ks[20], (DEPTH, D_MODEL, 2 * D_FF), D_MODEL ** -0.5),
        "ffn_conv_w": nrm(ks[21], (DEPTH, FFN_CONV, 2 * D_FF), FFN_CONV ** -0.5),
        "ffn_conv_b": nrm(ks[22], (DEPTH, 2 * D_FF), 0.01),
        "w_ffn_down": nrm(ks[23], (DEPTH, D_FF, D_MODEL), D_FF ** -0.5 * OUT_INIT),
        "ln2_g": 1.0 + nrm(ks[24], (DEPTH, D_MODEL), 0.01),
        "ln2_b": nrm(ks[25], (DEPTH, D_MODEL), 0.01),
    }


def reference(x_prompt, x_sample, cache_attn_k, cache_attn_v, cache_idx_k, state_delta,
              state_conv_qkv, state_ffn_conv, ln_in_g, ln_in_b, w_in, conv_qkv_w, conv_qkv_b,
              a_log, dt_bias, delta_norm_g, rel_bias, w_o, ln1_g, ln1_b, w_ffn_up, ffn_conv_w,
              ffn_conv_b, w_ffn_down, ln2_g, ln2_b):
    xp = layer_norm(x_prompt, ln_in_g, ln_in_b)
    xs = layer_norm(x_sample, ln_in_g, ln_in_b)
    b = x_prompt.shape[0]
    dt_ = x_prompt.dtype
    p_states = []
    s_states = []
    for l in range(DEPTH):
        weights = (w_in[l], conv_qkv_w[l], conv_qkv_b[l], a_log[l], dt_bias[l], delta_norm_g[l],
                   rel_bias, w_o[l], ln1_g[l], ln1_b[l], w_ffn_up[l], ffn_conv_w[l],
                   ffn_conv_b[l], w_ffn_down[l], ln2_g[l], ln2_b[l])
        xp, st_p = encoder_layer(
            xp,
            jnp.zeros((b, 0, N_KV_A, HEAD_DIM), dt_),
            jnp.zeros((b, 0, N_KV_A, HEAD_DIM), dt_),
            jnp.zeros((b, 0, IDX_DIM), dt_),
            jnp.zeros((b, N_HEADS_B, DK_B, DV_B), jnp.float32),
            jnp.zeros((b, CONV_B - 1, C_QKV), dt_),
            jnp.zeros((b, FFN_CONV - 1, 2 * D_FF), dt_),
            *weights)
        xs, st_s = encoder_layer(xs, cache_attn_k[l], cache_attn_v[l], cache_idx_k[l],
                                 state_delta[l], state_conv_qkv[l], state_ffn_conv[l], *weights)
        p_states.append(st_p)
        s_states.append(st_s)
    p_k, p_v, p_ik, p_delta, p_conv, p_ffn = [jnp.stack(z) for z in zip(*p_states)]
    s_k, s_v, s_ik, s_delta, s_conv, s_ffn = [jnp.stack(z) for z in zip(*s_states)]
    return (xp, xs, p_k, p_v, p_ik, p_delta, p_conv, p_ffn,
            s_k, s_v, s_ik, s_delta, s_conv, s_ffn)
```

```cpp
#include <hip/hip_runtime.h>
#include <cstdio>
#include <cstdint>
namespace pg8 {
#define PG8_LAS __attribute__((address_space(3)))
typedef unsigned short bf16_t;
typedef short bf16x8 __attribute__((ext_vector_type(8)));
typedef float f32x4 __attribute__((ext_vector_type(4)));
typedef unsigned u32x4 __attribute__((ext_vector_type(4)));
constexpr int BM = 256, BK = 64, HALF = 128, HTB = HALF * BK * 2  , STAGE_BYTES = 8 * HTB, NXCD = 8, WGM = 8;

__host__ __device__ __forceinline__ int lds_byte(int r, int c) { const int st = (r >> 4) * 2 + (c >> 5), rr = r & 15, cc = c & 31, ob = rr * 64 + cc * 2; return st * 1024 + (ob ^ (((ob >> 9) & 1) << 5)); }
__host__ __device__ __forceinline__ void stage_rc(int b, int& R, int& C) { const int st = b / 1024, sb = b % 1024, swz = sb ^ (((sb >> 9) & 1) << 5); R = (st >> 1) * 16 + swz / 64; C = (st & 1) * 32 + (swz % 64) / 2; }
__host__ __device__ __forceinline__ int perm32(int rho) { const int n = rho >> 4, i = rho & 15; return 8 * (i >> 2) + 4 * n + (i & 3); }

struct Unit { int pm, pn, koff, part, kn, tidx; };
struct Gemm { const bf16_t* A; const bf16_t* Bt; int M, N, K, lda; };

struct StaticOrder {
    int nM, nN, nwg, G, c, lim, wgm, xs;
    __host__ __device__ void init(int M, int N, int G_, int c_) { nM = M / BM; nN = N / BM; nwg = nM * nN; G = G_; c = c_; lim = nwg; wgm = WGM; xs = 0; }
    __host__ __device__ void map(long L, Unit& u) const {
        if (xs) {
            const int x = (int)(L % NXCD), e = (int)(L / NXCD), per = nM / NXCD, nig = wgm * nN, k = e / nig, w = e % nig;
            u.pm = x * per + k * wgm + w % wgm; u.pn = w / wgm; u.koff = 0; u.part = 0; u.kn = 0; u.tidx = 0; return;
        }
        int wgid = (int)L; { const int q = nwg / NXCD, r = nwg % NXCD, xcd = wgid % NXCD, off = wgid / NXCD; wgid = (xcd < r ? xcd * (q + 1) : r * (q + 1) + (xcd - r) * q) + off; }
        const int nig = wgm * nN, gid = wgid / nig, fm = gid * wgm, gsz = (nM - fm) < wgm ? (nM - fm) : wgm;
        u.pm = fm + ((wgid % nig) % gsz); u.pn = (wgid % nig) / gsz; u.koff = 0; u.part = 0; u.kn = 0; u.tidx = 0;
    }
    __host__ __device__ bool next(int i, Unit& u) const {
        const long L = (long)i * G + c; if (L >= lim) return false;
        map(L, u); return true;
    }
    __device__ __forceinline__ void a_ready(const Unit&) const {}
    __device__ __forceinline__ void done(const Unit&) const {}
};

struct TailOrder {
    StaticOrder S; int L0, nsplit, kt0, kt1;
    __host__ __device__ bool next(int i, Unit& u) const {
        if (i > 0) return false; const long L = L0 + S.c / nsplit; if (L >= S.nwg) return false;
        S.map(L, u); u.part = S.c % nsplit; u.koff = u.part == 0 ? 0 : (kt0 + (u.part - 1) * kt1) * BK; u.kn = u.part == 0 ? kt0 : kt1; u.tidx = (int)(L - L0); return true;
    }
    __device__ __forceinline__ void a_ready(const Unit&) const {}
    __device__ __forceinline__ void done(const Unit&) const {}
};
__device__ __forceinline__ unsigned cvt_pk_bf16(float lo, float hi) { unsigned r; asm volatile("v_cvt_pk_bf16_f32 %0, %1, %2" : "=v"(r) : "v"(lo), "v"(hi)); return r; }
typedef float f32x2 __attribute__((ext_vector_type(2)));

typedef int v8i_t __attribute__((ext_vector_type(8)));
__device__ __forceinline__ v8i_t cat16(bf16x8 lo, bf16x8 hi) { const u32x4 a = __builtin_bit_cast(u32x4, lo), b = __builtin_bit_cast(u32x4, hi); return (v8i_t){(int)a.x, (int)a.y, (int)a.z, (int)a.w, (int)b.x, (int)b.y, (int)b.z, (int)b.w}; }
template <class Epi, class Sched, bool ALIGN_EPI = false, bool SP2 = false, bool F8 = false>
__device__ __forceinline__ void gemm_phase(PG8_LAS unsigned char* lds, const Gemm g, const Sched& S, const Epi& E) {
    const int tid = threadIdx.x, wid = __builtin_amdgcn_readfirstlane(tid >> 6), lane = tid & 63, wr = wid >> 2, wc = wid & 3, fr = lane & 15, fq = lane >> 4;
    const int K = g.lda, nt = g.K / BK;
    unsigned voffA[2], voffB[2];
#pragma unroll
    for (int i = 0; i < 2; ++i) { int R, C; stage_rc(tid * 16 + i * 8192, R, C); const int Rb = Epi::PERM ? ((R & ~31) + perm32(R & 31)) : R;
        voffA[i] = (unsigned)(R * K + C) * 2u; voffB[i] = (unsigned)(Rb * K + C) * 2u; }
    const size_t kstep = (size_t)(BK * 2);
    const size_t hstep = (size_t)HALF * K * 2;
    const size_t tstep = 2 * hstep;
    const unsigned ldsw = (unsigned)wid * 1024u;
    const int aoff = lds_byte(wr * 64 + fr, fq * 8), boff = lds_byte(wc * 32 + fr, fq * 8);
#define PG8_SA(b, h) (((b) * 2 + (h)) * HTB)
#define PG8_SB(b, h) ((4 + (b) * 2 + (h)) * HTB)
#define PG8_STAGE(bufoff, gbase, voff) do { _Pragma("unroll") for (int _i = 0; _i < 2; ++_i) \
        __builtin_amdgcn_global_load_lds((const unsigned*)((const char*)(gbase) + (voff)[_i]), (PG8_LAS unsigned*)(lds + (bufoff) + ldsw + _i * 8192), 16, 0, 0); } while (0)
#define PG8_LDA(dst, b, h) do { if constexpr (F8) { _Pragma("unroll") for (int m = 0; m < 4; ++m) dst##8[m] = cat16(*(const PG8_LAS bf16x8*)(lds + PG8_SA(b, h) + aoff + m * 2048), *(const PG8_LAS bf16x8*)(lds + PG8_SA(b, h) + aoff + m * 2048 + 1024)); } \
        else { _Pragma("unroll") for (int m = 0; m < 4; ++m) _Pragma("unroll") for (int k = 0; k < 2; ++k) dst[m][k] = *(const PG8_LAS bf16x8*)(lds + PG8_SA(b, h) + aoff + m * 2048 + k * 1024); } } while (0)
#define PG8_LDB(dst, b, h) do { if constexpr (F8) { _Pragma("unroll") for (int n = 0; n < 2; ++n) dst##8[n] = cat16(*(const PG8_LAS bf16x8*)(lds + PG8_SB(b, h) + boff + n * 2048), *(const PG8_LAS bf16x8*)(lds + PG8_SB(b, h) + boff + n * 2048 + 1024)); } \
        else { _Pragma("unroll") for (int n = 0; n < 2; ++n) _Pragma("unroll") for (int k = 0; k < 2; ++k) dst[n][k] = *(const PG8_LAS bf16x8*)(lds + PG8_SB(b, h) + boff + n * 2048 + k * 1024); } } while (0)
#define PG8_MMA(ai, bj, At, Bt) do { __builtin_amdgcn_s_setprio(1); \
        if constexpr (F8) { _Pragma("unroll") for (int m = 0; m < 4; ++m) _Pragma("unroll") for (int n = 0; n < 2; ++n) \
            asm volatile("v_mfma_f32_16x16x128_f8f6f4 %0, %1, %2, %0" : "+v"(acc[ai][bj][m][n]) : "v"(Bt##8[n]), "v"(At##8[m])); } \
        else { _Pragma("unroll") for (int m = 0; m < 4; ++m) _Pragma("unroll") for (int n = 0; n < 2; ++n) _Pragma("unroll") for (int k = 0; k < 2; ++k) \
            acc[ai][bj][m][n] = __builtin_amdgcn_mfma_f32_16x16x32_bf16(Bt[n][k], At[m][k], acc[ai][bj][m][n], 0, 0, 0); } \
        __builtin_amdgcn_s_setprio(0); } while (0)
#define PG8_WAIT_V(n) asm volatile("s_waitcnt vmcnt(" #n ")" ::: "memory")
#define PG8_WAIT_L(n) asm volatile("s_waitcnt lgkmcnt(" #n ")" ::: "memory")
#define PG8_BAR __builtin_amdgcn_s_barrier()
#define PG8_SCHED __builtin_amdgcn_sched_barrier(0)
    Unit cur, nxt; int ui = 0;
    if (!S.next(0, cur)) return;
    f32x4 acc[2][2][4][2];
#pragma unroll
    for (int a = 0; a < 2; ++a)
#pragma unroll
        for (int b = 0; b < 2; ++b)
#pragma unroll
            for (int m = 0; m < 4; ++m)
#pragma unroll
                for (int n = 0; n < 2; ++n) acc[a][b][m][n] = (f32x4){0.f, 0.f, 0.f, 0.f};
    bf16x8 At[4][2], B0[2][2], B1[2][2]; v8i_t At8[4], B08[2], B18[2];
    const char* cA = (const char*)g.A + (size_t)cur.pm * tstep + (size_t)cur.koff * 2; const char* cB = (const char*)g.Bt + (size_t)cur.pn * tstep + (size_t)cur.koff * 2;
    S.a_ready(cur);
    if constexpr (SP2) {
        PG8_STAGE(PG8_SB(0, 0), cB, voffB); PG8_STAGE(PG8_SB(0, 1), cB + hstep, voffB); PG8_STAGE(PG8_SA(0, 0), cA, voffA); PG8_STAGE(PG8_SA(0, 1), cA + hstep, voffA);
        if (wr == 1) PG8_BAR;
        PG8_WAIT_V(2); PG8_BAR;
        PG8_STAGE(PG8_SB(1, 0), cB + kstep, voffB); PG8_STAGE(PG8_SA(1, 0), cA + kstep, voffA); PG8_STAGE(PG8_SB(1, 1), cB + hstep + kstep, voffB);
        PG8_WAIT_V(6); PG8_BAR;
    } else {
        PG8_STAGE(PG8_SB(0, 0), cB, voffB); PG8_STAGE(PG8_SA(0, 0), cA, voffA); PG8_STAGE(PG8_SB(0, 1), cB + hstep, voffB); PG8_STAGE(PG8_SA(0, 1), cA + hstep, voffA);
        if (wr == 1) PG8_BAR;
        PG8_WAIT_V(4); PG8_BAR;
        PG8_STAGE(PG8_SB(1, 0), cB + kstep, voffB); PG8_STAGE(PG8_SA(1, 0), cA + kstep, voffA); PG8_STAGE(PG8_SB(1, 1), cB + hstep + kstep, voffB);
        PG8_WAIT_V(6); PG8_BAR;
    }
    for (;;) {
        const bool has_next = S.next(ui + 1, nxt);
        const char* nA = has_next ? (const char*)g.A + (size_t)nxt.pm * tstep + (size_t)nxt.koff * 2 : cA; const char* nB = has_next ? (const char*)g.Bt + (size_t)nxt.pn * tstep + (size_t)nxt.koff * 2 : cB;
        const int ntu = cur.kn > 0 ? cur.kn : nt;
        for (int t = 0; t < ntu; t += 2) {
            const bool last = (t == ntu - 2);
            const char* a1 = cA + (size_t)(t + 1) * kstep;
            const char* a2 = last ? nA : cA + (size_t)(t + 2) * kstep; const char* b2 = last ? nB : cB + (size_t)(t + 2) * kstep;
            const char* a3 = a2 + kstep; const char* b3 = b2 + kstep;
            if (last && has_next) S.a_ready(nxt);
            if constexpr (SP2) {
            PG8_LDB(B0, 0, 0); PG8_LDB(B1, 0, 1); PG8_SCHED; PG8_LDA(At, 0, 0); PG8_STAGE(PG8_SA(1, 1), a1 + hstep, voffA);
            PG8_WAIT_V(8); PG8_WAIT_L(0); PG8_BAR; PG8_MMA(0, 0, At, B0); PG8_MMA(0, 1, At, B1); PG8_BAR; PG8_SCHED;
            PG8_LDA(At, 0, 1); PG8_STAGE(PG8_SB(0, 0), b2, voffB); PG8_STAGE(PG8_SB(0, 1), b2 + hstep, voffB); PG8_STAGE(PG8_SA(0, 0), a2, voffA);
            PG8_WAIT_V(8); PG8_WAIT_L(0); PG8_BAR; PG8_MMA(1, 0, At, B0); PG8_MMA(1, 1, At, B1); PG8_BAR; PG8_SCHED;
            PG8_LDB(B0, 1, 0); PG8_LDB(B1, 1, 1); PG8_SCHED; PG8_LDA(At, 1, 0); PG8_STAGE(PG8_SA(0, 1), a2 + hstep, voffA);
            PG8_WAIT_V(8); PG8_WAIT_L(0); PG8_BAR; PG8_MMA(0, 0, At, B0); PG8_MMA(0, 1, At, B1); PG8_BAR; PG8_SCHED;
            PG8_LDA(At, 1, 1); PG8_STAGE(PG8_SB(1, 0), b3, voffB); PG8_STAGE(PG8_SB(1, 1), b3 + hstep, voffB); PG8_STAGE(PG8_SA(1, 0), a3, voffA);
            PG8_WAIT_V(8); PG8_WAIT_L(0); PG8_BAR; PG8_MMA(1, 0, At, B0); PG8_MMA(1, 1, At, B1); PG8_BAR; PG8_SCHED;
            } else {
            PG8_LDB(B0, 0, 0); PG8_SCHED; PG8_LDA(At, 0, 0); PG8_STAGE(PG8_SA(1, 1), a1 + hstep, voffA);
            PG8_WAIT_L(8); PG8_BAR; PG8_WAIT_L(0); PG8_MMA(0, 0, At, B0); PG8_BAR; PG8_SCHED;
            PG8_LDB(B1, 0, 1); PG8_STAGE(PG8_SB(0, 0), b2, voffB);
            PG8_BAR; PG8_WAIT_L(0); PG8_MMA(0, 1, At, B1); PG8_BAR;
            PG8_LDA(At, 0, 1); PG8_STAGE(PG8_SA(0, 0), a2, voffA);
            PG8_BAR; PG8_WAIT_L(0); PG8_MMA(1, 0, At, B0); PG8_BAR; PG8_SCHED;
            PG8_STAGE(PG8_SB(0, 1), b2 + hstep, voffB);
            PG8_WAIT_V(6); PG8_BAR; PG8_MMA(1, 1, At, B1); PG8_BAR;
            PG8_LDB(B0, 1, 0); PG8_SCHED; PG8_LDA(At, 1, 0); PG8_STAGE(PG8_SA(0, 1), a2 + hstep, voffA);
            PG8_WAIT_L(8); PG8_BAR; PG8_WAIT_L(0); PG8_MMA(0, 0, At, B0); PG8_BAR; PG8_SCHED;
            PG8_LDB(B1, 1, 1); PG8_STAGE(PG8_SB(1, 0), b3, voffB);
            PG8_BAR; PG8_WAIT_L(0); PG8_MMA(0, 1, At, B1); PG8_BAR;
            PG8_LDA(At, 1, 1); PG8_STAGE(PG8_SA(1, 0), a3, voffA);
            PG8_BAR; PG8_WAIT_L(0); PG8_MMA(1, 0, At, B0); PG8_BAR; PG8_SCHED;
            PG8_STAGE(PG8_SB(1, 1), b3 + hstep, voffB);
            PG8_WAIT_V(6); PG8_BAR; PG8_MMA(1, 1, At, B1); PG8_BAR;
            }
        }
        if constexpr (F8) asm volatile("s_nop 15\n\ts_nop 15" ::: "memory");
        if constexpr (ALIGN_EPI) { if (wr == 0) PG8_BAR; }
        if constexpr (!Epi::AFTER_DRAIN) { E(acc, cur, wr, wc, fr, fq); S.done(cur); }
        if (!has_next) break;
#pragma unroll
        for (int a = 0; a < 2; ++a)
#pragma unroll
            for (int b = 0; b < 2; ++b)
#pragma unroll
                for (int m = 0; m < 4; ++m)
#pragma unroll
                    for (int n = 0; n < 2; ++n) acc[a][b][m][n] = (f32x4){0.f, 0.f, 0.f, 0.f};
        cur = nxt; cA = nA; cB = nB; ++ui;
        if constexpr (ALIGN_EPI) { if (wr == 1) PG8_BAR; }
    }
    PG8_WAIT_V(0);
    if constexpr (!ALIGN_EPI) { if (wr == 0) PG8_BAR; }
    PG8_BAR;
    if constexpr (Epi::AFTER_DRAIN) { E.fused(acc, cur, wr, wc, fr, fq, lds, wid, lane); S.done(cur); }
#undef PG8_SA
#undef PG8_SB
#undef PG8_STAGE
#undef PG8_LDA
#undef PG8_LDB
#undef PG8_MMA
#undef PG8_WAIT_V
#undef PG8_WAIT_L
#undef PG8_BAR
#undef PG8_SCHED
}
}

#define GAS __attribute__((address_space(1)))
#define LAS __attribute__((address_space(3)))
typedef unsigned short bf16;
typedef unsigned v4u __attribute__((ext_vector_type(4)));
typedef unsigned v2u __attribute__((ext_vector_type(2)));
typedef float f32x4 __attribute__((ext_vector_type(4)));
typedef float f32x2 __attribute__((ext_vector_type(2)));
typedef short bf16x8 __attribute__((ext_vector_type(8)));
typedef GAS unsigned gu32;

constexpr int NWAVES = 8;
constexpr int DM = 4096;
constexpr int NPROW = 16384, NSROW = 2048, MTOK = NPROW + NSROW;
constexpr int PSEQ = 2048, SSEQ = 64, PAST = 1024, NPB = 8, NSB = 32;
#ifndef LDX_PAD
#define LDX_PAD 0
#endif
constexpr int LDX = 4096 + LDX_PAD;
constexpr int LDH = 12544;
constexpr int HQ = 0, HK = 2048, HV = 2560, HIQ = 3072, HQKV = 4096, HZ = 10240, HSM = 12288;
constexpr int NIN = 12400, CQKV = 6144, DFF = 11008, DFF2 = 22016;
constexpr int TOPK = 256;
constexpr float LN_EPS = 1e-5f;
constexpr float ALPHA = 1.189207115002721f;
constexpr float IDX_SCALE = 0.03125f;
constexpr float QSCALE = 0.08838834764831845f;

constexpr size_t O_Y = 0;
constexpr size_t O_PK = (size_t)MTOK * DM;
constexpr size_t O_PV = O_PK + (size_t)NPROW * 512;
constexpr size_t O_PIK = O_PV + (size_t)NPROW * 512;
constexpr size_t O_PDELTA = O_PIK + (size_t)NPROW * 64;
constexpr size_t O_PCONV = O_PDELTA + (size_t)NPB * 16 * 128 * 128;
constexpr size_t O_PFFN = O_PCONV + (size_t)NPB * 3 * CQKV;
constexpr size_t O_SK = O_PFFN + (size_t)NPB * 2 * DFF2;
constexpr size_t O_SV = O_SK + (size_t)NSROW * 512;
constexpr size_t O_SIK = O_SV + (size_t)NSROW * 512;
constexpr size_t O_SDELTA = O_SIK + (size_t)NSROW * 64;
constexpr size_t O_SCONV = O_SDELTA + (size_t)NSB * 16 * 128 * 128;
constexpr size_t O_SFFN = O_SCONV + (size_t)NSB * 3 * CQKV;
constexpr size_t O_END = O_SFFN + (size_t)NSB * 2 * DFF2;
static_assert(O_END == 108535808ull, "d_out map");
constexpr size_t OS_SC = 0;
constexpr size_t OS_SM = (size_t)MTOK * 2048;
constexpr size_t OS_VTP = OS_SM + (size_t)MTOK * 128;
constexpr size_t OS_VTS = OS_VTP + (size_t)NPB * 4 * 128 * PSEQ / 2;
constexpr int SLEN = PAST + SSEQ;
constexpr int NDU = 9216;
constexpr size_t OS_TBF = ((OS_VTS + (size_t)NSB * 4 * 128 * SLEN / 2) + 3) & ~(size_t)3;
constexpr size_t OS_TGF = OS_TBF + (size_t)NDU * 512;
constexpr size_t OS_MFF = OS_TGF + (size_t)NDU * 512;
constexpr size_t OS_GB = OS_MFF + (size_t)NDU * 512;
constexpr size_t OS_MSK = OS_GB + (size_t)MTOK * 16;
static_assert(OS_MSK % 4 == 0 && OS_MSK + (size_t)MTOK * 64 <= O_PK, "scratch in y region");


constexpr size_t MiB = 1u << 20;
constexpr size_t WS_CTL = 0, CTL_ZERO_BYTES = 64 * 1024;
constexpr size_t WS_WO = 1 * MiB;
constexpr size_t WS_XN = WS_WO + 32 * MiB;
constexpr size_t WS_CAT = WS_XN + 150 * MiB;
constexpr size_t WS_WIN = WS_CAT + 144 * MiB;
constexpr size_t WS_H = WS_WIN + 102 * MiB;
constexpr size_t WS_QKVC = WS_H + 441 * MiB;
constexpr size_t WS_END = WS_QKVC + 216 * MiB;
#ifndef WUP_EARLY
#define WUP_EARLY 1
#endif
#if WUP_EARLY
constexpr size_t WS_WUP = WS_CAT + 72 * MiB;
constexpr size_t WS_WDN = WS_CAT;
static_assert((size_t)MTOK * DM <= 72 * MiB && (size_t)DM * DFF <= 72 * MiB && WS_WUP + (size_t)DFF2 * LDX * 2 <= WS_H, "early w_up layout");
#else
constexpr size_t WS_WUP = WS_CAT;
constexpr size_t WS_WDN = WS_WUP + 178 * MiB;
#endif
constexpr size_t WS_ACT = WS_CAT + 264 * MiB;
constexpr size_t WS_P2 = WS_CAT + 706 * MiB;
constexpr size_t WS_PRE1 = WS_ACT;
constexpr size_t WS_PRE2 = WS_WUP;
constexpr size_t WS_P3 = WS_ACT + 194 * MiB;
constexpr size_t WS_UPS = WS_ACT + 388 * MiB;
static_assert((size_t)MTOK * LDH * 2 <= 441 * MiB && (size_t)LDH * LDX * 2 <= 102 * MiB && (size_t)MTOK * LDX * 2 <= 150 * MiB && (size_t)MTOK * CQKV * 2 <= 216 * MiB, "ws sizes");
static_assert((size_t)DFF2 * LDX * 2 <= 178 * MiB && (size_t)DM * DFF * 2 <= 86 * MiB && (size_t)MTOK * DFF * 2 <= 388 * MiB && WS_UPS + (size_t)288 * 4 * DFF2 * 2 <= WS_P2 && WS_P2 + (size_t)128 * 65536 * 4 <= WS_END, "ffn ws sizes");

constexpr int CW_QT1 = 1024, CW_QT6 = 1088, CW_QT5 = 1152, CW_T3 = 13312;
constexpr int CW_Q2 = 64, CW_Q3 = 128;
constexpr int CW_BAR = 4096;
constexpr int CW_XR = 12288;
constexpr int CW_TIX2 = 8192, CW_TIX4 = 8192 + 1152;

constexpr int RING_BYTES = 131072;
constexpr int LDSCTL_OFF = RING_BYTES, MISC_OFF = LDSCTL_OFF + 320;
constexpr int LDS_BYTES = 147456;
constexpr int EPIW_OFF = LDSCTL_OFF + 4096;
static_assert(EPIW_OFF + 8192 <= LDS_BYTES, "lds map");

#define RLX_AGENT __ATOMIC_RELAXED, __HIP_MEMORY_SCOPE_AGENT
#define LDS_WAIT() asm volatile("s_waitcnt lgkmcnt(0)" ::: "memory")
__device__ __forceinline__ unsigned f2bf(float f) { unsigned u = __builtin_bit_cast(unsigned, f); return (u + 0x7fffu + ((u >> 16) & 1u)) >> 16; }
typedef float f32x2_t __attribute__((ext_vector_type(2))); typedef __bf16 bf16x2_t __attribute__((ext_vector_type(2)));
__device__ __forceinline__ unsigned pk2(float lo, float hi) { f32x2_t v = {lo, hi}; bf16x2_t b = __builtin_convertvector(v, bf16x2_t); return __builtin_bit_cast(unsigned, b); }
__device__ __forceinline__ float bflo(unsigned w) { return __uint_as_float(w << 16); }
__device__ __forceinline__ float bfhi(unsigned w) { return __uint_as_float(w & 0xffff0000u); }
#define DPPF(x, ctrl) __int_as_float(__builtin_amdgcn_mov_dpp(__float_as_int(x), (ctrl), 0xf, 0xf, true))
__device__ __forceinline__ float wave_sum(float v) {
    v += DPPF(v, 0xB1); v += DPPF(v, 0x4E); v += DPPF(v, 0x141); v += DPPF(v, 0x140);
    const float s0 = __int_as_float(__builtin_amdgcn_readlane(__float_as_int(v), 0)), s1 = __int_as_float(__builtin_amdgcn_readlane(__float_as_int(v), 16));
    const float s2 = __int_as_float(__builtin_amdgcn_readlane(__float_as_int(v), 32)), s3 = __int_as_float(__builtin_amdgcn_readlane(__float_as_int(v), 48));
    return (s0 + s1) + (s2 + s3);
}
__device__ __forceinline__ float wave_max(float v) {
#pragma unroll
    for (int o = 1; o < 64; o <<= 1) v = fmaxf(v, __shfl_xor(v, o));
    return v;
}
__device__ __forceinline__ int wave_sum_i(int v) {
#pragma unroll
    for (int o = 1; o < 64; o <<= 1) v += __shfl_xor(v, o);
    return v;
}
#define DS_RD128(dst, addr, off) asm volatile("ds_read_b128 %0, %1 offset:%c2" : "=v"(dst) : "v"(addr), "i"(off))
#define DS_RDTR(dst, addr, off) asm volatile("ds_read_b64_tr_b16 %0, %1 offset:%c2" : "=v"(dst) : "v"(addr), "i"(off))
#define DS_RD64(dst, addr, off) asm volatile("ds_read_b64 %0, %1 offset:%c2" : "=v"(dst) : "v"(addr), "i"(off))
__device__ __forceinline__ float silu_f(float x) { return x * __builtin_amdgcn_rcpf(1.f + __expf(-x)); }

#define GLD32(dst, ptr, off) asm volatile("global_load_dword %0, %1, off offset:%c2 sc1" : "=&v"(dst) : "v"(ptr), "i"(off) : "memory")
#define GLD128(dst, ptr) asm volatile("global_load_dwordx4 %0, %1, off" : "=&v"(dst) : "v"(ptr) : "memory")
#define GLD128S(dst, voff, sptr, imm) asm volatile("global_load_dwordx4 %0, %1, %2 offset:%c3" : "=&v"(dst) : "v"(voff), "s"(sptr), "i"(imm) : "memory")
#ifndef FFN_DOWN_FP8
#define FFN_DOWN_FP8 1
#endif
#ifndef MIX_FP8
#define MIX_FP8 1
#endif
constexpr float CAT_Q = 16.f, WO_Q = 512.f;
constexpr float ACT_Q = 2.f, WDN_Q = 1024.f;
__device__ __forceinline__ unsigned pk4_fp8(float a, float b, float c_, float d) {
    a = __builtin_amdgcn_fmed3f(a, -448.f, 448.f); b = __builtin_amdgcn_fmed3f(b, -448.f, 448.f); c_ = __builtin_amdgcn_fmed3f(c_, -448.f, 448.f); d = __builtin_amdgcn_fmed3f(d, -448.f, 448.f);
    int w = 0; w = __builtin_amdgcn_cvt_pk_fp8_f32(a, b, w, false); w = __builtin_amdgcn_cvt_pk_fp8_f32(c_, d, w, true); return (unsigned)w;
}
#ifndef EPI_NT
#define EPI_NT 0
#endif
#if EPI_NT
#define EPI_ST(ptr, val) __builtin_nontemporal_store((val), (ptr))
#else
#define EPI_ST(ptr, val) (*(ptr) = (val))
#endif
__device__ __forceinline__ void st8f(float* p, pg8::f32x4 a, pg8::f32x4 b) { EPI_ST((pg8::f32x4*)p, a); EPI_ST((pg8::f32x4*)(p + 4), b); }
__device__ __forceinline__ void st8b(bf16* p, pg8::f32x4 a, pg8::f32x4 b) { pg8::u32x4 w; w.x = pg8::cvt_pk_bf16(a[0], a[1]); w.y = pg8::cvt_pk_bf16(a[2], a[3]); w.z = pg8::cvt_pk_bf16(b[0], b[1]); w.w = pg8::cvt_pk_bf16(b[2], b[3]); EPI_ST((pg8::u32x4*)p, w); }

struct Epi1 {
    static constexpr bool PERM = true, AFTER_DRAIN = false;
    bf16* H; float* SM; float* out;
    __device__ __forceinline__ void operator()(const pg8::f32x4 (&acc)[2][2][4][2], const pg8::Unit& u, int wr, int wc, int fr, int fq) const {
        const int pn = u.pn;
#pragma unroll
        for (int ai = 0; ai < 2; ++ai)
#pragma unroll
            for (int m = 0; m < 4; ++m) {
                const int row = u.pm * 256 + ai * 128 + wr * 64 + m * 16 + fr;
                const bool prompt = row < NPROW; const int r2 = row - NPROW;
                const int b = prompt ? (row >> 11) : (r2 >> 6), t = prompt ? (row & 2047) : (r2 & 63);
#pragma unroll
                for (int bj = 0; bj < 2; ++bj) {
                    const int col = pn * 256 + bj * 128 + wc * 32 + 8 * fq;
                    const pg8::f32x4 v0 = acc[ai][bj][m][0], v1 = acc[ai][bj][m][1];
                    st8b(H + (size_t)row * LDH + col, v0, v1);
                    if (pn >= 8 && pn < 12) {
                        int c = col - HK; const bool isv = c >= 512; if (isv) c -= 512;
                        float* dst = out + (prompt ? (isv ? O_PV : O_PK) + (size_t)row * 512 : (isv ? O_SV : O_SK) + (size_t)r2 * 512) + c;
                        st8f(dst, v0, v1);
                    } else if (pn >= 16 && pn < 40) {
                        const int tl = prompt ? t - (PSEQ - 3) : t - (SSEQ - 3);
                        if (tl >= 0) st8f(out + (prompt ? O_PCONV : O_SCONV) + (size_t)(b * 3 + tl) * CQKV + (col - HQKV), v0, v1);
                    } else if (pn == 48) {
                        const int c = col - HSM;
                        if (c < 128) st8f(SM + (size_t)row * 128 + c, v0, v1);
                        if (c < 64) st8f(out + (prompt ? O_PIK + (size_t)row * 64 : O_SIK + (size_t)r2 * 64) + c, v0, v1);
                    }
                }
            }
    }
};
struct EpiRes {
    static constexpr bool PERM = true, AFTER_DRAIN = false;
    const bf16* res; bf16* out; int row0; float sc;
    float* p2; unsigned* tix;
    __device__ __forceinline__ void operator()(const pg8::f32x4 (&acc)[2][2][4][2], const pg8::Unit& u, int wr, int wc, int fr, int fq) const {
        const int rowb = row0 + u.pm * 256 + wr * 64 + fr, colb = u.pn * 256 + wc * 32 + 8 * fq;
        if (u.part != 0) {
            float* pt = p2 + (size_t)u.tidx * 65536 + (size_t)(wr * 64 + fr) * 256 + wc * 32 + 8 * fq;
#pragma unroll
            for (int ai = 0; ai < 2; ++ai)
#pragma unroll
                for (int m = 0; m < 4; ++m)
#pragma unroll
                    for (int bj = 0; bj < 2; ++bj) st8f(pt + (size_t)(ai * 128 + m * 16) * 256 + bj * 128, acc[ai][bj][m][0] * sc, acc[ai][bj][m][1] * sc);
            if (wr == 0 && wc == 0 && fr == 0 && fq == 0) tix[u.pm * 16 + u.pn] = (unsigned)u.tidx + 1u;
            return;
        }
        pg8::u32x4 r[2][4][2];
#pragma unroll
        for (int ai = 0; ai < 2; ++ai)
#pragma unroll
            for (int m = 0; m < 4; ++m)
#pragma unroll
                for (int bj = 0; bj < 2; ++bj) GLD128(r[ai][m][bj], res + (size_t)(rowb + ai * 128 + m * 16) * LDX + colb + bj * 128);
        asm volatile("s_waitcnt vmcnt(0)" : "+v"(r[0][0][0]), "+v"(r[0][0][1]), "+v"(r[0][1][0]), "+v"(r[0][1][1]), "+v"(r[0][2][0]), "+v"(r[0][2][1]), "+v"(r[0][3][0]), "+v"(r[0][3][1]),
                                            "+v"(r[1][0][0]), "+v"(r[1][0][1]), "+v"(r[1][1][0]), "+v"(r[1][1][1]), "+v"(r[1][2][0]), "+v"(r[1][2][1]), "+v"(r[1][3][0]), "+v"(r[1][3][1]));
#pragma unroll
        for (int ai = 0; ai < 2; ++ai) {
#pragma unroll
            for (int m = 0; m < 4; ++m) {
                const int row = rowb + ai * 128 + m * 16;
#pragma unroll
                for (int bj = 0; bj < 2; ++bj) {
                    const int col = colb + bj * 128;
                    const pg8::u32x4 rr = r[ai][m][bj];
                    pg8::f32x4 v0 = acc[ai][bj][m][0] * sc, v1 = acc[ai][bj][m][1] * sc;
                    v0[0] += ALPHA * bflo(rr.x); v0[1] += ALPHA * bfhi(rr.x); v0[2] += ALPHA * bflo(rr.y); v0[3] += ALPHA * bfhi(rr.y);
                    v1[0] += ALPHA * bflo(rr.z); v1[1] += ALPHA * bfhi(rr.z); v1[2] += ALPHA * bflo(rr.w); v1[3] += ALPHA * bfhi(rr.w);
                    st8b(out + (size_t)row * DM + col, v0, v1);
                }
            }
        }
    }
};
__device__ __forceinline__ float dpp_ror1(float x) { return __int_as_float(__builtin_amdgcn_mov_dpp(__float_as_int(x), 0x121, 0xf, 0xf, true)); }
__device__ __forceinline__ float dpp_ror2(float x) { return __int_as_float(__builtin_amdgcn_mov_dpp(__float_as_int(x), 0x122, 0xf, 0xf, true)); }
#ifndef UPT_NS
#define UPT_NS 4
#endif
struct EpiUpAct {
    static constexpr bool PERM = true, AFTER_DRAIN = false;
    bf16* ACT; bf16* UPS; float* out; const float* fw; const float* fb; LAS float* wl;
    float* part; unsigned* cnt;
    __device__ __forceinline__ void operator()(const pg8::f32x4 (&acc)[2][2][4][2], const pg8::Unit& u, int wr, int wc, int fr, int fq) const {
        const int colb = u.pn * 128 + wc * 32 + 8 * fq;
        if (u.kn > 0) {
            pg8::f32x4 (&A)[2][2][4][2] = const_cast<pg8::f32x4 (&)[2][2][4][2]>(acc);
            const int lane_ = fq * 16 + fr, ws_ = wr * 4 + wc;
            float* pb = part + (size_t)u.tidx * (UPT_NS * 65536) + ws_ * 8192 + lane_ * 4;
            float* mine = pb + (size_t)u.part * 65536;
#pragma unroll
            for (int ai = 0; ai < 2; ++ai)
#pragma unroll
                for (int bj = 0; bj < 2; ++bj)
#pragma unroll
                    for (int m = 0; m < 4; ++m)
#pragma unroll
                        for (int n = 0; n < 2; ++n) asm volatile("global_store_dwordx4 %0, %1, off sc1" :: "v"(mine + (((ai * 2 + bj) * 4 + m) * 2 + n) * 256), "v"(A[ai][bj][m][n]) : "memory");
            asm volatile("s_waitcnt vmcnt(0)" ::: "memory");
            unsigned old_ = 0u;
            if (lane_ == 0) old_ = __hip_atomic_fetch_add(cnt + u.tidx * 8 + ws_, 1u, __ATOMIC_RELAXED, __HIP_MEMORY_SCOPE_AGENT);
            old_ = __builtin_amdgcn_readfirstlane(old_);
            if (old_ != (unsigned)(UPT_NS - 1)) return;
            __builtin_amdgcn_fence(__ATOMIC_ACQUIRE, "agent");
#pragma unroll 1
            for (int j = 1; j < UPT_NS; ++j) {
                const float* op = pb + (size_t)((u.part + j) % UPT_NS) * 65536;
#pragma unroll
                for (int ai = 0; ai < 2; ++ai)
#pragma unroll
                    for (int bj = 0; bj < 2; ++bj)
#pragma unroll
                        for (int m = 0; m < 4; ++m)
#pragma unroll
                            for (int n = 0; n < 2; ++n) A[ai][bj][m][n] += *(const pg8::f32x4*)(op + (((ai * 2 + bj) * 4 + m) * 2 + n) * 256);
            }
        }
        LAS float* wl_ = wl + (wr * 4 + wc) * 256;
        {
            const int lane_ = fq * 16 + fr, k = lane_ >> 3, c4 = lane_ & 7;
            const float* src = ((k & 3) == 3 ? fb : fw + (k & 3) * DFF2) + (k >> 2) * DFF + u.pn * 128 + wc * 32 + 4 * c4;
            const pg8::f32x4 wv_ = *(const pg8::f32x4*)src * ((FFN_DOWN_FP8 && k >= 4) ? ACT_Q : 1.f);
            *(LAS pg8::f32x4*)(wl_ + lane_ * 4) = wv_;
            LDS_WAIT(); asm volatile("" ::: "memory");
        }
#pragma unroll
        for (int n = 0; n < 2; ++n) {
            const int cg = colb + 4 * n;
            pg8::f32x4 W[1][8];
#pragma unroll
            for (int k = 0; k < 8; ++k) W[0][k] = *(const LAS pg8::f32x4*)(wl_ + (k * 8 + 2 * fq + n) * 4);
            const pg8::f32x4 wg0 = W[0][0], wg1 = W[0][1], wg2 = W[0][2], bg = W[0][3], wv0 = W[0][4], wv1 = W[0][5], wv2 = W[0][6], bv = W[0][7];
#pragma unroll
            for (int ai = 0; ai < 2; ++ai) {
                pg8::f32x4 g1p = {0.f, 0.f, 0.f, 0.f}, g2p = g1p, v1p = g1p, v2p = g1p;
#pragma unroll
                for (int m = 0; m < 4; ++m) {
                    const int row = u.pm * 256 + ai * 128 + wr * 64 + m * 16 + fr;
                    const pg8::f32x4 G = acc[ai][0][m][n], V = acc[ai][1][m][n];
                    pg8::f32x4 g1, g2, v1, v2, a;
#pragma unroll
                    for (int e2 = 0; e2 < 4; e2 += 2) {
                        typedef float f2_t __attribute__((ext_vector_type(2)));
                        f2_t pg1, pg2, pv1, pv2;
#pragma unroll
                        for (int q = 0; q < 2; ++q) { const int e = e2 + q;
                            g1[e] = dpp_ror1(G[e]); g2[e] = dpp_ror2(G[e]); v1[e] = dpp_ror1(V[e]); v2[e] = dpp_ror2(V[e]);
                            pg1[q] = fr == 0 ? g1p[e] : g1[e]; pg2[q] = fr < 2 ? g2p[e] : g2[e]; pv1[q] = fr == 0 ? v1p[e] : v1[e]; pv2[q] = fr < 2 ? v2p[e] : v2[e]; }
                        const f2_t G2 = {G[e2], G[e2 + 1]}, V2 = {V[e2], V[e2 + 1]};
                        const f2_t cg2 = (f2_t){bg[e2], bg[e2 + 1]} + (f2_t){wg0[e2], wg0[e2 + 1]} * pg2 + (f2_t){wg1[e2], wg1[e2 + 1]} * pg1 + (f2_t){wg2[e2], wg2[e2 + 1]} * G2;
                        const f2_t cv2 = (f2_t){bv[e2], bv[e2 + 1]} + (f2_t){wv0[e2], wv0[e2 + 1]} * pv2 + (f2_t){wv1[e2], wv1[e2 + 1]} * pv1 + (f2_t){wv2[e2], wv2[e2 + 1]} * V2;
#pragma unroll
                        for (int q = 0; q < 2; ++q) a[e2 + q] = cg2[q] * __builtin_amdgcn_rcpf(1.f + __expf(-cg2[q])) * cv2[q];
                    }
                    g1p = g1; g2p = g2; v1p = v1; v2p = v2;
                    const bool first2 = (m == 0) && fr < 2;
#if FFN_DOWN_FP8
                    if (!first2) *(unsigned*)((unsigned char*)ACT + (size_t)row * DFF + cg) = pk4_fp8(a[0], a[1], a[2], a[3]);
#else
                    if (!first2) { pg8::u32x4 t; t.x = pg8::cvt_pk_bf16(a[0], a[1]); t.y = pg8::cvt_pk_bf16(a[2], a[3]); *(unsigned long long*)(ACT + (size_t)row * DFF + cg) = (unsigned long long)t.x | ((unsigned long long)t.y << 32); }
#endif
                    if (first2 || ((m == 3) && fr >= 14)) {
                        bf16* us = UPS + (size_t)((row >> 6) * 4 + (((row & 63) + 2) & 63)) * DFF2;
                        *(unsigned long long*)(us + cg) = (unsigned long long)pg8::cvt_pk_bf16(G[0], G[1]) | ((unsigned long long)pg8::cvt_pk_bf16(G[2], G[3]) << 32);
                        *(unsigned long long*)(us + DFF + cg) = (unsigned long long)pg8::cvt_pk_bf16(V[0], V[1]) | ((unsigned long long)pg8::cvt_pk_bf16(V[2], V[3]) << 32);
                    }
                    {
                        const bool prompt = row < NPROW; const int r2 = row - NPROW;
                        const int b = prompt ? (row >> 11) : (r2 >> 6), t = prompt ? (row & 2047) : (r2 & 63);
                        const int tl = prompt ? t - (PSEQ - 2) : t - (SSEQ - 2);
                        if (tl >= 0) { float* so = out + (prompt ? O_PFFN : O_SFFN) + (size_t)(b * 2 + tl) * DFF2; *(pg8::f32x4*)(so + cg) = G; *(pg8::f32x4*)(so + DFF + cg) = V; }
                    }
                }
            }
        }
    }
};

#define XB_TMO      128
#define XB_XCNT(j)  (256  + 64 * (j))
#define XB_XSUB(j)  (1280 + 64 * (j))
#define XB_XGEN(j)  (2304 + 64 * (j))
#define XB_TOP      3328
#define XB_TOPGEN   3392
#define XCD_BAR_WORDS 3456
#define XB_SPIN_CAP (1u << 18)

__device__ __forceinline__ unsigned xb_ld(unsigned* p)              { return __hip_atomic_load(p, __ATOMIC_RELAXED, __HIP_MEMORY_SCOPE_AGENT); }
__device__ __forceinline__ unsigned xb_add(unsigned* p, unsigned v) { return __hip_atomic_fetch_add(p, v, __ATOMIC_RELAXED, __HIP_MEMORY_SCOPE_AGENT); }
__device__ __forceinline__ unsigned xb_xcc_id() { return (unsigned)__builtin_amdgcn_s_getreg((3 << 11) | 20) & 0xFu; }
#define XB_SPIN(cond, bar) do { unsigned _sp = 0; while (cond) { __builtin_amdgcn_s_sleep(1); \
    if ((++_sp & 255u) == 0u) { if (xb_ld(&(bar)[XB_TMO])) break; if (_sp > XB_SPIN_CAP) { atomicAdd(&(bar)[XB_TMO], 1u); break; } } } } while (0)

struct XcdBarrier {
    unsigned* bar; unsigned x;
    volatile LAS unsigned* st;
};

__device__ __forceinline__ XcdBarrier xcd_barrier_post(unsigned* bar, volatile LAS unsigned* st) {
    XcdBarrier b; b.bar = bar; b.x = xb_xcc_id(); b.st = st;
    if (threadIdx.x == 0) (void)xb_add(&bar[XB_XCNT(b.x)], 1u);
    return b;
}
__device__ __forceinline__ void xcd_barrier_complete(unsigned* bar, unsigned x, unsigned& nloc, unsigned& nx) {
    const unsigned G = gridDim.x * gridDim.y * gridDim.z;
    unsigned sum, cnt, mine, sp = 0u;
    for (;;) {
        sum = 0u; cnt = 0u; mine = 0u;
#pragma unroll
        for (unsigned j = 0; j < 16; ++j) { const unsigned c = xb_ld(&bar[XB_XCNT(j)]); sum += c; cnt += (c > 0u) ? 1u : 0u; mine = (j == x) ? c : mine; }
        if (sum == G) break;
        __builtin_amdgcn_s_sleep(1);
        if ((++sp & 255u) == 0u) { if (xb_ld(&bar[XB_TMO])) break; if (sp > XB_SPIN_CAP) { atomicAdd(&bar[XB_TMO], 1u); break; } }
    }
    nloc = mine > 0u ? mine : 1u; nx = cnt > 0u ? cnt : 1u;
}

__device__ __forceinline__ void xcd_barrier(const XcdBarrier& b) {
    asm volatile("s_waitcnt vmcnt(0)" ::: "memory");
    __syncthreads();
    if (threadIdx.x == 0) {
        unsigned* bar = b.bar;
        __builtin_amdgcn_s_waitcnt(0);
        unsigned nloc = b.st[0], nx = b.st[1];
        if (nloc == 0u) { xcd_barrier_complete(bar, b.x, nloc, nx); b.st[0] = nloc; b.st[1] = nx; }
        const unsigned old = xb_add(&bar[XB_XSUB(b.x)], 1u);
        const unsigned gen = old / nloc;
        if (old + 1u == (gen + 1u) * nloc) {
            __builtin_amdgcn_fence(__ATOMIC_RELEASE, "agent");
            asm volatile("s_waitcnt vmcnt(0)" ::: "memory");
            const unsigned og = xb_add(&bar[XB_TOP], 1u);
            const unsigned tg = og / nx;
            if (og + 1u == (tg + 1u) * nx) xb_add(&bar[XB_TOPGEN], 1u);
            else XB_SPIN(xb_ld(&bar[XB_TOPGEN]) == tg, bar);
            __builtin_amdgcn_fence(__ATOMIC_ACQUIRE, "agent");
            xb_add(&bar[XB_XGEN(b.x)], 1u);
            asm volatile("s_waitcnt vmcnt(0)" ::: "memory");
        } else {
            XB_SPIN(xb_ld(&bar[XB_XGEN(b.x)]) == gen, bar);
            __builtin_amdgcn_fence(__ATOMIC_ACQUIRE, "agent");
            asm volatile("s_waitcnt vmcnt(0)" ::: "memory");
        }
    }
    __syncthreads();
}

struct Ctx {
    float* out; unsigned char* ws;
    LAS unsigned char* lds; gu32* ctl;
    int tid, lane, wave, G, bid;
};
enum { I_XP = 0, I_XS, I_CK, I_CV, I_CIK, I_SDELTA, I_SCONV, I_SFFN, I_LNG, I_LNB, I_WIN, I_CQW, I_CQB, I_ALOG, I_DTB, I_DNG, I_RELB, I_WO, I_LN1G, I_LN1B, I_WUP, I_FCW, I_FCB, I_WDN, I_LN2G, I_LN2B };

constexpr int PTAB_OFF = LDSCTL_OFF + 1024;
__device__ __forceinline__ const float* inp(const Ctx& C, int i) {
    const unsigned long long v = ((const LAS unsigned long long*)(C.lds + PTAB_OFF))[i];
    const unsigned lo = __builtin_amdgcn_readfirstlane((unsigned)v), hi = __builtin_amdgcn_readfirstlane((unsigned)(v >> 32));
    return (const float*)(const GAS float*)(size_t)(((unsigned long long)hi << 32) | lo);
}
__device__ __forceinline__ int q_next(const Ctx& C, int cw) {
    volatile LAS unsigned* slot = (volatile LAS unsigned*)(C.lds + MISC_OFF) + 16;
    __syncthreads();
    if (C.tid == 0) *slot = __hip_atomic_fetch_add((unsigned*)(C.ctl + cw), 1u, __ATOMIC_RELAXED, __HIP_MEMORY_SCOPE_AGENT);
    __syncthreads();
    return (int)*slot;
}

template <int MODE> __device__ __forceinline__ int dst_row_map(int n) {
    if (MODE == 0 || MODE == 3 || MODE == 4) return n;
    if (MODE == 2) { const int v = n >= DFF, j = v ? n - DFF : n; return (j >> 7) * 256 + v * 128 + (j & 127); }
    if (n < 4096) return n;
    if (n < 4160) return HSM + (n - 4096);
    if (n < 4176) return HSM + 64 + (n - 4160);
    if (n < 12368) return n - 80;
    return n;
}
__device__ __forceinline__ void tr_load(const float* W, int K, int N, int item, int lane, float (&v)[32]) {
    const int nblk = (N + 31) / 32, kb = item / nblk, nb = item % nblk, k0 = 64 * kb, n0 = 32 * nb;
    const int nn = min(n0 + (lane & 31), N - 1);
    const float* src = W + (size_t)(k0 + (lane >> 5)) * N + nn;
#pragma unroll
    for (int i = 0; i < 32; ++i) v[i] = src[(size_t)(2 * i) * N];
}
template <int MODE> __device__ __forceinline__ void tr_store(int K, int N, bf16* WT, LAS float* scr, int item, int lane, const float (&v)[32]) {
    const int ldw = (MODE == 1 || MODE == 2) ? LDX : K;
    const int nblk = (N + 31) / 32, kb = item / nblk, nb = item % nblk, k0 = 64 * kb, n0 = 32 * nb;
#pragma unroll
    for (int i = 0; i < 32; ++i) scr[(2 * i + (lane >> 5)) * 33 + (lane & 31)] = v[i];
    LDS_WAIT(); asm volatile("" ::: "memory");
    const int c = lane & 7;
#pragma unroll
    for (int j = 0; j < 4; ++j) { const int n = (lane >> 3) + 8 * j; const LAS float* s = scr + (8 * c) * 33 + n;
        v4u o; o.x = pk2(s[0 * 33], s[1 * 33]); o.y = pk2(s[2 * 33], s[3 * 33]); o.z = pk2(s[4 * 33], s[5 * 33]); o.w = pk2(s[6 * 33], s[7 * 33]);
        if (MODE == 3 || MODE == 4) { const float WQ_ = MODE == 3 ? WDN_Q : WO_Q; if (n0 + n < N) { v2u q; q.x = pk4_fp8(s[0 * 33] * WQ_, s[1 * 33] * WQ_, s[2 * 33] * WQ_, s[3 * 33] * WQ_); q.y = pk4_fp8(s[4 * 33] * WQ_, s[5 * 33] * WQ_, s[6 * 33] * WQ_, s[7 * 33] * WQ_);
                                          *(v2u*)((unsigned char*)WT + (size_t)(n0 + n) * K + k0 + 8 * c) = q; } }
        else if (n0 + n < N) *(v4u*)(WT + (size_t)dst_row_map<MODE>(n0 + n) * ldw + k0 + 8 * c) = o; }
    LDS_WAIT(); asm volatile("" ::: "memory");
}
template <int MODE> __device__ __forceinline__ void transpose_static(const float* W, int K, int N, bf16* WT, int total, LAS float* scr, int gw, int NGW, int lane) {
    float a[32], b[32];
    int it = gw;
    if (it >= total) return;
    tr_load(W, K, N, it, lane, a);
#pragma unroll 1
    for (;;) {
        const int it1 = it + NGW, it2 = it1 + NGW;
        tr_load(W, K, N, min(it1, total - 1), lane, b);
        tr_store<MODE>(K, N, WT, scr, it, lane, a);
        if (it1 >= total) break;
        tr_load(W, K, N, min(it2, total - 1), lane, a);
        tr_store<MODE>(K, N, WT, scr, it1, lane, b);
        if (it2 >= total) break;
        it = it2;
    }
}
template <int MODE> __device__ __forceinline__ void transpose_queue(const Ctx& C, const float* W, int K, int N, bf16* WT, int nitems, int cw, int g_lo = 0, int g_hi = 1 << 30, int scr_base = 0, int scr_stride = 16384) {
    LAS float* scr = (LAS float*)(C.lds + scr_base + C.wave * scr_stride);
    volatile LAS unsigned* slot = (volatile LAS unsigned*)(C.lds + MISC_OFF) + 16;
    const int ngrab = min((nitems + 15) / 16, g_hi);
    int g = g_lo + q_next(C, cw);
    if (g >= ngrab) return;
    float a[32], b[32];
    tr_load(W, K, N, min(g * 16 + C.wave, nitems - 1), C.lane, a);
#pragma unroll 1
    for (;;) {
        const int i0 = g * 16 + C.wave, i1 = i0 + 8;
        unsigned tk = 0u;
        if (C.tid == 0) tk = __hip_atomic_fetch_add((unsigned*)(C.ctl + cw), 1u, __ATOMIC_RELAXED, __HIP_MEMORY_SCOPE_AGENT);
        tr_load(W, K, N, min(i1, nitems - 1), C.lane, b);
        if (i0 < nitems) tr_store<MODE>(K, N, WT, scr, i0, C.lane, a);
        __syncthreads();
        if (C.tid == 0) *slot = tk;
        __syncthreads();
        const int gn = g_lo + (int)*slot;
        tr_load(W, K, N, min(gn * 16 + C.wave, nitems - 1), C.lane, a);
        if (i1 < nitems) tr_store<MODE>(K, N, WT, scr, i1, C.lane, b);
        if (gn >= ngrab) break;
        g = gn;
    }
}
template <int MODE> __device__ __forceinline__ bool transpose_grabs(const Ctx& C, const float* W, int K, int N, bf16* WT, int nitems, int cw, int g_lo, int g_hi, int scr_base, int scr_stride, int ngr) {
    LAS float* scr = (LAS float*)(C.lds + scr_base + C.wave * scr_stride);
    const int ngrab = min((nitems + 15) / 16, g_hi);
#pragma unroll 1
    for (int j = 0; j < ngr; ++j) {
        const int g = g_lo + q_next(C, cw); if (g >= ngrab) return false;
        const int i0 = g * 16 + C.wave, i1 = i0 + 8;
        float a[32], b[32];
        tr_load(W, K, N, min(i0, nitems - 1), C.lane, a);
        tr_load(W, K, N, min(i1, nitems - 1), C.lane, b);
        if (i0 < nitems) tr_store<MODE>(K, N, WT, scr, i0, C.lane, a);
        if (i1 < nitems) tr_store<MODE>(K, N, WT, scr, i1, C.lane, b);
    }
    return true;
}
struct LnP { f32x4 g[16], b[16]; };
__device__ __forceinline__ void ln_params(LnP& P, const float* g, const float* bta, int lane) {
#pragma unroll
    for (int j = 0; j < 16; ++j) { P.g[j] = ((const f32x4*)g)[lane + 64 * j]; P.b[j] = ((const f32x4*)bta)[lane + 64 * j]; }
}
template <bool F32OUT, bool TAIL = false, bool INBF = false> __device__ __forceinline__ void ln_row(const void* xrow, const LnP& P, void* orow, int lane, const unsigned* tix16 = nullptr, const float* p2 = nullptr, int rin = 0) {
    f32x4 v[16]; float s = 0.f;
    if (INBF) {
        const v2u* xr = (const v2u*)xrow + lane;
#pragma unroll
        for (int j = 0; j < 16; ++j) { const v2u w = xr[64 * j]; v[j] = (f32x4){bflo(w.x), bfhi(w.x), bflo(w.y), bfhi(w.y)}; }
    } else {
        const f32x4* xr = (const f32x4*)xrow + lane;
#pragma unroll
        for (int j = 0; j < 16; ++j) v[j] = xr[64 * j];
    }
    if (TAIL) {
        unsigned tt[16], any = 0u;
#pragma unroll
        for (int j = 0; j < 16; ++j) { tt[j] = __builtin_amdgcn_readfirstlane(tix16[j]); any |= tt[j]; }
        if (any) {
#pragma unroll
            for (int h = 0; h < 4; ++h) {
                f32x4 pv[4];
#pragma unroll
                for (int j = 0; j < 4; ++j) { const unsigned t = tt[4 * h + j]; pv[j] = *(const f32x4*)(p2 + (size_t)(t ? t - 1u : 0u) * 65536 + (size_t)rin * 256 + lane * 4); }
#pragma unroll
                for (int j = 0; j < 4; ++j) { const float on = tt[4 * h + j] ? 1.f : 0.f; v[4 * h + j] += pv[j] * on; }
            }
        }
    }
#pragma unroll
    for (int j = 0; j < 16; ++j) s += (v[j].x + v[j].y) + (v[j].z + v[j].w);
    const float mean = wave_sum(s) * (1.f / DM); float s2 = 0.f;
#pragma unroll
    for (int j = 0; j < 16; ++j) { v[j] = v[j] - mean; s2 += (v[j].x * v[j].x + v[j].y * v[j].y) + (v[j].z * v[j].z + v[j].w * v[j].w); }
    const float rstd = 1.f / sqrtf(wave_sum(s2) * (1.f / DM) + LN_EPS);
#pragma unroll
    for (int j = 0; j < 16; ++j) {
        const f32x4 y = v[j] * rstd * P.g[j] + P.b[j];
        if (F32OUT) ((f32x4*)orow)[lane + 64 * j] = y;
        else { v2u w; w.x = pk2(y.x, y.y); w.y = pk2(y.z, y.w); ((v2u*)orow)[lane + 64 * j] = w; }
    }
}

#ifndef LN_PIPE
#define LN_PIPE 0
#endif
__device__ __forceinline__ void ln_ld(f32x4 (&v)[16], const float* xrow, int lane) {
    const unsigned vo = 16u * (unsigned)lane;
#pragma unroll
    for (int j = 0; j < 16; ++j) GLD128S(v[j], vo + 4096u * (j >> 2), xrow, 1024 * (j & 3));
}
#define LN_WAIT(N, v) asm volatile("s_waitcnt vmcnt(" #N ")" : "+v"(v[0]), "+v"(v[1]), "+v"(v[2]), "+v"(v[3]), "+v"(v[4]), "+v"(v[5]), "+v"(v[6]), "+v"(v[7]), "+v"(v[8]), "+v"(v[9]), "+v"(v[10]), "+v"(v[11]), "+v"(v[12]), "+v"(v[13]), "+v"(v[14]), "+v"(v[15]))
__device__ __forceinline__ void ln_fin(f32x4 (&v)[16], const LAS f32x4* gl, const LAS f32x4* bl, bf16* orow, int lane) {
    float s = 0.f;
#pragma unroll
    for (int j = 0; j < 16; ++j) s += (v[j].x + v[j].y) + (v[j].z + v[j].w);
    const float mean = wave_sum(s) * (1.f / DM); float s2 = 0.f;
#pragma unroll
    for (int j = 0; j < 16; ++j) { v[j] = v[j] - mean; s2 += (v[j].x * v[j].x + v[j].y * v[j].y) + (v[j].z * v[j].z + v[j].w * v[j].w); }
    const float rstd = 1.f / sqrtf(wave_sum(s2) * (1.f / DM) + LN_EPS);
    const unsigned ga = (unsigned)(size_t)gl + 16u * lane;
#pragma unroll
    for (int q = 0; q < 4; ++q) {
        f32x4 g4[4], b4[4];
#pragma unroll
        for (int j = 0; j < 4; ++j) { DS_RD128(g4[j], ga, 1024 * (4 * q + j)); DS_RD128(b4[j], ga, 16384 + 1024 * (4 * q + j)); }
        asm volatile("s_waitcnt lgkmcnt(0)" : "+v"(g4[0]), "+v"(g4[1]), "+v"(g4[2]), "+v"(g4[3]), "+v"(b4[0]), "+v"(b4[1]), "+v"(b4[2]), "+v"(b4[3]));
#pragma unroll
        for (int j = 0; j < 4; ++j) {
            const f32x4 y = v[4 * q + j] * rstd * g4[j] + b4[j];
            v2u w; w.x = pk2(y.x, y.y); w.y = pk2(y.z, y.w); ((v2u*)orow)[lane + 64 * (4 * q + j)] = w;
        }
    }
    (void)bl;
}
__device__ __forceinline__ void phase0(const Ctx& C) {
    LAS float* scr = (LAS float*)(C.lds + C.wave * 16384);
    const int gw = C.bid * NWAVES + C.wave, NGW = C.G * NWAVES;
    bf16* WinT = (bf16*)(C.ws + WS_WIN); bf16* WoT = (bf16*)(C.ws + WS_WO); bf16* XN = (bf16*)(C.ws + WS_XN);
    constexpr int I_IN = (DM / 64) * ((NIN + 31) / 32), I_O = (DM / 64) * (DM / 32);
    transpose_static<1>(inp(C, I_WIN), DM, NIN, WinT, I_IN, scr, gw, NGW, C.lane);
    (void)WoT; (void)I_O;
    for (int i = gw * 64 + C.lane; i < 144 * (LDX / 8); i += NGW * 64) ((v4u*)(WinT + (size_t)NIN * LDX))[i] = (v4u){0u, 0u, 0u, 0u};
#if defined(PROBE_DUP) && PROBE_DUP == 13
    transpose_static<1>(inp(C, I_WIN), DM, NIN, WinT, I_IN, scr, gw, NGW, C.lane);
#endif
#if LN_PIPE
    {
        __syncthreads();
        LAS f32x4* gl = (LAS f32x4*)C.lds; LAS f32x4* bl = gl + DM / 4;
        for (int i = C.tid; i < DM / 4; i += NWAVES * 64) { gl[i] = ((const f32x4*)inp(C, I_LNG))[i]; bl[i] = ((const f32x4*)inp(C, I_LNB))[i]; }
        __syncthreads();
        const float* xp = inp(C, I_XP); const float* xs = inp(C, I_XS);
        f32x4 va[16], vb[16];
        int m = gw;
        if (m < MTOK) {
            ln_ld(va, m < NPROW ? xp + (size_t)m * DM : xs + (size_t)(m - NPROW) * DM, C.lane);
            LN_WAIT(0, va);
#pragma unroll 1
            for (;;) {
                const int m1 = m + NGW, m1c = min(m1, MTOK - 1), m2 = m1 + NGW, m2c = min(m2, MTOK - 1);
                ln_ld(vb, m1c < NPROW ? xp + (size_t)m1c * DM : xs + (size_t)(m1c - NPROW) * DM, C.lane);
                LN_WAIT(32, va);
                ln_fin(va, gl, bl, XN + (size_t)m * LDX, C.lane);
                if (m1 >= MTOK) break;
                ln_ld(va, m2c < NPROW ? xp + (size_t)m2c * DM : xs + (size_t)(m2c - NPROW) * DM, C.lane);
                LN_WAIT(32, vb);
                ln_fin(vb, gl, bl, XN + (size_t)m1 * LDX, C.lane);
                if (m2 >= MTOK) break;
                m = m2;
            }
            asm volatile("s_waitcnt vmcnt(0)" ::: "memory");
        }
    }
#else
    LnP P; ln_params(P, inp(C, I_LNG), inp(C, I_LNB), C.lane);
#pragma unroll 1
    for (int m = gw; m < MTOK; m += NGW) {
        const float* xr = m < NPROW ? inp(C, I_XP) + (size_t)m * DM : inp(C, I_XS) + (size_t)(m - NPROW) * DM;
        ln_row<false>(xr, P, XN + (size_t)m * LDX, C.lane);
    }
#endif
#if defined(PROBE_DUP) && PROBE_DUP == 14
#pragma unroll 1
    for (int m = gw; m < MTOK; m += NGW) {
        const float* xr = m < NPROW ? inp(C, I_XP) + (size_t)m * DM : inp(C, I_XS) + (size_t)(m - NPROW) * DM;
        ln_row<false>(xr, P, XN + (size_t)m * LDX, C.lane);
    }
#endif
}

__device__ __forceinline__ void select_row(const Ctx& C, int row, int L, unsigned long long* msk, int lane) {
    const float* SC = C.out + OS_SC;
    if (L <= TOPK) { if (lane < 32) msk[lane] = (64 * lane < L) ? ~0ull : 0ull; return; }
    unsigned v[32];
    {
        const float* p0 = SC + (size_t)row * 2048 + lane; const float* p1 = p0 + 1024;
#pragma unroll
        for (int i = 0; i < 16; ++i) { GLD32(v[i], p0, i * 256); GLD32(v[16 + i], p1, i * 256); }
        asm volatile("s_waitcnt vmcnt(0)" : "+v"(v[0]), "+v"(v[1]), "+v"(v[2]), "+v"(v[3]), "+v"(v[4]), "+v"(v[5]), "+v"(v[6]), "+v"(v[7]), "+v"(v[8]), "+v"(v[9]), "+v"(v[10]), "+v"(v[11]), "+v"(v[12]), "+v"(v[13]), "+v"(v[14]), "+v"(v[15]));
        asm volatile("" : "+v"(v[16]), "+v"(v[17]), "+v"(v[18]), "+v"(v[19]), "+v"(v[20]), "+v"(v[21]), "+v"(v[22]), "+v"(v[23]), "+v"(v[24]), "+v"(v[25]), "+v"(v[26]), "+v"(v[27]), "+v"(v[28]), "+v"(v[29]), "+v"(v[30]), "+v"(v[31]));
        int Lr = L; asm volatile("" : "+s"(Lr));
#pragma unroll
        for (int i = 0; i < 32; ++i) { unsigned u = v[i]; u = (u & 0x80000000u) ? ~u : (u | 0x80000000u); v[i] = (lane + 64 * i < Lr) ? u : 0u; }
    }
    unsigned T = 0u;
    for (int bit = 31; bit >= 0; --bit) {
        const unsigned cand = T | (1u << bit); int cnt = 0;
#pragma unroll
        for (int i = 0; i < 32; ++i) cnt += __popcll(__ballot(v[i] >= cand));
        if (cnt >= TOPK) { T = cand; if (cnt == TOPK) break; }
    }
    int cgt = 0;
#pragma unroll
    for (int i = 0; i < 32; ++i) cgt += __popcll(__ballot(v[i] > T));
    const int need = TOPK - cgt;
    const unsigned long long ltm = (1ull << lane) - 1ull;
    int eqb = 0;
#pragma unroll
    for (int i = 0; i < 32; ++i) {
        const bool gt = v[i] > T, eq = v[i] == T;
        const unsigned long long eqm = __ballot(eq);
        const int myeq = eqb + __popcll(eqm & ltm);
        const unsigned long long sm = __ballot(gt || (eq && myeq < need));
        if (lane == 0) msk[i] = sm;
        eqb += __popcll(eqm);
    }
}
__device__ __forceinline__ float relu_i(float x) { const int b = __builtin_bit_cast(int, x); return __builtin_bit_cast(float, b > 0 ? b : 0); }
__device__ __forceinline__ float relu_f(float x) { return __builtin_amdgcn_fmed3f(x, 0.f, __builtin_inff()); }
template <bool DOSEL = true> __device__ __forceinline__ void idx_unit(const Ctx& C, int item) {
    bool prompt; int b, c;
    if (item < 120) { prompt = true; c = 31 - item / 8; b = item % 8; }
    else if (item < 152) { prompt = false; c = 0; b = item - 120; }
    else { prompt = true; const int j = item - 152; c = 16 - j / 8; b = j % 8; }
    const bf16* H = (const bf16*)(C.ws + WS_H);
    const float* SM = C.out + OS_SM; float* SC = C.out + OS_SC;
    const int row0 = prompt ? b * PSEQ + c * 64 : NPROW + b * SSEQ;
    const int nkt = prompt ? c + 1 : (PAST + SSEQ) / 64;
    int lane_ = C.lane; asm volatile("" : "+v"(lane_));
    const int lane = lane_, l15 = lane & 15, l4 = lane >> 4;
    LAS float* wl = (LAS float*)(C.lds + EPIW_OFF);
    LAS unsigned char* QL = C.lds;
    __syncthreads();
    for (int i = C.tid; i < 1024; i += NWAVES * 64) wl[i] = SM[(size_t)(row0 + (i >> 4)) * 128 + 64 + (i & 15)] * IDX_SCALE;
    {
        const bf16* qsrc = H + (size_t)(row0 + (C.tid >> 7)) * LDH + HIQ + (C.tid & 127) * 8;
        v4u qv[16];
#pragma unroll
        for (int k = 0; k < 16; ++k) qv[k] = *(const v4u*)(qsrc + (size_t)(4 * k) * LDH);
#pragma unroll
        for (int k = 0; k < 16; ++k) { const int row = (C.tid >> 7) + 4 * k, p = C.tid & 127; *(LAS v4u*)(QL + row * 2048 + ((p ^ (row & 15)) << 4)) = qv[k]; }
    }
    __syncthreads();
    const unsigned qrb = (unsigned)(size_t)QL + (unsigned)l15 * 2048u;
    const unsigned qlo00 = qrb + (unsigned)(((0 + l4) ^ l15) << 4), qlo01 = qrb + (unsigned)(((4 + l4) ^ l15) << 4), qlo10 = qrb + (unsigned)(((8 + l4) ^ l15) << 4), qlo11 = qrb + (unsigned)(((12 + l4) ^ l15) << 4);
#define IDX_QRD(dst, a0, a1) do { const unsigned b0_ = (a0) + 65536u, b1_ = (a1) + 65536u; \
        DS_RD128(dst[0][0], a0, 0); DS_RD128(dst[0][1], a1, 0); DS_RD128(dst[1][0], a0, 32768); DS_RD128(dst[1][1], a1, 32768); \
        DS_RD128(dst[2][0], b0_, 0); DS_RD128(dst[2][1], b1_, 0); DS_RD128(dst[3][0], b0_, 32768); DS_RD128(dst[3][1], b1_, 32768); } while (0)
#define IDX_QWAIT(f) asm volatile("s_waitcnt lgkmcnt(0)" : "+v"(f[0][0]), "+v"(f[0][1]), "+v"(f[1][0]), "+v"(f[1][1]), "+v"(f[2][0]), "+v"(f[2][1]), "+v"(f[3][0]), "+v"(f[3][1]))
#define IDX_HEAD(f, HH) do { float w[4]; \
        _Pragma("unroll") for (int qb = 0; qb < 4; ++qb) w[qb] = wl[(qb * 16 + l15) * 16 + (HH)]; \
        _Pragma("unroll") for (int kb = 0; kb < 4; ++kb) {     \
            f32x4 a[4]; \
            _Pragma("unroll") for (int qb = 0; qb < 4; ++qb) a[qb] = __builtin_amdgcn_mfma_f32_16x16x32_bf16(afr[kb][0], f[qb][0], (f32x4){0.f, 0.f, 0.f, 0.f}, 0, 0, 0); \
            _Pragma("unroll") for (int qb = 0; qb < 4; ++qb) a[qb] = __builtin_amdgcn_mfma_f32_16x16x32_bf16(afr[kb][1], f[qb][1], a[qb], 0, 0, 0); \
            __builtin_amdgcn_sched_barrier(0); \
            _Pragma("unroll") for (int qb = 0; qb < 4; ++qb) { const f32x4 av = a[qb]; \
                  \
                const f32x4 rv = (f32x4){relu_i(av[0]), relu_i(av[1]), relu_i(av[2]), relu_i(av[3])}; \
                idx[kb][qb] += rv * w[qb]; } \
            __builtin_amdgcn_sched_barrier(0); } } while (0)
    for (int kt = C.wave; kt < nkt; kt += NWAVES) {
        bf16x8 afr[4][2];
        if (prompt || kt == nkt - 1) {
            const int krow0 = prompt ? b * PSEQ + kt * 64 : NPROW + b * SSEQ;
#pragma unroll
            for (int kb = 0; kb < 4; ++kb)
#pragma unroll
                for (int ks = 0; ks < 2; ++ks) afr[kb][ks] = *(const bf16x8*)(H + (size_t)(krow0 + kb * 16 + l15) * LDH + HSM + ks * 32 + l4 * 8);
        } else {
            const float* ck = inp(C, I_CIK) + ((size_t)b * PAST + kt * 64) * 64;
#pragma unroll
            for (int kb = 0; kb < 4; ++kb)
#pragma unroll
                for (int ks = 0; ks < 2; ++ks) {
                    const f32x4* p = (const f32x4*)(ck + (size_t)(kb * 16 + l15) * 64 + ks * 32 + l4 * 8);
                    const f32x4 x0 = p[0], x1 = p[1]; v4u w; w.x = pk2(x0.x, x0.y); w.y = pk2(x0.z, x0.w); w.z = pk2(x1.x, x1.y); w.w = pk2(x1.z, x1.w);
                    afr[kb][ks] = __builtin_bit_cast(bf16x8, w);
                }
        }
        f32x4 idx[4][4];
#pragma unroll
        for (int kb = 0; kb < 4; ++kb)
#pragma unroll
            for (int qb = 0; qb < 4; ++qb) idx[kb][qb] = (f32x4){0.f, 0.f, 0.f, 0.f};
        bf16x8 bfr[4][2], bnx[4][2];
        IDX_QRD(bfr, qlo00, qlo01); IDX_QWAIT(bfr);
#pragma unroll 1
        for (int hp = 0; hp < 8; ++hp) {
            const unsigned ho = (unsigned)hp * 256u, hn = (unsigned)(hp < 7 ? hp + 1 : 7) * 256u;
            IDX_QRD(bnx, qlo10 + ho, qlo11 + ho);
            __builtin_amdgcn_sched_barrier(0);
            IDX_HEAD(bfr, 2 * hp);
            __builtin_amdgcn_sched_barrier(0);
            IDX_QWAIT(bnx);
            IDX_QRD(bfr, qlo00 + hn, qlo01 + hn);
            __builtin_amdgcn_sched_barrier(0);
            IDX_HEAD(bnx, 2 * hp + 1);
            __builtin_amdgcn_sched_barrier(0);
            IDX_QWAIT(bfr);
        }
#pragma unroll
        for (int kb = 0; kb < 4; ++kb)
#pragma unroll
            for (int qb = 0; qb < 4; ++qb)
                *(f32x4*)(SC + (size_t)(row0 + qb * 16 + l15) * 2048 + kt * 64 + kb * 16 + l4 * 4) = idx[kb][qb];
    }
#undef IDX_QRD
#undef IDX_QWAIT
#undef IDX_HEAD
    __syncthreads();
    if (DOSEL) {
        unsigned long long* MG = (unsigned long long*)(C.out + OS_MSK);
        const int Lq = prompt ? (c + 1) * 64 : SLEN;
#pragma unroll 1
        for (int j = 0; j < 8; ++j) { const int row = row0 + C.wave * 8 + j; select_row(C, row, Lq, MG + (size_t)row * 32, lane); }
    }
}
__device__ __forceinline__ void prep_unit(const Ctx& C, int tb) {
    const bf16* H = (const bf16*)(C.ws + WS_H); bf16* QKVC = (bf16*)(C.ws + WS_QKVC);
    const int R0 = tb * 16; const bool prompt = R0 < NPROW; const int r2 = R0 - NPROW;
    const int b = prompt ? (R0 >> 11) : (r2 >> 6), t0 = prompt ? (R0 & 2047) : (r2 & 63);
    const float* cw = inp(C, I_CQW); const float* cb = inp(C, I_CQB); const float* st = inp(C, I_SCONV);
    for (int seg = C.wave; seg < 48; seg += NWAVES) {
        const int c = seg * 128 + 2 * C.lane;
        const f32x2 w0 = *(const f32x2*)(cw + c), w1 = *(const f32x2*)(cw + CQKV + c), w2 = *(const f32x2*)(cw + 2 * CQKV + c), w3 = *(const f32x2*)(cw + 3 * CQKV + c), bi = *(const f32x2*)(cb + c);
        f32x2 xm3, xm2, xm1;
        if (t0 > 0) {
            const unsigned a = *(const unsigned*)(H + (size_t)(R0 - 3) * LDH + HQKV + c), bq = *(const unsigned*)(H + (size_t)(R0 - 2) * LDH + HQKV + c), cq = *(const unsigned*)(H + (size_t)(R0 - 1) * LDH + HQKV + c);
            xm3 = (f32x2){bflo(a), bfhi(a)}; xm2 = (f32x2){bflo(bq), bfhi(bq)}; xm1 = (f32x2){bflo(cq), bfhi(cq)};
        } else if (prompt) { xm3 = xm2 = xm1 = (f32x2){0.f, 0.f}; }
        else { xm3 = *(const f32x2*)(st + (size_t)(b * 3 + 0) * CQKV + c); xm2 = *(const f32x2*)(st + (size_t)(b * 3 + 1) * CQKV + c); xm1 = *(const f32x2*)(st + (size_t)(b * 3 + 2) * CQKV + c); }
        const float post = seg < 16 ? QSCALE : 1.f;
#pragma unroll 4
        for (int i = 0; i < 16; ++i) {
            const unsigned xw = *(const unsigned*)(H + (size_t)(R0 + i) * LDH + HQKV + c);
            const f32x2 x0 = (f32x2){bflo(xw), bfhi(xw)};
            f32x2 y = bi + w0 * xm3 + w1 * xm2 + w2 * xm1 + w3 * x0;
            y.x = silu_f(y.x); y.y = silu_f(y.y);
            if (seg < 32) { const float ss = wave_sum(y.x * y.x + y.y * y.y); const float sc = post / sqrtf(ss + 1e-6f); y.x *= sc; y.y *= sc; }
            *(unsigned*)(QKVC + (size_t)(R0 + i) * CQKV + c) = pk2(y.x, y.y);
            xm3 = xm2; xm2 = xm1; xm1 = x0;
        }
    }
}

constexpr int DCH = 32;
__device__ __forceinline__ void delta_unit(const Ctx& C, int item) {
    const bool prompt = item < 128; const int j2 = item - 128;
    const int b = prompt ? item >> 4 : j2 >> 4, h = item & 15;
    const int T = prompt ? PSEQ : SSEQ, rowbase = prompt ? b * PSEQ : NPROW + b * SSEQ;
    const bf16* H = (const bf16*)(C.ws + WS_H); const bf16* QKVC = (const bf16*)(C.ws + WS_QKVC); bf16* CAT = (bf16*)(C.ws + WS_CAT);
    const float* SM = C.out + OS_SM;
    LAS float* qs = (LAS float*)(C.lds + 16384);
    LAS float* ks = qs + DCH * 128;
    LAS float* vs = ks + DCH * 128;
    LAS float* os = vs + DCH * 128;
    LAS float* xch = os + DCH * 128;
    LAS float* sc = xch + 2 * 4 * 128 * 2;
    int tid_ = C.tid; asm volatile("" : "+v"(tid_));
    const int tid = tid_, e = tid & 127, part = __builtin_amdgcn_readfirstlane(tid >> 7), lane = tid & 63, wave = __builtin_amdgcn_readfirstlane(tid >> 6);
    float S[32];
    if (prompt) {
#pragma unroll
        for (int i = 0; i < 32; ++i) S[i] = 0.f;
    } else {
        const float* s0 = inp(C, I_SDELTA) + ((size_t)(b * 16 + h) * 128 + part * 32) * 128 + e;
#pragma unroll
        for (int i = 0; i < 32; ++i) S[i] = s0[(size_t)i * 128];
    }
    const float Aexp = expf(inp(C, I_ALOG)[h]), dtb = inp(C, I_DTB)[h];
    const f32x2 gn = *(const f32x2*)(inp(C, I_DNG) + 2 * lane);
    for (int c0 = 0; c0 < T; c0 += DCH) {
        __syncthreads();
        for (int idx = tid; idx < DCH * 192; idx += NWAVES * 64) {
            const int r = idx / 192, p = idx % 192, which = p >> 6, pp = p & 63;
            const unsigned w = *(const unsigned*)(QKVC + (size_t)(rowbase + c0 + r) * CQKV + which * 2048 + h * 128 + 2 * pp);
            LAS float* dst = (which == 0 ? qs : which == 1 ? ks : vs) + r * 128 + 2 * pp;
            dst[0] = bflo(w); dst[1] = bfhi(w);
        }
        if (tid < DCH) {
            const size_t row = (size_t)(rowbase + c0 + tid);
            const float a_in = SM[row * 128 + 96 + h], b_in = SM[row * 128 + 80 + h];
            const float x = a_in + dtb; const float sp = x > 20.f ? x : log1pf(expf(x));
            sc[tid * 4 + 0] = expf(-Aexp * sp); sc[tid * 4 + 1] = 1.f / (1.f + expf(-b_in));
        }
        __syncthreads();
        for (int r = wave; r < DCH; r += NWAVES) {
            const float d = qs[r * 128 + 2 * lane] * ks[r * 128 + 2 * lane] + qs[r * 128 + 2 * lane + 1] * ks[r * 128 + 2 * lane + 1];
            const float s = wave_sum(d); if (lane == 0) sc[r * 4 + 2] = s;
        }
        __syncthreads();
        for (int t = 0; t < DCH; ++t) {
            const LAS float* kt = ks + t * 128 + part * 32; const LAS float* qt = qs + t * 128 + part * 32;
            float kreg[32]; float pk = 0.f, pq = 0.f;
#pragma unroll
            for (int i = 0; i < 32; ++i) { kreg[i] = kt[i]; pk += kreg[i] * S[i]; pq += qt[i] * S[i]; }
            LAS f32x2* xb = (LAS f32x2*)xch + (t & 1) * 512;
            xb[part * 128 + e] = (f32x2){pk, pq};
            __syncthreads();
            const f32x2 x0 = xb[e], x1 = xb[128 + e], x2 = xb[256 + e], x3 = xb[384 + e];
            const float kS = (x0.x + x1.x) + (x2.x + x3.x), qS = (x0.y + x1.y) + (x2.y + x3.y);
            const float eg = sc[t * 4 + 0], beta = sc[t * 4 + 1], qk = sc[t * 4 + 2];
            const float vn = beta * (vs[t * 128 + e] - eg * kS);
            const float o = eg * qS + qk * vn;
#pragma unroll
            for (int i = 0; i < 32; ++i) S[i] = eg * S[i] + kreg[i] * vn;
            if (part == 0) os[t * 128 + e] = o;
        }
        __syncthreads();
        for (int r = wave; r < DCH; r += NWAVES) {
            const size_t row = (size_t)(rowbase + c0 + r);
            const float o0 = os[r * 128 + 2 * lane], o1 = os[r * 128 + 2 * lane + 1];
            const float ss = wave_sum(o0 * o0 + o1 * o1);
            const float rs = 1.f / sqrtf(ss * (1.f / 128.f) + LN_EPS);
            const unsigned zw = *(const unsigned*)(H + row * LDH + HZ + h * 128 + 2 * lane);
            const float y0 = o0 * rs * gn.x * silu_f(bflo(zw)), y1 = o1 * rs * gn.y * silu_f(bfhi(zw));
            *(unsigned*)(CAT + row * DM + 2048 + h * 128 + 2 * lane) = pk2(y0, y1);
        }
    }
    float* so = C.out + (prompt ? O_PDELTA : O_SDELTA) + ((size_t)(b * 16 + h) * 128 + part * 32) * 128 + e;
#pragma unroll
    for (int i = 0; i < 32; ++i) so[(size_t)i * 128] = S[i];
    __syncthreads();
}

__device__ __forceinline__ void vt_item(const Ctx& C, int item) {
    const bf16* H = (const bf16*)(C.ws + WS_H);
    LAS unsigned char* scr = C.lds + C.wave * 16384;
    int lane_ = C.lane; asm volatile("" : "+v"(lane_)); const int lane = lane_;
    bool prompt; int b, n, kt;
    if (item < NPB * 4 * 32) { prompt = true; b = item >> 7; n = (item >> 5) & 3; kt = item & 31; }
    else { prompt = false; const int j = item - NPB * 4 * 32; b = j / 68; n = (j % 68) / 17; kt = j % 17; }
    if (prompt || kt == 16) {
        const bf16* src = H + (size_t)(prompt ? b * PSEQ + kt * 64 + lane : NPROW + b * SSEQ + lane) * LDH + HV + n * 128;
#pragma unroll
        for (int c = 0; c < 16; ++c) *(LAS v4u*)(scr + lane * 256 + c * 16) = *(const v4u*)(src + c * 8);
    } else {
        const float* src = inp(C, I_CV) + ((size_t)(b * PAST + kt * 64 + lane) * 4 + n) * 128;
#pragma unroll
        for (int c = 0; c < 16; ++c) { const f32x4 x0 = *(const f32x4*)(src + c * 8), x1 = *(const f32x4*)(src + c * 8 + 4);
            v4u w; w.x = pk2(x0.x, x0.y); w.y = pk2(x0.z, x0.w); w.z = pk2(x1.x, x1.y); w.w = pk2(x1.z, x1.w); *(LAS v4u*)(scr + lane * 256 + c * 16) = w; }
    }
    LDS_WAIT(); asm volatile("" ::: "memory");
    bf16* VT = (bf16*)(C.out + (prompt ? OS_VTP : OS_VTS));
    const int ntile = prompt ? PSEQ / 64 : SLEN / 64;
#pragma unroll 4
    for (int c = 0; c < 16; ++c) {
        const int cid = lane + 64 * c, d = cid >> 3, kc = cid & 7;
        const LAS unsigned short* s = (const LAS unsigned short*)(scr + (kc * 8) * 256 + d * 2);
        v4u w;
        w.x = (unsigned)s[0 * 128] | ((unsigned)s[1 * 128] << 16); w.y = (unsigned)s[2 * 128] | ((unsigned)s[3 * 128] << 16);
        w.z = (unsigned)s[4 * 128] | ((unsigned)s[5 * 128] << 16); w.w = (unsigned)s[6 * 128] | ((unsigned)s[7 * 128] << 16);
        *(v4u*)(VT + ((size_t)(((b * 4 + n) * ntile + kt) * 128 + d)) * 64 + kc * 8) = w;
    }
    LDS_WAIT(); asm volatile("" ::: "memory");
}

typedef float f32x16 __attribute__((ext_vector_type(16)));
constexpr int A_LUT = 0, A_MSK = 16384, A_KS = 32768, A_VS = A_KS + 64 * 272, A_BUF = 2 * 64 * 272, A_END = A_KS + 2 * A_BUF;
static_assert(A_END <= RING_BYTES, "attention LDS map");
constexpr float LOG2E = 1.4426950408889634f;
__device__ __forceinline__ int t5_bucket(int rel) {
    const int n = rel < 0 ? -rel : rel; int bk;
    if (n < 8) bk = n; else bk = n < 12 ? 8 : n < 16 ? 9 : n < 23 ? 10 : n < 32 ? 11 : n < 46 ? 12 : n < 64 ? 13 : n < 91 ? 14 : 15;
    return (rel > 0 ? 16 : 0) + bk;
}
__device__ __forceinline__ void attn_lut(const Ctx& C) {
    LAS float* lut = (LAS float*)(C.lds + A_LUT);
    for (int i = C.tid; i < 16 * 256; i += NWAVES * 64) { const int head = i >> 8, rel = (i & 255) - 191; lut[i] = inp(C, I_RELB)[t5_bucket(rel) * 16 + head] * LOG2E; }
}
__device__ __forceinline__ float max3f(float a, float b, float c) { float r; asm("v_max3_f32 %0, %1, %2, %3" : "=v"(r) : "v"(a), "v"(b), "v"(c)); return r; }
#ifndef ATT_PP
#define ATT_PP 1
#endif
#if !ATT_PP
__device__ __forceinline__ void attn_unit_seq(const Ctx& C, int item) {
    bool prompt; int b, c, n;
    if (item < 480) { prompt = true; c = 31 - (item >> 5); b = (item & 31) >> 2; n = item & 3; }
    else if (item < 608) { prompt = false; c = 0; const int j = item - 480; b = j >> 2; n = j & 3; }
    else { prompt = true; const int j = item - 608; c = 16 - (j >> 5); b = (j & 31) >> 2; n = j & 3; }
    const bf16* H = (const bf16*)(C.ws + WS_H); bf16* CAT = (bf16*)(C.ws + WS_CAT);
    int tid_ = C.tid; asm volatile("" : "+v"(tid_));
    const int tid = tid_, lane = tid & 63, wave = __builtin_amdgcn_readfirstlane(tid >> 6);
    const int row0 = prompt ? b * PSEQ + c * 64 : NPROW + b * SSEQ;
    const int past = prompt ? 0 : PAST, t0 = prompt ? c * 64 : 0;
    const int L = prompt ? (c + 1) * 64 : SLEN, nkt = L / 64;
    const int ntile = prompt ? PSEQ / 64 : SLEN / 64;
    LAS unsigned long long* MSK = (LAS unsigned long long*)(C.lds + A_MSK);
    LAS unsigned char* KS = C.lds + A_KS; LAS unsigned char* VS = C.lds + A_VS;
    const LAS float* LUT = (const LAS float*)(C.lds + A_LUT);
    __syncthreads();
    {
        const v4u* mg = (const v4u*)(C.out + OS_MSK + (size_t)row0 * 64);
        ((LAS v4u*)MSK)[tid] = mg[tid]; ((LAS v4u*)MSK)[tid + 512] = mg[tid + 512];
    }
    const int g = wave & 3, qh = wave >> 2, h = lane >> 5, l31 = lane & 31;
    const int ql = qh * 32 + l31, qpos = past + t0 + ql, qpos_min = past + t0 + qh * 32;
    const float SC2 = QSCALE * LOG2E;
    const int head = n * 4 + g;
    bf16x8 qf[8];
#pragma unroll
    for (int s = 0; s < 8; ++s) qf[s] = *(const bf16x8*)(H + (size_t)(row0 + ql) * LDH + HQ + head * 128 + 16 * s + 8 * h);
    f32x16 oacc[4];
#pragma unroll
    for (int db = 0; db < 4; ++db)
#pragma unroll
        for (int r = 0; r < 16; ++r) oacc[db][r] = 0.f;
    float m_run = -INFINITY, l_run = 0.f;
    const float bfar = inp(C, I_RELB)[15 * 16 + head] * LOG2E;
    const LAS float* lut = LUT + head * 256;
    v4u kreg[2], vreg[2];
    const unsigned koffH0 = (unsigned)(tid >> 4) * LDH + (unsigned)(tid & 15) * 8u, koffH1 = koffH0 + 32u * LDH;
    const unsigned koffC0 = (unsigned)(tid >> 4) * 512u + (unsigned)(tid & 15) * 8u, koffC1 = koffC0 + 32u * 512u;
#define ATT_LOAD(KT) do { const int kt_ = (KT); \
        if (prompt || kt_ == 16) { const bf16* kb_ = H + (size_t)(prompt ? b * PSEQ + kt_ * 64 : NPROW + b * SSEQ) * LDH + HK + n * 128; kreg[0] = *(const v4u*)(kb_ + koffH0); kreg[1] = *(const v4u*)(kb_ + koffH1); } \
        else { const float* cb_ = inp(C, I_CK) + ((size_t)(b * PAST + kt_ * 64) * 4 + n) * 128; \
               const f32x4 x0 = *(const f32x4*)(cb_ + koffC0), x1 = *(const f32x4*)(cb_ + koffC0 + 4), y0 = *(const f32x4*)(cb_ + koffC1), y1 = *(const f32x4*)(cb_ + koffC1 + 4); \
               kreg[0].x = pk2(x0.x, x0.y); kreg[0].y = pk2(x0.z, x0.w); kreg[0].z = pk2(x1.x, x1.y); kreg[0].w = pk2(x1.z, x1.w); \
               kreg[1].x = pk2(y0.x, y0.y); kreg[1].y = pk2(y0.z, y0.w); kreg[1].z = pk2(y1.x, y1.y); kreg[1].w = pk2(y1.z, y1.w); } \
        if (prompt || kt_ == 16) { const bf16* vb_ = H + (size_t)(prompt ? b * PSEQ + kt_ * 64 : NPROW + b * SSEQ) * LDH + HV + n * 128; vreg[0] = *(const v4u*)(vb_ + koffH0); vreg[1] = *(const v4u*)(vb_ + koffH1); } \
        else { const float* cb_ = inp(C, I_CV) + ((size_t)(b * PAST + kt_ * 64) * 4 + n) * 128; \
               const f32x4 x0 = *(const f32x4*)(cb_ + koffC0), x1 = *(const f32x4*)(cb_ + koffC0 + 4), y0 = *(const f32x4*)(cb_ + koffC1), y1 = *(const f32x4*)(cb_ + koffC1 + 4); \
               vreg[0].x = pk2(x0.x, x0.y); vreg[0].y = pk2(x0.z, x0.w); vreg[0].z = pk2(x1.x, x1.y); vreg[0].w = pk2(x1.z, x1.w); \
               vreg[1].x = pk2(y0.x, y0.y); vreg[1].y = pk2(y0.z, y0.w); vreg[1].z = pk2(y1.x, y1.y); vreg[1].w = pk2(y1.z, y1.w); } } while (0)
    ATT_LOAD(0);
#pragma unroll 1
    for (int kt = 0; kt < nkt; ++kt) {
        __syncthreads();
#pragma unroll
        for (int i = 0; i < 2; ++i) { const int cid = tid + 512 * i;
            *(LAS v4u*)(KS + (cid >> 4) * 272 + (cid & 15) * 16) = kreg[i];
            *(LAS v4u*)(VS + (cid >> 4) * 272 + (cid & 15) * 16) = vreg[i]; }
        __syncthreads();
        if (kt + 1 < nkt) ATT_LOAD(kt + 1);
        f32x16 s0, s1;
#pragma unroll
        for (int r = 0; r < 16; ++r) { s0[r] = 0.f; s1[r] = 0.f; }
        {
            const unsigned kaddr = (unsigned)(size_t)(KS + l31 * 272 + 16 * h);
            asm volatile("" ::: "memory");
#pragma unroll
            for (int s4 = 0; s4 < 2; ++s4) {
                bf16x8 kA[4], kB[4];
#pragma unroll
                for (int s = 0; s < 4; ++s) { DS_RD128(kA[s], kaddr, 32 * (4 * s4 + s)); DS_RD128(kB[s], kaddr, 32 * 272 + 32 * (4 * s4 + s)); }
                asm volatile("s_waitcnt lgkmcnt(0)" : "+v"(kA[0]), "+v"(kA[1]), "+v"(kA[2]), "+v"(kA[3]), "+v"(kB[0]), "+v"(kB[1]), "+v"(kB[2]), "+v"(kB[3]));
#pragma unroll
                for (int s = 0; s < 4; ++s) {
                    s0 = __builtin_amdgcn_mfma_f32_32x32x16_bf16(kA[s], qf[4 * s4 + s], s0, 0, 0, 0);
                    s1 = __builtin_amdgcn_mfma_f32_32x32x16_bf16(kB[s], qf[4 * s4 + s], s1, 0, 0, 0);
                }
            }
        }
        asm volatile("s_nop 7\n\ts_nop 7\n\ts_nop 3" : "+v"(s0), "+v"(s1));
        const unsigned long long mw = MSK[ql * 32 + kt];
        const unsigned wlo = (unsigned)mw >> (4 * h), whi = (unsigned)(mw >> 32) >> (4 * h);
        const bool far = (kt * 64 + 63 - qpos_min) <= -91;
        float mx;
        if (far) {
            float a = max3f(s0[0], s0[1], s0[2]), bq = max3f(s1[0], s1[1], s1[2]);
#pragma unroll
            for (int r = 3; r < 15; r += 2) { a = max3f(a, s0[r], s0[r + 1]); bq = max3f(bq, s1[r], s1[r + 1]); }
            mx = fmaf(max3f(a, bq, fmaxf(s0[15], s1[15])), SC2, bfar);
        } else {
            const int relb0 = kt * 64 + 4 * h - qpos + 191;
#pragma unroll
            for (int r = 0; r < 16; ++r) { const int cr = (r & 3) + 8 * (r >> 2);
                s0[r] = fmaf(s0[r], SC2, lut[relb0 + cr]); s1[r] = fmaf(s1[r], SC2, lut[relb0 + 32 + cr]); }
            float a = max3f(s0[0], s0[1], s0[2]), bq = max3f(s1[0], s1[1], s1[2]);
#pragma unroll
            for (int r = 3; r < 15; r += 2) { a = max3f(a, s0[r], s0[r + 1]); bq = max3f(bq, s1[r], s1[r + 1]); }
            mx = max3f(a, bq, fmaxf(s0[15], s1[15]));
        }
        mx = fmaxf(mx, __shfl_xor(mx, 32));
        const float m_new = fmaxf(m_run, mx);
        if (__any(m_new != m_run)) {
            const float alpha = __builtin_amdgcn_exp2f(m_run - m_new);
            l_run *= alpha;
#pragma unroll
            for (int db = 0; db < 4; ++db)
#pragma unroll
                for (int r = 0; r < 16; ++r) oacc[db][r] *= alpha;
        }
        m_run = m_new;
        const float sc = far ? SC2 : 1.f, sb = far ? bfar - m_new : -m_new;
        float psum = 0.f;
#pragma unroll
        for (int r = 0; r < 16; ++r) { const int cr = (r & 3) + 8 * (r >> 2);
            const float p0 = __builtin_amdgcn_exp2f(fmaf(s0[r], sc, sb)), p1 = __builtin_amdgcn_exp2f(fmaf(s1[r], sc, sb));
            unsigned m0, m1;
            asm("v_bfe_i32 %0, %1, %c2, 1" : "=v"(m0) : "v"(wlo), "i"(cr)); asm("v_bfe_i32 %0, %1, %c2, 1" : "=v"(m1) : "v"(whi), "i"(cr));
            s0[r] = __uint_as_float(__float_as_uint(p0) & m0); s1[r] = __uint_as_float(__float_as_uint(p1) & m1);
            psum += s0[r] + s1[r]; }
        l_run += psum;
        bf16x8 pb[2][2];
#pragma unroll
        for (int s = 0; s < 2; ++s) {
            v4u w0, w1;
            w0.x = pk2(s0[8 * s + 0], s0[8 * s + 1]); w0.y = pk2(s0[8 * s + 2], s0[8 * s + 3]); w0.z = pk2(s0[8 * s + 4], s0[8 * s + 5]); w0.w = pk2(s0[8 * s + 6], s0[8 * s + 7]);
            w1.x = pk2(s1[8 * s + 0], s1[8 * s + 1]); w1.y = pk2(s1[8 * s + 2], s1[8 * s + 3]); w1.z = pk2(s1[8 * s + 4], s1[8 * s + 5]); w1.w = pk2(s1[8 * s + 6], s1[8 * s + 7]);
            pb[0][s] = __builtin_bit_cast(bf16x8, w0); pb[1][s] = __builtin_bit_cast(bf16x8, w1);
        }
        {
            const unsigned vaddr = (unsigned)(size_t)(VS + (4 * h + ((lane & 15) >> 2)) * 272 + (16 * ((lane >> 4) & 1) + 4 * (lane & 3)) * 2);
#pragma unroll
            for (int d2 = 0; d2 < 2; ++d2) {
                v2u vlo[8], vhi[8];
#pragma unroll
                for (int dd = 0; dd < 2; ++dd)
#pragma unroll
                    for (int ks = 0; ks < 4; ++ks) { DS_RDTR(vlo[dd * 4 + ks], vaddr, ks * 4352 + (2 * d2 + dd) * 64); DS_RDTR(vhi[dd * 4 + ks], vaddr, ks * 4352 + 2176 + (2 * d2 + dd) * 64); }
                asm volatile("s_waitcnt lgkmcnt(0)" : "+v"(vlo[0]), "+v"(vlo[1]), "+v"(vlo[2]), "+v"(vlo[3]), "+v"(vlo[4]), "+v"(vlo[5]), "+v"(vlo[6]), "+v"(vlo[7]),
                                                      "+v"(vhi[0]), "+v"(vhi[1]), "+v"(vhi[2]), "+v"(vhi[3]), "+v"(vhi[4]), "+v"(vhi[5]), "+v"(vhi[6]), "+v"(vhi[7]));
#pragma unroll
                for (int dd = 0; dd < 2; ++dd)
#pragma unroll
                    for (int ks = 0; ks < 4; ++ks) {
                        const bf16x8 a = __builtin_bit_cast(bf16x8, (v4u){vlo[dd * 4 + ks].x, vlo[dd * 4 + ks].y, vhi[dd * 4 + ks].x, vhi[dd * 4 + ks].y});
                        oacc[2 * d2 + dd] = __builtin_amdgcn_mfma_f32_32x32x16_bf16(a, pb[ks >> 1][ks & 1], oacc[2 * d2 + dd], 0, 0, 0);
                    }
            }
        }
    }
#undef ATT_LOAD
    const float inv = 1.f / (l_run + __shfl_xor(l_run, 32));
    bf16* op = CAT + (size_t)(row0 + ql) * DM + head * 128 + 4 * h;
#pragma unroll
    for (int db = 0; db < 4; ++db)
#pragma unroll
        for (int q4 = 0; q4 < 4; ++q4) {
#if MIX_FP8
            *(unsigned*)((unsigned char*)CAT + (size_t)(row0 + ql) * DM + head * 128 + 4 * h + 32 * db + 8 * q4) = pk4_fp8(oacc[db][4 * q4 + 0] * (inv * CAT_Q), oacc[db][4 * q4 + 1] * (inv * CAT_Q), oacc[db][4 * q4 + 2] * (inv * CAT_Q), oacc[db][4 * q4 + 3] * (inv * CAT_Q));
#else
            v2u w; w.x = pk2(oacc[db][4 * q4 + 0] * inv, oacc[db][4 * q4 + 1] * inv); w.y = pk2(oacc[db][4 * q4 + 2] * inv, oacc[db][4 * q4 + 3] * inv);
            *(v2u*)(op + 32 * db + 8 * q4) = w;
#endif
        }
}
#define attn_unit attn_unit_seq
#else
__device__ __forceinline__ void attn_unit(const Ctx& C, int item) {
    bool prompt; int b, c, n;
    if (item < 480) { prompt = true; c = 31 - (item >> 5); b = (item & 31) >> 2; n = item & 3; }
    else if (item < 608) { prompt = false; c = 0; const int j = item - 480; b = j >> 2; n = j & 3; }
    else { prompt = true; const int j = item - 608; c = 16 - (j >> 5); b = (j & 31) >> 2; n = j & 3; }
    const bf16* H = (const bf16*)(C.ws + WS_H); bf16* CAT = (bf16*)(C.ws + WS_CAT);
    int tid_ = C.tid; asm volatile("" : "+v"(tid_));
    const int tid = tid_, lane = tid & 63, wave = __builtin_amdgcn_readfirstlane(tid >> 6);
    const int row0 = prompt ? b * PSEQ + c * 64 : NPROW + b * SSEQ;
    const int past = prompt ? 0 : PAST, t0 = prompt ? c * 64 : 0;
    const int L = prompt ? (c + 1) * 64 : SLEN, nkt = L / 64;
    const int ntile = prompt ? PSEQ / 64 : SLEN / 64;
    LAS unsigned long long* MSK = (LAS unsigned long long*)(C.lds + A_MSK);
    LAS unsigned char* KS = C.lds + A_KS; LAS unsigned char* VS = C.lds + A_VS;
    const LAS float* LUT = (const LAS float*)(C.lds + A_LUT);
    __syncthreads();
    {
        const v4u* mg = (const v4u*)(C.out + OS_MSK + (size_t)row0 * 64);
        ((LAS v4u*)MSK)[tid] = mg[tid]; ((LAS v4u*)MSK)[tid + 512] = mg[tid + 512];
    }
    const int g = wave & 3, qh = wave >> 2, h = lane >> 5, l31 = lane & 31;
    const int ql = qh * 32 + l31, qpos = past + t0 + ql, qpos_min = past + t0 + qh * 32;
    const float SC2 = QSCALE * LOG2E;
    const int head = n * 4 + g;
    bf16x8 qf[8];
#pragma unroll
    for (int s = 0; s < 8; ++s) qf[s] = *(const bf16x8*)(H + (size_t)(row0 + ql) * LDH + HQ + head * 128 + 16 * s + 8 * h);
    f32x16 oacc[4];
#pragma unroll
    for (int db = 0; db < 4; ++db)
#pragma unroll
        for (int r = 0; r < 16; ++r) oacc[db][r] = 0.f;
    float m_run = -INFINITY, l_run = 0.f;
    const float bfar = inp(C, I_RELB)[15 * 16 + head] * LOG2E;
    const LAS float* lut = LUT + head * 256;
    v4u kreg[2], vreg[2];
    const unsigned koffH0 = (unsigned)(tid >> 4) * LDH + (unsigned)(tid & 15) * 8u, koffH1 = koffH0 + 32u * LDH;
    const unsigned koffC0 = (unsigned)(tid >> 4) * 512u + (unsigned)(tid & 15) * 8u, koffC1 = koffC0 + 32u * 512u;
#define ATT_LOADK(KT) do { const int kt_ = (KT); \
        if (prompt || kt_ == 16) { const bf16* kb_ = H + (size_t)(prompt ? b * PSEQ + kt_ * 64 : NPROW + b * SSEQ) * LDH + HK + n * 128; kreg[0] = *(const v4u*)(kb_ + koffH0); kreg[1] = *(const v4u*)(kb_ + koffH1); } \
        else { const float* cb_ = inp(C, I_CK) + ((size_t)(b * PAST + kt_ * 64) * 4 + n) * 128; \
               const f32x4 x0 = *(const f32x4*)(cb_ + koffC0), x1 = *(const f32x4*)(cb_ + koffC0 + 4), y0 = *(const f32x4*)(cb_ + koffC1), y1 = *(const f32x4*)(cb_ + koffC1 + 4); \
               kreg[0].x = pk2(x0.x, x0.y); kreg[0].y = pk2(x0.z, x0.w); kreg[0].z = pk2(x1.x, x1.y); kreg[0].w = pk2(x1.z, x1.w); \
               kreg[1].x = pk2(y0.x, y0.y); kreg[1].y = pk2(y0.z, y0.w); kreg[1].z = pk2(y1.x, y1.y); kreg[1].w = pk2(y1.z, y1.w); } } while (0)
#define ATT_LOADV(KT) do { const int kt_ = (KT); \
        if (prompt || kt_ == 16) { const bf16* vb_ = H + (size_t)(prompt ? b * PSEQ + kt_ * 64 : NPROW + b * SSEQ) * LDH + HV + n * 128; vreg[0] = *(const v4u*)(vb_ + koffH0); vreg[1] = *(const v4u*)(vb_ + koffH1); } \
        else { const float* cb_ = inp(C, I_CV) + ((size_t)(b * PAST + kt_ * 64) * 4 + n) * 128; \
               const f32x4 x0 = *(const f32x4*)(cb_ + koffC0), x1 = *(const f32x4*)(cb_ + koffC0 + 4), y0 = *(const f32x4*)(cb_ + koffC1), y1 = *(const f32x4*)(cb_ + koffC1 + 4); \
               vreg[0].x = pk2(x0.x, x0.y); vreg[0].y = pk2(x0.z, x0.w); vreg[0].z = pk2(x1.x, x1.y); vreg[0].w = pk2(x1.z, x1.w); \
               vreg[1].x = pk2(y0.x, y0.y); vreg[1].y = pk2(y0.z, y0.w); vreg[1].z = pk2(y1.x, y1.y); vreg[1].w = pk2(y1.z, y1.w); } } while (0)
    f32x16 s0, s1; bf16x8 pb[2][2];
    auto STK = [&](const int slot) __attribute__((always_inline)) {
#pragma unroll
        for (int i = 0; i < 2; ++i) { const int cid = tid + 512 * i; *(LAS v4u*)(KS + slot * A_BUF + (cid >> 4) * 272 + (cid & 15) * 16) = kreg[i]; } };
    auto STV = [&](const int slot) __attribute__((always_inline)) {
#pragma unroll
        for (int i = 0; i < 2; ++i) { const int cid = tid + 512 * i; *(LAS v4u*)(VS + slot * A_BUF + (cid >> 4) * 272 + (cid & 15) * 16) = vreg[i]; } };
    auto QK = [&](const int kt) __attribute__((always_inline)) {
        LAS unsigned char* KSk = KS + (kt & 1) * A_BUF;
#pragma unroll
        for (int r = 0; r < 16; ++r) { s0[r] = 0.f; s1[r] = 0.f; }
        {
            const unsigned kaddr = (unsigned)(size_t)(KSk + l31 * 272 + 16 * h);
            asm volatile("" ::: "memory");
#pragma unroll
            for (int s4 = 0; s4 < 2; ++s4) {
                bf16x8 kA[4], kB[4];
#pragma unroll
                for (int s = 0; s < 4; ++s) { DS_RD128(kA[s], kaddr, 32 * (4 * s4 + s)); DS_RD128(kB[s], kaddr, 32 * 272 + 32 * (4 * s4 + s)); }
                asm volatile("s_waitcnt lgkmcnt(0)" : "+v"(kA[0]), "+v"(kA[1]), "+v"(kA[2]), "+v"(kA[3]), "+v"(kB[0]), "+v"(kB[1]), "+v"(kB[2]), "+v"(kB[3]));
#pragma unroll
                for (int s = 0; s < 4; ++s) {
                    s0 = __builtin_amdgcn_mfma_f32_32x32x16_bf16(kA[s], qf[4 * s4 + s], s0, 0, 0, 0);
                    s1 = __builtin_amdgcn_mfma_f32_32x32x16_bf16(kB[s], qf[4 * s4 + s], s1, 0, 0, 0);
                }
            }
        }
        asm volatile("s_nop 7\n\ts_nop 7\n\ts_nop 3" : "+v"(s0), "+v"(s1));
    };
    auto SM = [&](const int kt) __attribute__((always_inline)) {
        const unsigned long long mw = MSK[ql * 32 + kt];
        const unsigned wlo = (unsigned)mw >> (4 * h), whi = (unsigned)(mw >> 32) >> (4 * h);
        const bool far = (kt * 64 + 63 - qpos_min) <= -91;
        float mx;
        if (far) {
            float a = max3f(s0[0], s0[1], s0[2]), bq = max3f(s1[0], s1[1], s1[2]);
#pragma unroll
            for (int r = 3; r < 15; r += 2) { a = max3f(a, s0[r], s0[r + 1]); bq = max3f(bq, s1[r], s1[r + 1]); }
            mx = fmaf(max3f(a, bq, fmaxf(s0[15], s1[15])), SC2, bfar);
        } else {
            const int relb0 = kt * 64 + 4 * h - qpos + 191;
#pragma unroll
            for (int r = 0; r < 16; ++r) { const int cr = (r & 3) + 8 * (r >> 2);
                s0[r] = fmaf(s0[r], SC2, lut[relb0 + cr]); s1[r] = fmaf(s1[r], SC2, lut[relb0 + 32 + cr]); }
            float a = max3f(s0[0], s0[1], s0[2]), bq = max3f(s1[0], s1[1], s1[2]);
#pragma unroll
            for (int r = 3; r < 15; r += 2) { a = max3f(a, s0[r], s0[r + 1]); bq = max3f(bq, s1[r], s1[r + 1]); }
            mx = max3f(a, bq, fmaxf(s0[15], s1[15]));
        }
        mx = fmaxf(mx, __shfl_xor(mx, 32));
        const float m_new = fmaxf(m_run, mx);
        if (__any(m_new != m_run)) {
            const float alpha = __builtin_amdgcn_exp2f(m_run - m_new);
            l_run *= alpha;
#pragma unroll
            for (int db = 0; db < 4; ++db)
#pragma unroll
                for (int r = 0; r < 16; ++r) oacc[db][r] *= alpha;
        }
        m_run = m_new;
        const float sc = far ? SC2 : 1.f, sb = far ? bfar - m_new : -m_new;
        float psum = 0.f;
#pragma unroll
        for (int r = 0; r < 16; ++r) { const int cr = (r & 3) + 8 * (r >> 2);
            const float p0 = __builtin_amdgcn_exp2f(fmaf(s0[r], sc, sb)), p1 = __builtin_amdgcn_exp2f(fmaf(s1[r], sc, sb));
            unsigned m0, m1;
            asm("v_bfe_i32 %0, %1, %c2, 1" : "=v"(m0) : "v"(wlo), "i"(cr)); asm("v_bfe_i32 %0, %1, %c2, 1" : "=v"(m1) : "v"(whi), "i"(cr));
            s0[r] = __uint_as_float(__float_as_uint(p0) & m0); s1[r] = __uint_as_float(__float_as_uint(p1) & m1);
            psum += s0[r] + s1[r]; }
        l_run += psum;
#pragma unroll
        for (int s = 0; s < 2; ++s) {
            v4u w0, w1;
            w0.x = pk2(s0[8 * s + 0], s0[8 * s + 1]); w0.y = pk2(s0[8 * s + 2], s0[8 * s + 3]); w0.z = pk2(s0[8 * s + 4], s0[8 * s + 5]); w0.w = pk2(s0[8 * s + 6], s0[8 * s + 7]);
            w1.x = pk2(s1[8 * s + 0], s1[8 * s + 1]); w1.y = pk2(s1[8 * s + 2], s1[8 * s + 3]); w1.z = pk2(s1[8 * s + 4], s1[8 * s + 5]); w1.w = pk2(s1[8 * s + 6], s1[8 * s + 7]);
            pb[0][s] = __builtin_bit_cast(bf16x8, w0); pb[1][s] = __builtin_bit_cast(bf16x8, w1);
        }
    };
    auto PV = [&](const int kt) __attribute__((always_inline)) {
        LAS unsigned char* VSk = VS + (kt & 1) * A_BUF;
        {
            const unsigned vaddr = (unsigned)(size_t)(VSk + (4 * h + ((lane & 15) >> 2)) * 272 + (16 * ((lane >> 4) & 1) + 4 * (lane & 3)) * 2);
#pragma unroll
            for (int d2 = 0; d2 < 2; ++d2) {
                v2u vlo[8], vhi[8];
#pragma unroll
                for (int dd = 0; dd < 2; ++dd)
#pragma unroll
                    for (int ks = 0; ks < 4; ++ks) { DS_RDTR(vlo[dd * 4 + ks], vaddr, ks * 4352 + (2 * d2 + dd) * 64); DS_RDTR(vhi[dd * 4 + ks], vaddr, ks * 4352 + 2176 + (2 * d2 + dd) * 64); }
                asm volatile("s_waitcnt lgkmcnt(0)" : "+v"(vlo[0]), "+v"(vlo[1]), "+v"(vlo[2]), "+v"(vlo[3]), "+v"(vlo[4]), "+v"(vlo[5]), "+v"(vlo[6]), "+v"(vlo[7]),
                                                      "+v"(vhi[0]), "+v"(vhi[1]), "+v"(vhi[2]), "+v"(vhi[3]), "+v"(vhi[4]), "+v"(vhi[5]), "+v"(vhi[6]), "+v"(vhi[7]));
#pragma unroll
                for (int dd = 0; dd < 2; ++dd)
#pragma unroll
                    for (int ks = 0; ks < 4; ++ks) {
                        const bf16x8 a = __builtin_bit_cast(bf16x8, (v4u){vlo[dd * 4 + ks].x, vlo[dd * 4 + ks].y, vhi[dd * 4 + ks].x, vhi[dd * 4 + ks].y});
                        oacc[2 * d2 + dd] = __builtin_amdgcn_mfma_f32_32x32x16_bf16(a, pb[ks >> 1][ks & 1], oacc[2 * d2 + dd], 0, 0, 0);
                    }
            }
        }
    };
    ATT_LOADK(0); STK(0);
    ATT_LOADK(nkt > 1 ? 1 : 0); ATT_LOADV(0);
#define ATT_STAGE(t) do { if ((t) + 1 < nkt) STK(((t) + 1) & 1); STV((t) & 1); if ((t) + 2 < nkt) ATT_LOADK((t) + 2); if ((t) + 1 < nkt) ATT_LOADV((t) + 1); } while (0)
    if (qh == 0) {
#pragma unroll 1
        for (int t = 0; t < nkt; ++t) {
            __syncthreads(); ATT_STAGE(t);
            if (t > 0) PV(t - 1);
            QK(t);
            __syncthreads();
            SM(t);
        }
        __syncthreads();
        PV(nkt - 1);
        __syncthreads();
    } else {
#pragma unroll 1
        for (int t = 0; t < nkt; ++t) {
            __syncthreads(); ATT_STAGE(t);
            if (t > 0) SM(t - 1);
            __syncthreads();
            if (t > 0) PV(t - 1);
            QK(t);
        }
        __syncthreads();
        SM(nkt - 1);
        __syncthreads();
        PV(nkt - 1);
    }
#undef ATT_STAGE
#undef ATT_LOADK
#undef ATT_LOADV
    const float inv = 1.f / (l_run + __shfl_xor(l_run, 32));
    bf16* op = CAT + (size_t)(row0 + ql) * DM + head * 128 + 4 * h;
#pragma unroll
    for (int db = 0; db < 4; ++db)
#pragma unroll
        for (int q4 = 0; q4 < 4; ++q4) {
#if MIX_FP8
            *(unsigned*)((unsigned char*)CAT + (size_t)(row0 + ql) * DM + head * 128 + 4 * h + 32 * db + 8 * q4) = pk4_fp8(oacc[db][4 * q4 + 0] * (inv * CAT_Q), oacc[db][4 * q4 + 1] * (inv * CAT_Q), oacc[db][4 * q4 + 2] * (inv * CAT_Q), oacc[db][4 * q4 + 3] * (inv * CAT_Q));
#else
            v2u w; w.x = pk2(oacc[db][4 * q4 + 0] * inv, oacc[db][4 * q4 + 1] * inv); w.y = pk2(oacc[db][4 * q4 + 2] * inv, oacc[db][4 * q4 + 3] * inv);
            *(v2u*)(op + 32 * db + 8 * q4) = w;
#endif
        }
}
#endif

__device__ __forceinline__ void phase5(const Ctx& C) {
    LAS float* scr = (LAS float*)(C.lds + C.wave * 16384);
    const int gw = C.bid * NWAVES + C.wave, NGW = C.G * NWAVES;
    bf16* WupT = (bf16*)(C.ws + WS_WUP); bf16* WdnT = (bf16*)(C.ws + WS_WDN); bf16* X1 = (bf16*)(C.ws + WS_XN);
    { LnP P; ln_params(P, inp(C, I_LN1G), inp(C, I_LN1B), C.lane);
#pragma unroll 1
      for (int m = gw; m < MTOK; m += NGW) ln_row<false, true, true>((const bf16*)(C.ws + WS_PRE1) + (size_t)m * DM, P, X1 + (size_t)m * LDX, C.lane, (const unsigned*)(C.ctl + CW_TIX2) + (m >> 8) * 16, (const float*)(C.ws + WS_P2), m & 255); }
#if defined(PROBE_DUP) && PROBE_DUP == 9
    { LnP P; ln_params(P, inp(C, I_LN1G), inp(C, I_LN1B), C.lane);
#pragma unroll 1
      for (int m = gw; m < MTOK; m += NGW) ln_row<false, true, true>((const bf16*)(C.ws + WS_PRE1) + (size_t)m * DM, P, X1 + (size_t)m * LDX, C.lane, (const unsigned*)(C.ctl + CW_TIX2) + (m >> 8) * 16, (const float*)(C.ws + WS_P2), m & 255); }
#endif
    constexpr int I_UP = (DM / 64) * (DFF2 / 32), I_DN = (DFF / 64) * (DM / 32);
#if !WUP_EARLY
    transpose_static<2>(inp(C, I_WUP), DM, DFF2, WupT, I_UP, scr, gw, NGW, C.lane); (void)WdnT; (void)I_DN;
#else
    (void)scr; (void)WupT; (void)WdnT; (void)I_UP; (void)I_DN;
#endif
}
__device__ __forceinline__ void ffn_fixup(const Ctx& C) {
    const bf16* UPS = (const bf16*)(C.ws + WS_UPS); bf16* ACT = (bf16*)(C.ws + WS_ACT);
    const float* fw = inp(C, I_FCW); const float* fb = inp(C, I_FCB); const float* st = inp(C, I_SFFN);
    const int gt = C.bid * (NWAVES * 64) + C.tid, NGT = C.G * NWAVES * 64;
    for (int it = gt; it < 576 * (DFF / 4); it += NGT) {
        const int ri = it / (DFF / 4), j = (it % (DFF / 4)) * 4, blk = ri >> 1, w = ri & 1, row = blk * 64 + w;
        const bool prompt = row < NPROW; const int r2 = row - NPROW;
        const int b = prompt ? (row >> 11) : (r2 >> 6), t = prompt ? (row & 2047) : (r2 & 63);
        f32x4 g[3], v[3];
        v2u ua[3], uc[3]; f32x4 sg[3], sv[3];
#pragma unroll
        for (int k = 0; k < 3; ++k) {
            const int dt = k - 2, tt = t + dt;
            const int rr = max(row + dt, 0), bb = rr >> 6, idx = ((rr & 63) + 2) & 63;
            ua[k] = *(const v2u*)(UPS + (size_t)(bb * 4 + idx) * DFF2 + j); uc[k] = *(const v2u*)(UPS + (size_t)(bb * 4 + idx) * DFF2 + DFF + j);
            const int si = min(max(2 + tt, 0), 1), bs = prompt ? 0 : b;
            sg[k] = *(const f32x4*)(st + (size_t)(bs * 2 + si) * DFF2 + j); sv[k] = *(const f32x4*)(st + (size_t)(bs * 2 + si) * DFF2 + DFF + j);
        }
        asm volatile("" : "+v"(ua[0]), "+v"(ua[1]), "+v"(ua[2]), "+v"(uc[0]), "+v"(uc[1]), "+v"(uc[2]), "+v"(sg[0]), "+v"(sg[1]), "+v"(sg[2]), "+v"(sv[0]), "+v"(sv[1]), "+v"(sv[2]));
#pragma unroll
        for (int k = 0; k < 3; ++k) {
            const int tt = t + k - 2;
            const float ks = (tt < 0 && !prompt) ? 1.f : 0.f;
            const f32x4 gu = (f32x4){bflo(ua[k].x), bfhi(ua[k].x), bflo(ua[k].y), bfhi(ua[k].y)}, vu = (f32x4){bflo(uc[k].x), bfhi(uc[k].x), bflo(uc[k].y), bfhi(uc[k].y)};
            g[k] = tt >= 0 ? gu : sg[k] * ks; v[k] = tt >= 0 ? vu : sv[k] * ks;
        }
        f32x4 G = *(const f32x4*)(fb + j), V = *(const f32x4*)(fb + DFF + j);
#pragma unroll
        for (int k = 0; k < 3; ++k) { G += *(const f32x4*)(fw + (size_t)k * DFF2 + j) * g[k]; V += *(const f32x4*)(fw + (size_t)k * DFF2 + DFF + j) * v[k]; }
#if FFN_DOWN_FP8
        *(unsigned*)((unsigned char*)ACT + (size_t)row * DFF + j) = pk4_fp8(silu_f(G.x) * V.x * ACT_Q, silu_f(G.y) * V.y * ACT_Q, silu_f(G.z) * V.z * ACT_Q, silu_f(G.w) * V.w * ACT_Q);
#else
        v2u o; o.x = pk2(silu_f(G.x) * V.x, silu_f(G.y) * V.y); o.y = pk2(silu_f(G.z) * V.z, silu_f(G.w) * V.w);
        *(v2u*)(ACT + (size_t)row * DFF + j) = o;
#endif
    }
}

__device__ __forceinline__ int crow16(int r, int h) { return (r & 3) + 8 * (r >> 2) + 4 * h; }
__device__ __forceinline__ bf16x8 pack8(float a0, float a1, float a2, float a3, float a4, float a5, float a6, float a7) {
    v4u w; w.x = pk2(a0, a1); w.y = pk2(a2, a3); w.z = pk2(a4, a5); w.w = pk2(a6, a7); return __builtin_bit_cast(bf16x8, w);
}
typedef short v4i16_t __attribute__((ext_vector_type(4)));
__device__ __forceinline__ v2u tr4(LAS unsigned char* tile, int row0, int col0, int lane) {
    const int q = (lane & 15) >> 2, p = lane & 3, blk = (lane >> 4) & 1;
    const v4i16_t r = __builtin_amdgcn_ds_read_tr16_b64_v4i16((LAS v4i16_t*)(tile + (row0 + q) * 272 + (col0 + 16 * blk + 4 * p) * 2));
    return __builtin_bit_cast(v2u, r);
}

template <int SIDX> __device__ __forceinline__ void dprep_pass(const Ctx& C, const bf16* H, bf16* QKVC, const float* cw, const float* cb, const float* st, LAS unsigned char* tile, int R0, int t0, bool prompt, int b, int h, int lane) {
    const int cch = SIDX * 2048 + h * 128 + 2 * lane;
    const f32x2 w0 = *(const f32x2*)(cw + cch), w1 = *(const f32x2*)(cw + CQKV + cch), w2 = *(const f32x2*)(cw + 2 * CQKV + cch), w3 = *(const f32x2*)(cw + 3 * CQKV + cch), bi = *(const f32x2*)(cb + cch);
    f32x2 xm3, xm2, xm1;
    const int Rh = R0 >= 3 ? R0 - 3 : 0, bs = prompt ? 0 : b;
    unsigned ha = *(const unsigned*)(H + (size_t)Rh * LDH + HQKV + cch), hb = *(const unsigned*)(H + (size_t)(Rh + 1) * LDH + HQKV + cch), hc = *(const unsigned*)(H + (size_t)(Rh + 2) * LDH + HQKV + cch);
    f32x2 s3 = *(const f32x2*)(st + (size_t)(bs * 3 + 0) * CQKV + cch), s2 = *(const f32x2*)(st + (size_t)(bs * 3 + 1) * CQKV + cch), s1 = *(const f32x2*)(st + (size_t)(bs * 3 + 2) * CQKV + cch);
    const float post = SIDX == 0 ? QSCALE : 1.f;
    unsigned xws[32];
#pragma unroll
    for (int i = 0; i < 32; ++i) xws[i] = *(const unsigned*)(H + (size_t)(R0 + i) * LDH + HQKV + cch);
    asm volatile("" : "+v"(ha), "+v"(hb), "+v"(hc), "+v"(s3), "+v"(s2), "+v"(s1));
    {
        const bool fromH = t0 > 0; const float ks = (!fromH && !prompt) ? 1.f : 0.f;
        xm3 = fromH ? (f32x2){bflo(ha), bfhi(ha)} : s3 * ks; xm2 = fromH ? (f32x2){bflo(hb), bfhi(hb)} : s2 * ks; xm1 = fromH ? (f32x2){bflo(hc), bfhi(hc)} : s1 * ks;
    }
#pragma unroll
    for (int i0 = 0; i0 < 32; i0 += 8) {
        f32x2 y[8];
#pragma unroll
        for (int j = 0; j < 8; ++j) {
            const unsigned xw = xws[i0 + j];
            const f32x2 x0 = (f32x2){bflo(xw), bfhi(xw)};
            y[j] = bi + w0 * xm3 + w1 * xm2 + w2 * xm1 + w3 * x0;
            xm3 = xm2; xm2 = xm1; xm1 = x0;
        }
#pragma unroll
        for (int j = 0; j < 8; ++j) { y[j].x = silu_f(y[j].x); y[j].y = silu_f(y[j].y); }
        if (SIDX < 2) {
            float ss[8];
#pragma unroll
            for (int j = 0; j < 8; ++j) ss[j] = wave_sum(y[j].x * y[j].x + y[j].y * y[j].y);
#pragma unroll
            for (int j = 0; j < 8; ++j) { const float sc = post * __builtin_amdgcn_rsqf(ss[j] + 1e-6f); y[j].x *= sc; y[j].y *= sc; }
        }
#pragma unroll
        for (int j = 0; j < 8; ++j) {
            const unsigned pw = pk2(y[j].x, y[j].y);
            *(unsigned*)(QKVC + (size_t)(R0 + i0 + j) * CQKV + cch) = pw;
            if (SIDX < 2) *(LAS unsigned*)(tile + (i0 + j) * 272 + 4 * lane) = pw;
        }
    }
}

__device__ __forceinline__ void dprep_unit(const Ctx& C, int u, int lane_in, LAS unsigned char* scr, const int pmode = 0) {
    int lane = lane_in; asm volatile("" : "+v"(lane));
    const bool prompt = u < 8192; const int u2 = u - 8192;
    const int bh = prompt ? (u >> 6) : (u2 >> 1), c = prompt ? (u & 63) : (u2 & 1), b = bh >> 4, h = bh & 15;
    const int R0 = (prompt ? b * PSEQ : NPROW + b * SSEQ) + c * 32, t0 = c * 32;
    const bf16* H = (const bf16*)(C.ws + WS_H); bf16* QKVC = (bf16*)(C.ws + WS_QKVC);
    const float* SM = C.out + OS_SM;
    const float* cw = inp(C, I_CQW); const float* cb = inp(C, I_CQB); const float* st = inp(C, I_SCONV);
    LAS unsigned char* tile = scr;
    LAS float* LT = (LAS float*)(scr + 8704);
    LAS float* Gs = LT + 32 * 36;
    LAS float* Bs = Gs + 32;
    const int l31 = lane & 31, hh = lane >> 5;
    bf16x8 kf[8], qf[8];
    if (pmode != 2)
    dprep_pass<1>(C, H, QKVC, cw, cb, st, tile, R0, t0, prompt, b, h, lane);
#pragma unroll
    for (int s = 0; s < 8; ++s) kf[s] = *(const LAS bf16x8*)(tile + l31 * 272 + 32 * s + 16 * hh);
    LDS_WAIT(); asm volatile("" ::: "memory");
    if (pmode != 2)
    dprep_pass<0>(C, H, QKVC, cw, cb, st, tile, R0, t0, prompt, b, h, lane);
#pragma unroll
    for (int s = 0; s < 8; ++s) qf[s] = *(const LAS bf16x8*)(tile + l31 * 272 + 32 * s + 16 * hh);
    LDS_WAIT(); asm volatile("" ::: "memory");
    if (pmode != 2)
    dprep_pass<2>(C, H, QKVC, cw, cb, st, tile, R0, t0, prompt, b, h, lane);
    LDS_WAIT(); asm volatile("" ::: "memory");
    if (pmode == 1) return;
    const size_t grow = (size_t)(R0 + l31);
    const float Aexp = expf(inp(C, I_ALOG)[h]), dtb = inp(C, I_DTB)[h];
    const float xg = SM[grow * 128 + 96 + h] + dtb; const float sp = xg > 20.f ? xg : log1pf(expf(xg));
    float G = -Aexp * sp;
#pragma unroll
    for (int off = 1; off < 32; off <<= 1) { const float t = __shfl_up(G, off, 32); if (l31 >= off) G += t; }
    const float beta = 1.f / (1.f + expf(-SM[grow * 128 + 80 + h]));
    if (lane < 32) { Gs[lane] = G; Bs[lane] = beta; (C.out + OS_GB)[grow * 16 + h] = G; }
    f32x16 KK, KQ;
#pragma unroll
    for (int r = 0; r < 16; ++r) { KK[r] = 0.f; KQ[r] = 0.f; }
#pragma unroll
    for (int s = 0; s < 8; ++s) { KK = __builtin_amdgcn_mfma_f32_32x32x16_bf16(kf[s], kf[s], KK, 0, 0, 0); KQ = __builtin_amdgcn_mfma_f32_32x32x16_bf16(kf[s], qf[s], KQ, 0, 0, 0); }
    LDS_WAIT(); asm volatile("" ::: "memory");
    float mfv[16];
#pragma unroll
    for (int q4 = 0; q4 < 4; ++q4) {
        const f32x4 Gm = *(const LAS f32x4*)(Gs + 8 * q4 + 4 * hh), Bm = *(const LAS f32x4*)(Bs + 8 * q4 + 4 * hh);
        f32x4 lv;
#pragma unroll
        for (int e = 0; e < 4; ++e) {
            const int r = 4 * q4 + e, m = 8 * q4 + 4 * hh + e;
            lv[e] = (m > l31) ? Bm[e] * KK[r] * __expf(Gm[e] - G) : 0.f;
            mfv[r] = (l31 >= m) ? KQ[r] * __expf(G - Gm[e]) : 0.f;
        }
        *(LAS f32x4*)(LT + l31 * 36 + 8 * q4 + 4 * hh) = lv;
    }
    {
        float* mff = C.out + OS_MFF + (size_t)u * 512;
        *(bf16x8*)(mff + (0 * 64 + lane) * 4) = pack8(mfv[0], mfv[1], mfv[2], mfv[3], mfv[4], mfv[5], mfv[6], mfv[7]);
        *(bf16x8*)(mff + (1 * 64 + lane) * 4) = pack8(mfv[8], mfv[9], mfv[10], mfv[11], mfv[12], mfv[13], mfv[14], mfv[15]);
    }
    LDS_WAIT(); asm volatile("" ::: "memory");
    LAS float* Tm = (LAS float*)scr + l31 * 33;
    for (int j = 31; j >= 0; --j) {
        float p = 0.f;
        const LAS float* lrow = LT + j * 36;
#pragma unroll 4
        for (int i2 = j + 1 + hh; i2 < 32; i2 += 2) p += Tm[i2] * lrow[i2];
        const auto rr = __builtin_amdgcn_permlane32_swap(__float_as_uint(p), __float_as_uint(p), false, false);
        Tm[j] = ((l31 == j) ? 1.f : 0.f) - (__uint_as_float(rr[0]) + __uint_as_float(rr[1]));
    }
    const float eG = __expf(G);
    if (lane < 32) Gs[lane] = beta * eG;
    LDS_WAIT(); asm volatile("" ::: "memory");
    float* tbf = C.out + OS_TBF + (size_t)u * 512; float* tgf = C.out + OS_TGF + (size_t)u * 512;
#pragma unroll
    for (int s = 0; s < 2; ++s) {
        float a[8], g8[8];
#pragma unroll
        for (int jj = 0; jj < 8; ++jj) {
            const int jn = 16 * s + 8 * hh + jj;
            const int jk = 16 * s + 8 * (jj >> 2) + 4 * hh + (jj & 3);
            a[jj] = Tm[jn] * Bs[jn]; g8[jj] = Tm[jk] * Gs[jk];
        }
        *(bf16x8*)(tbf + (s * 64 + lane) * 4) = pack8(a[0], a[1], a[2], a[3], a[4], a[5], a[6], a[7]);
        *(bf16x8*)(tgf + (s * 64 + lane) * 4) = pack8(g8[0], g8[1], g8[2], g8[3], g8[4], g8[5], g8[6], g8[7]);
    }
    LDS_WAIT(); asm volatile("" ::: "memory");
}

constexpr int DS_BASE = 16384, DS_TILE = 32 * 272, DS_FR = 3 * DS_TILE, DS_SCL = DS_FR + 6144, DS_OB = DS_SCL + 320, DS_HALF = DS_OB + 32 * 132 * 4;
static_assert(DS_BASE + 2 * DS_HALF <= RING_BYTES && DS_HALF % 16 == 0, "dscan LDS map");
__device__ __forceinline__ void dscan_unit(const Ctx& C, int item, const int HOT = 0) {
    int tid_ = C.tid; asm volatile("" : "+v"(tid_));
    const int tid = tid_, lane = tid & 63, wave = __builtin_amdgcn_readfirstlane(tid >> 6);
    const bool prompt = item < 64;
    const int half = wave >> 2, eb = wave & 3, ht = tid & 255;
    const int bh = prompt ? item * 2 + half : (item - 64) * 2 + half, b = bh >> 4, h = bh & 15;
    const int nch = prompt ? 64 : 2, rowbase = prompt ? b * PSEQ : NPROW + b * SSEQ, ubase = prompt ? bh * 64 : 8192 + bh * 2;
    const bf16* H = (const bf16*)(C.ws + WS_H); const bf16* QKVC = (const bf16*)(C.ws + WS_QKVC); bf16* CAT = (bf16*)(C.ws + WS_CAT);
    LAS unsigned char* hb = C.lds + DS_BASE + half * DS_HALF;
    LAS unsigned char* QT = hb; LAS unsigned char* KT = hb + DS_TILE; LAS unsigned char* VT_ = hb + 2 * DS_TILE;
    LAS unsigned char* FR = hb + DS_FR; LAS float* SCL = (LAS float*)(hb + DS_SCL); LAS float* OB = (LAS float*)(hb + DS_OB);
    const int l31 = lane & 31, hh = lane >> 5;
    f32x16 S[4];
    if (prompt) {
#pragma unroll
        for (int db = 0; db < 4; ++db)
#pragma unroll
            for (int r = 0; r < 16; ++r) S[db][r] = 0.f;
    } else {
        const float* s0 = inp(C, I_SDELTA) + (size_t)bh * 128 * 128 + 32 * eb + l31;
#pragma unroll
        for (int db = 0; db < 4; ++db)
#pragma unroll
            for (int r = 0; r < 16; ++r) S[db][r] = s0[(size_t)(32 * db + crow16(r, hh)) * 128];
    }
    const f32x2 gn = *(const f32x2*)(inp(C, I_DNG) + 2 * lane);
    v4u sreg[8]; float gi = 0.f, gl_ = 0.f;
#define DS_REQ(CH) do { const int R0_ = rowbase + (HOT ? 0 : (CH)) * 32, u_ = ubase + (HOT ? 0 : (CH)); \
        const bf16* qb_ = QKVC + (size_t)R0_ * CQKV + h * 128; const float* fb_ = C.out + (size_t)u_ * 512;     \
        _Pragma("unroll") for (int k_ = 0; k_ < 6; ++k_) { const unsigned idx = (unsigned)ht + 256u * k_, which = idx >> 9, r = (idx & 511u) >> 4, pc = idx & 15u; \
            sreg[k_] = *(const v4u*)(qb_ + (r * (unsigned)CQKV + which * 2048u + pc * 8u)); } \
        _Pragma("unroll") for (int k_ = 0; k_ < 2; ++k_) { const unsigned idx = (unsigned)ht + 256u * k_; if (idx < 384u) { const unsigned f = idx >> 7, rest = idx & 127u; \
            sreg[6 + k_] = *(const v4u*)(fb_ + ((f == 0 ? OS_TBF : f == 1 ? OS_TGF : OS_MFF) + rest * 4u)); } } \
        if (ht < 32) { const float* gb = C.out + OS_GB + (size_t)R0_ * 16 + h; gi = gb[ht * 16]; gl_ = gb[31 * 16]; } } while (0)
    DS_REQ(0);
#pragma unroll 1
    for (int ch = 0; ch < nch; ++ch) {
        const int R0 = rowbase + ch * 32;
#pragma unroll
        for (int k_ = 0; k_ < 6; ++k_) { const int idx = ht + 256 * k_, which = idx >> 9, r = (idx & 511) >> 4, pc = idx & 15; *(LAS v4u*)(hb + which * DS_TILE + r * 272 + pc * 16) = sreg[k_]; }
#pragma unroll
        for (int k_ = 0; k_ < 2; ++k_) { const int idx = ht + 256 * k_; if (idx < 384) *(LAS v4u*)(FR + idx * 16) = sreg[6 + k_]; }
        if (ht < 32) { SCL[ht] = __expf(gi); SCL[32 + ht] = __expf(gl_ - gi); if (ht == 0) SCL[64] = __expf(gl_); }
        __syncthreads();
        if (ch + 1 < nch) DS_REQ(ch + 1);
        f32x16 un;
#pragma unroll
        for (int r = 0; r < 16; ++r) un[r] = 0.f;
        {
            const bf16x8 tb0 = *(const LAS bf16x8*)(FR + lane * 16), tb1 = *(const LAS bf16x8*)(FR + (64 + lane) * 16);
            const v2u a0 = tr4(VT_, 8 * hh, 32 * eb, lane), a1 = tr4(VT_, 8 * hh + 4, 32 * eb, lane), b0 = tr4(VT_, 16 + 8 * hh, 32 * eb, lane), b1 = tr4(VT_, 16 + 8 * hh + 4, 32 * eb, lane);
            un = __builtin_amdgcn_mfma_f32_32x32x16_bf16(tb0, __builtin_bit_cast(bf16x8, (v4u){a0.x, a0.y, a1.x, a1.y}), un, 0, 0, 0);
            un = __builtin_amdgcn_mfma_f32_32x32x16_bf16(tb1, __builtin_bit_cast(bf16x8, (v4u){b0.x, b0.y, b1.x, b1.y}), un, 0, 0, 0);
        }
        {
            const bf16x8 tg0 = *(const LAS bf16x8*)(FR + 2048 + lane * 16), tg1 = *(const LAS bf16x8*)(FR + 2048 + (64 + lane) * 16);
#pragma unroll
            for (int db = 0; db < 4; ++db) {
                const v2u l0 = tr4(KT, 4 * hh, 32 * db, lane), h0 = tr4(KT, 8 + 4 * hh, 32 * db, lane), l1 = tr4(KT, 16 + 4 * hh, 32 * db, lane), h1 = tr4(KT, 24 + 4 * hh, 32 * db, lane);
                f32x16 w;
#pragma unroll
                for (int r = 0; r < 16; ++r) w[r] = 0.f;
                w = __builtin_amdgcn_mfma_f32_32x32x16_bf16(__builtin_bit_cast(bf16x8, (v4u){l0.x, l0.y, h0.x, h0.y}), tg0, w, 0, 0, 0);
                w = __builtin_amdgcn_mfma_f32_32x32x16_bf16(__builtin_bit_cast(bf16x8, (v4u){l1.x, l1.y, h1.x, h1.y}), tg1, w, 0, 0, 0);
                const bf16x8 wA0 = pack8(-w[0], -w[1], -w[2], -w[3], -w[4], -w[5], -w[6], -w[7]), wA1 = pack8(-w[8], -w[9], -w[10], -w[11], -w[12], -w[13], -w[14], -w[15]);
                const bf16x8 SB0 = pack8(S[db][0], S[db][1], S[db][2], S[db][3], S[db][4], S[db][5], S[db][6], S[db][7]);
                const bf16x8 SB1 = pack8(S[db][8], S[db][9], S[db][10], S[db][11], S[db][12], S[db][13], S[db][14], S[db][15]);
                un = __builtin_amdgcn_mfma_f32_32x32x16_bf16(wA0, SB0, un, 0, 0, 0);
                un = __builtin_amdgcn_mfma_f32_32x32x16_bf16(wA1, SB1, un, 0, 0, 0);
            }
        }
        bf16x8 vnB0, vnB1, vnS0, vnS1;
        {
            float vn[16], dc[16];
#pragma unroll
            for (int q4 = 0; q4 < 4; ++q4) {
                const f32x4 d4 = *(const LAS f32x4*)(SCL + 32 + 8 * q4 + 4 * hh);
#pragma unroll
                for (int e = 0; e < 4; ++e) { dc[4 * q4 + e] = d4[e]; vn[4 * q4 + e] = un[4 * q4 + e]; }
            }
            vnB0 = pack8(vn[0], vn[1], vn[2], vn[3], vn[4], vn[5], vn[6], vn[7]); vnB1 = pack8(vn[8], vn[9], vn[10], vn[11], vn[12], vn[13], vn[14], vn[15]);
            vnS0 = pack8(vn[0] * dc[0], vn[1] * dc[1], vn[2] * dc[2], vn[3] * dc[3], vn[4] * dc[4], vn[5] * dc[5], vn[6] * dc[6], vn[7] * dc[7]);
            vnS1 = pack8(vn[8] * dc[8], vn[9] * dc[9], vn[10] * dc[10], vn[11] * dc[11], vn[12] * dc[12], vn[13] * dc[13], vn[14] * dc[14], vn[15] * dc[15]);
        }
        unsigned zreg[8];
#pragma unroll
        for (int jr = 0; jr < 8; ++jr) zreg[jr] = *(const unsigned*)(H + (size_t)((HOT ? rowbase : R0) + eb * 8 + jr) * LDH + HZ + h * 128 + 2 * lane);
        f32x16 qs, o2;
#pragma unroll
        for (int r = 0; r < 16; ++r) { qs[r] = 0.f; o2[r] = 0.f; }
        const float gl = SCL[64];
#pragma unroll
        for (int db = 0; db < 4; ++db) {
            const bf16x8 SB0 = pack8(S[db][0], S[db][1], S[db][2], S[db][3], S[db][4], S[db][5], S[db][6], S[db][7]);
            const bf16x8 SB1 = pack8(S[db][8], S[db][9], S[db][10], S[db][11], S[db][12], S[db][13], S[db][14], S[db][15]);
            const LAS unsigned char* qp = QT + l31 * 272 + (32 * db + 4 * hh) * 2;
            const v2u ql0 = *(const LAS v2u*)qp, qh0 = *(const LAS v2u*)(qp + 16), ql1 = *(const LAS v2u*)(qp + 32), qh1 = *(const LAS v2u*)(qp + 48);
            qs = __builtin_amdgcn_mfma_f32_32x32x16_bf16(__builtin_bit_cast(bf16x8, (v4u){ql0.x, ql0.y, qh0.x, qh0.y}), SB0, qs, 0, 0, 0);
            qs = __builtin_amdgcn_mfma_f32_32x32x16_bf16(__builtin_bit_cast(bf16x8, (v4u){ql1.x, ql1.y, qh1.x, qh1.y}), SB1, qs, 0, 0, 0);
            const v2u l0 = tr4(KT, 4 * hh, 32 * db, lane), h0 = tr4(KT, 8 + 4 * hh, 32 * db, lane), l1 = tr4(KT, 16 + 4 * hh, 32 * db, lane), h1 = tr4(KT, 24 + 4 * hh, 32 * db, lane);
#pragma unroll
            for (int r = 0; r < 16; ++r) S[db][r] *= gl;
            S[db] = __builtin_amdgcn_mfma_f32_32x32x16_bf16(__builtin_bit_cast(bf16x8, (v4u){l0.x, l0.y, h0.x, h0.y}), vnS0, S[db], 0, 0, 0);
            S[db] = __builtin_amdgcn_mfma_f32_32x32x16_bf16(__builtin_bit_cast(bf16x8, (v4u){l1.x, l1.y, h1.x, h1.y}), vnS1, S[db], 0, 0, 0);
        }
        {
            const bf16x8 mf0 = *(const LAS bf16x8*)(FR + 4096 + lane * 16), mf1 = *(const LAS bf16x8*)(FR + 4096 + (64 + lane) * 16);
            o2 = __builtin_amdgcn_mfma_f32_32x32x16_bf16(mf0, vnB0, o2, 0, 0, 0);
            o2 = __builtin_amdgcn_mfma_f32_32x32x16_bf16(mf1, vnB1, o2, 0, 0, 0);
        }
        float eg[16];
#pragma unroll
        for (int q4 = 0; q4 < 4; ++q4) { const f32x4 e4 = *(const LAS f32x4*)(SCL + 8 * q4 + 4 * hh); eg[4 * q4] = e4[0]; eg[4 * q4 + 1] = e4[1]; eg[4 * q4 + 2] = e4[2]; eg[4 * q4 + 3] = e4[3]; }
#pragma unroll
        for (int r = 0; r < 16; ++r) OB[crow16(r, hh) * 132 + 32 * eb + l31] = qs[r] * eg[r] + o2[r];
        __syncthreads();
        f32x2 ovv[8]; float ssq[8];
#pragma unroll
        for (int jr = 0; jr < 8; ++jr) ovv[jr] = *(const LAS f32x2*)(OB + (eb * 8 + jr) * 132 + 2 * lane);
#pragma unroll
        for (int jr = 0; jr < 8; ++jr) ssq[jr] = wave_sum(ovv[jr].x * ovv[jr].x + ovv[jr].y * ovv[jr].y);
#pragma unroll
        for (int jr = 0; jr < 8; ++jr) {
            const int i = eb * 8 + jr; const size_t row = (size_t)(R0 + i);
            const f32x2 ov = ovv[jr];
            const float rs = __builtin_amdgcn_rsqf(ssq[jr] * (1.f / 128.f) + LN_EPS);
            const unsigned zw = zreg[jr];
#if MIX_FP8
            *(unsigned short*)((unsigned char*)(HOT ? (bf16*)(C.ws + 427 * MiB) : CAT) + (HOT ? (size_t)i : row) * DM + 2048 + h * 128 + 2 * lane) = (unsigned short)pk4_fp8(ov.x * rs * gn.x * silu_f(bflo(zw)) * CAT_Q, ov.y * rs * gn.y * silu_f(bfhi(zw)) * CAT_Q, 0.f, 0.f);
#else
            *(unsigned*)(CAT + row * DM + 2048 + h * 128 + 2 * lane) = pk2(ov.x * rs * gn.x * silu_f(bflo(zw)), ov.y * rs * gn.y * silu_f(bfhi(zw)));
#endif
        }
    }
#undef DS_REQ
    float* so = HOT ? (float*)(C.ws + 427 * MiB + 262144) + (size_t)(bh & 15) * 128 * 128 + 32 * eb + l31 : C.out + (prompt ? O_PDELTA : O_SDELTA) + (size_t)bh * 128 * 128 + 32 * eb + l31;
#pragma unroll
    for (int db = 0; db < 4; ++db)
#pragma unroll
        for (int r = 0; r < 16; ++r) so[(size_t)(32 * db + crow16(r, hh)) * 128] = S[db][r];
}

#ifndef MK_PER_PHASE
#define MK_PER_PHASE 0
#endif
constexpr int N_PHASES = 10;
#ifndef GEMM_XS
#define GEMM_XS 0
#endif
#ifndef UP_TAIL_SPLIT
#define UP_TAIL_SPLIT 0
#endif
#ifndef WUP_MIX
#define WUP_MIX 0
#endif
#ifndef WUP_SPLIT
#define WUP_SPLIT 0
#endif
#ifndef GEMM_WGM_RES
#define GEMM_WGM_RES 4
#endif
#ifndef GEMM_WGM
#define GEMM_WGM 4
#endif
struct Args { const float* in[26]; float* out; unsigned char* ws; int ph_lo, ph_hi; };
static_assert(sizeof(Args) == 26 * 8 + 8 + 8 + 8, "Args has no padding");

struct HotOrder { pg8::StaticOrder S; __device__ bool next(int i, pg8::Unit& u) const { pg8::Unit t; if (!S.next(i, t)) return false; u.pm = S.c & 3; u.pn = (S.c >> 2) & 7; u.koff = 0; u.part = 0; u.kn = 0; u.tidx = 0; return true; }
                  __device__ void a_ready(const pg8::Unit&) const {} __device__ void done(const pg8::Unit&) const {} };
__device__ __forceinline__ int dprep_map(int j, int wave) {
    if (j < 1024) { const int b = j >> 7, rem = j & 127, c = rem >> 1, h = (rem & 1) * 8 + wave; return (b * 16 + h) * 64 + c; }
    const int j2 = j - 1024, b = j2 >> 2, rem = j2 & 3, c = rem >> 1, h = (rem & 1) * 8 + wave; return 8192 + (b * 16 + h) * 2 + c;
}
struct EpiNull { static constexpr bool PERM = true, AFTER_DRAIN = false; float* sink;
                 __device__ __forceinline__ void operator()(const pg8::f32x4 (&acc)[2][2][4][2], const pg8::Unit& u, int wr, int wc, int fr, int fq) const {
                     float s = 0.f;
#pragma unroll
                     for (int a = 0; a < 2; ++a)
#pragma unroll
                         for (int b = 0; b < 2; ++b)
#pragma unroll
                             for (int m = 0; m < 4; ++m) s += acc[a][b][m][0][0] + acc[a][b][m][1][3];
                     if (s == 123456.789f) sink[0] = s; } };
__global__ void __launch_bounds__(NWAVES * 64, 2) fwd_kernel(Args args) {
    extern __shared__ __attribute__((aligned(16))) unsigned char lds_raw[];
    Ctx C;
    C.out = args.out; C.ws = args.ws;
    C.lds = (LAS unsigned char*)lds_raw; C.ctl = (gu32*)(args.ws + WS_CTL);
    C.tid = threadIdx.x; C.lane = C.tid & 63; C.wave = __builtin_amdgcn_readfirstlane(C.tid >> 6); C.G = gridDim.x; C.bid = blockIdx.x;
    for (int u = C.tid; u < (LDS_BYTES - LDSCTL_OFF) / 4; u += NWAVES * 64) ((LAS unsigned*)(C.lds + LDSCTL_OFF))[u] = 0u;
    __syncthreads();
    if (C.tid < 26) ((LAS unsigned long long*)(C.lds + PTAB_OFF))[C.tid] = (unsigned long long)(size_t)args.in[C.tid];
    __syncthreads();
    XcdBarrier bar; bar.bar = (unsigned*)(C.ctl + CW_BAR); bar.x = 0; bar.st = nullptr;
    if (!MK_PER_PHASE) bar = xcd_barrier_post((unsigned*)(C.ctl + CW_BAR), (volatile LAS unsigned*)(C.lds + MISC_OFF) + 8);
    const int lo = args.ph_lo, hi = args.ph_hi;
#define IN(k) (lo <= (k) && (k) < hi)
#define SEAM(k) do { if (IN(k) && IN((k) + 1)) xcd_barrier(bar); REFRESH_IDS(); } while (0)
#define REFRESH_IDS() do { int t_ = threadIdx.x; asm volatile("" : "+v"(t_)); C.tid = t_; C.lane = t_ & 63; C.wave = __builtin_amdgcn_readfirstlane(t_ >> 6); } while (0)

#ifndef PROBE_DUP
#define PROBE_DUP 0
#endif
    if (IN(0)) { phase0(C); if (PROBE_DUP == 1) { xcd_barrier(bar); phase0(C); } } SEAM(0);

    if (IN(1)) {
        pg8::Gemm g{(const pg8::bf16_t*)(C.ws + WS_XN), (const pg8::bf16_t*)(C.ws + WS_WIN), MTOK, LDH, DM, LDX};
        pg8::StaticOrder S; S.init(MTOK, LDH, C.G, C.bid); S.wgm = GEMM_WGM; S.xs = GEMM_XS;
        Epi1 E{(bf16*)(C.ws + WS_H), C.out + OS_SM, C.out};
#if defined(GEMM_STAGGER) && GEMM_STAGGER
        for (int d = 0; d < ((C.bid >> 5) & 7) * GEMM_STAGGER; ++d) __builtin_amdgcn_s_sleep(127);
#endif
        pg8::gemm_phase<Epi1, pg8::StaticOrder, true, true>(C.lds, g, S, E);
        REFRESH_IDS();
        transpose_queue<MIX_FP8 ? 4 : 0>(C, inp(C, I_WO), DM, DM, (bf16*)(C.ws + WS_WO), (DM / 64) * (DM / 32), CW_QT1);
        if (PROBE_DUP == 4) { xcd_barrier(bar); pg8::gemm_phase<Epi1, pg8::StaticOrder, true, true>(C.lds, g, S, E); }
        if (PROBE_DUP == 21) { xcd_barrier(bar); EpiNull EN{(float*)(C.ws + WS_P2)}; pg8::gemm_phase<EpiNull, pg8::StaticOrder, true, true>(C.lds, g, S, EN); }
        if (PROBE_DUP == 20) {
            xcd_barrier(bar);
            HotOrder HO{S}; EpiNull EN{(float*)(C.ws + WS_P2)};
            pg8::gemm_phase<EpiNull, HotOrder, true, true>(C.lds, g, HO, EN);
        }
    } SEAM(1);

    if (IN(2)) {
#if PROBE_DUP == 32 || PROBE_DUP == 33
        { const int pm = __builtin_amdgcn_readfirstlane(PROBE_DUP - 31); for (;;) { const int it = q_next(C, CW_Q2 + 256); if (it >= NDU / 8) break; dprep_unit(C, it * 8 + C.wave, C.lane, C.lds + C.wave * 13824, pm); } xcd_barrier(bar); REFRESH_IDS(); }
#endif
        for (;;) { const int it = q_next(C, CW_Q2); if (it >= 288 + NDU / 8) break; if (it < 288) idx_unit(C, it); else dprep_unit(C, dprep_map(it - 288, C.wave), C.lane, C.lds + C.wave * 13824); }
#if WUP_EARLY
        REFRESH_IDS();
        transpose_queue<2>(C, inp(C, I_WUP), DM, DFF2, (bf16*)(C.ws + WS_WUP), (DM / 64) * (DFF2 / 32), CW_QT5, 0, WUP_SPLIT, 16384, 8704);
#endif
        if (PROBE_DUP == 2) { xcd_barrier(bar); for (;;) { const int it = q_next(C, CW_Q2 + 256); if (it >= 288 + NDU / 8) break; if (it < 288) idx_unit(C, it); else dprep_unit(C, (it - 288) * 8 + C.wave, C.lane, C.lds + C.wave * 13824); } }
        if (PROBE_DUP == 12) { xcd_barrier(bar); for (;;) { const int it = q_next(C, CW_Q2 + 256); if (it >= 288) break; idx_unit<false>(C, it); } }
        if (PROBE_DUP == 10) { xcd_barrier(bar); for (;;) { const int it = q_next(C, CW_Q2 + 256); if (it >= 288) break; idx_unit(C, it); } }
        if (PROBE_DUP == 11) { xcd_barrier(bar); for (;;) { const int it = q_next(C, CW_Q2 + 256); if (it >= NDU / 8) break; dprep_unit(C, it * 8 + C.wave, C.lane, C.lds + C.wave * 13824); } }
    } SEAM(2);

    if (IN(3)) {
        attn_lut(C);
#if PROBE_DUP == 31
#pragma unroll 1
        for (int hot = 1; hot >= 0; --hot) { const int hv = __builtin_amdgcn_readfirstlane(hot); for (;;) { const int it = q_next(C, CW_Q3 + 256 * hv); if (it >= 320) break; dscan_unit(C, it, hv); } xcd_barrier(bar); }
#else
        for (;;) { const int it = q_next(C, CW_Q3); if (it >= 320) break; dscan_unit(C, it); }
#endif
        REFRESH_IDS();
#if WUP_EARLY && WUP_MIX > 0
        {
            bool more = true;
            for (;;) { const int it = q_next(C, CW_Q3 + 64); if (it >= 1152) break; attn_unit(C, it);
                if (more) { REFRESH_IDS(); more = transpose_grabs<2>(C, inp(C, I_WUP), DM, DFF2, (bf16*)(C.ws + WS_WUP), (DM / 64) * (DFF2 / 32), CW_QT5 + 64, WUP_SPLIT, 1 << 30, 16384, 8704, WUP_MIX); REFRESH_IDS(); } }
        }
#else
        for (;;) { const int it = q_next(C, CW_Q3 + 64); if (it >= 1152) break; attn_unit(C, it); }
#endif
#if WUP_EARLY
        REFRESH_IDS();
        transpose_queue<2>(C, inp(C, I_WUP), DM, DFF2, (bf16*)(C.ws + WS_WUP), (DM / 64) * (DFF2 / 32), CW_QT5 + 64, WUP_SPLIT, 1 << 30, 16384, 8704);
#endif
        if (PROBE_DUP == 3) { xcd_barrier(bar); for (;;) { const int it = q_next(C, CW_Q3 + 256); if (it >= 320) break; dscan_unit(C, it); } }
        if (PROBE_DUP == 6) { xcd_barrier(bar); for (;;) { const int it = q_next(C, CW_Q3 + 320); if (it >= 1152) break; attn_unit(C, it); } }
    } SEAM(3);

    if (IN(4)) {
        pg8::StaticOrder S; S.init(MTOK, DM, C.G, C.bid); S.wgm = GEMM_WGM_RES; S.xs = GEMM_XS;
#if MIX_FP8
        pg8::Gemm g{(const pg8::bf16_t*)(C.ws + WS_CAT), (const pg8::bf16_t*)(C.ws + WS_WO), MTOK, DM, DM / 2, DM / 2};
        EpiRes E{(const bf16*)(C.ws + WS_XN), (bf16*)(C.ws + WS_PRE1), 0, 1.f / (CAT_Q * WO_Q), (float*)(C.ws + WS_P2), (unsigned*)(C.ctl + CW_TIX2)};
        S.lim = 1024;
        pg8::gemm_phase<EpiRes, pg8::StaticOrder, true, true, true>(C.lds, g, S, E);
        { pg8::TailOrder T{S, 1024, 2, 16, 16}; pg8::gemm_phase<EpiRes, pg8::TailOrder, true, true, true>(C.lds, g, T, E); }
#else
        pg8::Gemm g{(const pg8::bf16_t*)(C.ws + WS_CAT), (const pg8::bf16_t*)(C.ws + WS_WO), MTOK, DM, DM, DM};
        EpiRes E{(const bf16*)(C.ws + WS_XN), (bf16*)(C.ws + WS_PRE1), 0, 1.f, nullptr, nullptr};
        pg8::gemm_phase<EpiRes, pg8::StaticOrder, true, true>(C.lds, g, S, E);
#endif
    } SEAM(4);

    if (IN(5)) { phase5(C); if (PROBE_DUP == 1) { xcd_barrier(bar); phase5(C); } } SEAM(5);

    if (IN(6)) {
        pg8::Gemm g{(const pg8::bf16_t*)(C.ws + WS_XN), (const pg8::bf16_t*)(C.ws + WS_WUP), MTOK, DFF2, DM, LDX};
        pg8::StaticOrder S; S.init(MTOK, DFF2, C.G, C.bid); S.wgm = GEMM_WGM; S.xs = GEMM_XS;
        EpiUpAct E{(bf16*)(C.ws + WS_ACT), (bf16*)(C.ws + WS_UPS), C.out, inp(C, I_FCW), inp(C, I_FCB), (LAS float*)(C.lds + EPIW_OFF), (float*)(C.ws + WS_P3), (unsigned*)(C.ctl + CW_T3)};
#if UP_TAIL_SPLIT
        S.lim = 6144;
        pg8::gemm_phase<EpiUpAct, pg8::StaticOrder, true, true>(C.lds, g, S, E);
        { pg8::TailOrder T{S, 6144, UPT_NS, 64 / UPT_NS, 64 / UPT_NS}; pg8::gemm_phase<EpiUpAct, pg8::TailOrder, true, true>(C.lds, g, T, E); }
#else
        pg8::gemm_phase<EpiUpAct, pg8::StaticOrder, true, true>(C.lds, g, S, E);
#endif
        REFRESH_IDS();
        if (PROBE_DUP == 40) { xcd_barrier(bar); pg8::gemm_phase<EpiUpAct, pg8::StaticOrder, true, true>(C.lds, g, S, E); REFRESH_IDS(); }
        if (PROBE_DUP == 41) { xcd_barrier(bar); EpiNull EN{(float*)(C.ws + WS_P2)}; pg8::gemm_phase<EpiNull, pg8::StaticOrder, true, true>(C.lds, g, S, EN); REFRESH_IDS(); }
        transpose_queue<FFN_DOWN_FP8 ? 3 : 0>(C, inp(C, I_WDN), DFF, DM, (bf16*)(C.ws + WS_WDN), (DFF / 64) * (DM / 32), CW_QT6);
    } SEAM(6);
    if (IN(7)) { ffn_fixup(C); } SEAM(7);
    if (IN(8)) {
#if FFN_DOWN_FP8
        pg8::Gemm g{(const pg8::bf16_t*)(C.ws + WS_ACT), (const pg8::bf16_t*)(C.ws + WS_WDN), MTOK, DM, DFF / 2, DFF / 2};
        pg8::StaticOrder S; S.init(MTOK, DM, C.G, C.bid); S.wgm = GEMM_WGM_RES; S.xs = GEMM_XS;
        EpiRes E{(const bf16*)(C.ws + WS_XN), (bf16*)(C.ws + WS_PRE2), 0, 1.f / (ACT_Q * WDN_Q), (float*)(C.ws + WS_P2), (unsigned*)(C.ctl + CW_TIX4)};
        S.lim = 1024;
        pg8::gemm_phase<EpiRes, pg8::StaticOrder, true, true, true>(C.lds, g, S, E);
        { pg8::TailOrder T{S, 1024, 2, 44, 42}; pg8::gemm_phase<EpiRes, pg8::TailOrder, true, true, true>(C.lds, g, T, E); }
#else
        pg8::Gemm g{(const pg8::bf16_t*)(C.ws + WS_ACT), (const pg8::bf16_t*)(C.ws + WS_WDN), MTOK, DM, DFF, DFF};
        pg8::StaticOrder S; S.init(MTOK, DM, C.G, C.bid); S.wgm = GEMM_WGM_RES; S.xs = GEMM_XS;
        EpiRes E{(const bf16*)(C.ws + WS_XN), (bf16*)(C.ws + WS_PRE2), 0, 1.f, nullptr, nullptr};
        pg8::gemm_phase<EpiRes, pg8::StaticOrder, true, true>(C.lds, g, S, E);
#endif
    } SEAM(8);

    if (IN(9)) {
        const int gw = C.bid * NWAVES + C.wave, NGW = C.G * NWAVES;
        LnP P; ln_params(P, inp(C, I_LN2G), inp(C, I_LN2B), C.lane);
#pragma unroll 1
        for (int m = gw; m < MTOK; m += NGW) ln_row<true, true, true>((const bf16*)(C.ws + WS_PRE2) + (size_t)m * DM, P, C.out + O_Y + (size_t)m * DM, C.lane, (const unsigned*)(C.ctl + CW_TIX4) + (m >> 8) * 16, (const float*)(C.ws + WS_P2), m & 255);
    }
#undef IN
#undef SEAM
}

extern "C" void kernel_launch(void* const* d_in, const int* in_sizes, int n_in, void* d_out, int out_size, void* d_ws, size_t ws_size, hipStream_t stream) {
    static int grid = 0;
    if (grid == 0) {
        if (n_in != 26 || (size_t)out_size != O_END || ws_size < WS_END) { fprintf(stderr, "kernel_launch: unexpected shapes: n_in %d out %d ws %zu (need %zu)\n", n_in, out_size, ws_size, (size_t)WS_END); grid = -1; return; }
        int dev = 0, cus = 0, per_cu = 0;
        if (hipGetDevice(&dev) != hipSuccess || hipDeviceGetAttribute(&cus, hipDeviceAttributeMultiprocessorCount, dev) != hipSuccess) { grid = -1; return; }
        if (hipFuncSetAttribute((const void*)fwd_kernel, hipFuncAttributeMaxDynamicSharedMemorySize, LDS_BYTES) != hipSuccess) { fprintf(stderr, "kernel_launch: hipFuncSetAttribute failed\n"); grid = -1; return; }
        if (hipOccupancyMaxActiveBlocksPerMultiprocessor(&per_cu, (const void*)fwd_kernel, NWAVES * 64, LDS_BYTES) != hipSuccess || per_cu < 1) { fprintf(stderr, "kernel_launch: occupancy query says %d\n", per_cu); }
        (void)hipGetLastError();
        grid = cus;
    }
    if (grid < 0) return;
    if (hipMemsetAsync((char*)d_ws + WS_CTL, 0, CTL_ZERO_BYTES, stream) != hipSuccess) return;
    Args a{};
    for (int i = 0; i < 26; ++i) a.in[i] = (const float*)d_in[i];
    a.out = (float*)d_out; a.ws = (unsigned char*)d_ws;
#if MK_PER_PHASE
    for (int p = 0; p < N_PHASES; ++p) { a.ph_lo = p; a.ph_hi = p + 1; hipLaunchKernelGGL(fwd_kernel, dim3(grid), dim3(NWAVES * 64), LDS_BYTES, stream, a); }
#else
    a.ph_lo = 0; a.ph_hi = N_PHASES;
    hipLaunchKernelGGL(fwd_kernel, dim3(grid), dim3(NWAVES * 64), LDS_BYTES, stream, a);
#endif
    const hipError_t le = hipPeekAtLastError();
    if (le != hipSuccess) fprintf(stderr, "kernel_launch: launch failed: %s\n", hipGetErrorName(le));
}
```

```cpp
#include <hip/hip_runtime.h>
#include <cstdio>
#include <cstdint>
namespace pg8 {
#define PG8_LAS __attribute__((address_space(3)))
typedef unsigned short bf16_t;
typedef short bf16x8 __attribute__((ext_vector_type(8)));
typedef float f32x4 __attribute__((ext_vector_type(4)));
typedef unsigned u32x4 __attribute__((ext_vector_type(4)));
constexpr int BM = 256, BK = 64, HALF = 128, HTB = HALF * BK * 2  , STAGE_BYTES = 8 * HTB, NXCD = 8, WGM = 8;

__host__ __device__ __forceinline__ int lds_byte(int r, int c) { const int st = (r >> 4) * 2 + (c >> 5), rr = r & 15, cc = c & 31, ob = rr * 64 + cc * 2; return st * 1024 + (ob ^ (((ob >> 9) & 1) << 5)); }
__host__ __device__ __forceinline__ void stage_rc(int b, int& R, int& C) { const int st = b / 1024, sb = b % 1024, swz = sb ^ (((sb >> 9) & 1) << 5); R = (st >> 1) * 16 + swz / 64; C = (st & 1) * 32 + (swz % 64) / 2; }
__host__ __device__ __forceinline__ int perm32(int rho) { const int n = rho >> 4, i = rho & 15; return 8 * (i >> 2) + 4 * n + (i & 3); }

struct Unit { int pm, pn, koff, part, kn, tidx; };
struct Gemm { const bf16_t* A; const bf16_t* Bt; int M, N, K, lda; };

struct StaticOrder {
    int nM, nN, nwg, G, c, lim, wgm, xs;
    __host__ __device__ void init(int M, int N, int G_, int c_) { nM = M / BM; nN = N / BM; nwg = nM * nN; G = G_; c = c_; lim = nwg; wgm = WGM; xs = 0; }
    __host__ __device__ void map(long L, Unit& u) const {
        if (xs) {
            const int x = (int)(L % NXCD), e = (int)(L / NXCD), per = nM / NXCD, nig = wgm * nN, k = e / nig, w = e % nig;
            u.pm = x * per + k * wgm + w % wgm; u.pn = w / wgm; u.koff = 0; u.part = 0; u.kn = 0; u.tidx = 0; return;
        }
        int wgid = (int)L; { const int q = nwg / NXCD, r = nwg % NXCD, xcd = wgid % NXCD, off = wgid / NXCD; wgid = (xcd < r ? xcd * (q + 1) : r * (q + 1) + (xcd - r) * q) + off; }
        const int nig = wgm * nN, gid = wgid / nig, fm = gid * wgm, gsz = (nM - fm) < wgm ? (nM - fm) : wgm;
        u.pm = fm + ((wgid % nig) % gsz); u.pn = (wgid % nig) / gsz; u.koff = 0; u.part = 0; u.kn = 0; u.tidx = 0;
    }
    __host__ __device__ bool next(int i, Unit& u) const {
        const long L = (long)i * G + c; if (L >= lim) return false;
        map(L, u); return true;
    }
    __device__ __forceinline__ void a_ready(const Unit&) const {}
    __device__ __forceinline__ void done(const Unit&) const {}
};

struct TailOrder {
    StaticOrder S; int L0, nsplit, kt0, kt1;
    __host__ __device__ bool next(int i, Unit& u) const {
        if (i > 0) return false; const long L = L0 + S.c / nsplit; if (L >= S.nwg) return false;
        S.map(L, u); u.part = S.c % nsplit; u.koff = u.part == 0 ? 0 : (kt0 + (u.part - 1) * kt1) * BK; u.kn = u.part == 0 ? kt0 : kt1; u.tidx = (int)(L - L0); return true;
    }
    __device__ __forceinline__ void a_ready(const Unit&) const {}
    __device__ __forceinline__ void done(const Unit&) const {}
};
__device__ __forceinline__ unsigned cvt_pk_bf16(float lo, float hi) { unsigned r; asm volatile("v_cvt_pk_bf16_f32 %0, %1, %2" : "=v"(r) : "v"(lo), "v"(hi)); return r; }
typedef float f32x2 __attribute__((ext_vector_type(2)));

typedef int v8i_t __attribute__((ext_vector_type(8)));
__device__ __forceinline__ v8i_t cat16(bf16x8 lo, bf16x8 hi) { const u32x4 a = __builtin_bit_cast(u32x4, lo), b = __builtin_bit_cast(u32x4, hi); return (v8i_t){(int)a.x, (int)a.y, (int)a.z, (int)a.w, (int)b.x, (int)b.y, (int)b.z, (int)b.w}; }
template <class Epi, class Sched, bool ALIGN_EPI = false, bool SP2 = false, bool F8 = false>
__device__ __forceinline__ void gemm_phase(PG8_LAS unsigned char* lds, const Gemm g, const Sched& S, const Epi& E) {
    const int tid = threadIdx.x, wid = __builtin_amdgcn_readfirstlane(tid >> 6), lane = tid & 63, wr = wid >> 2, wc = wid & 3, fr = lane & 15, fq = lane >> 4;
    const int K = g.lda, nt = g.K / BK;
    unsigned voffA[2], voffB[2];
#pragma unroll
    for (int i = 0; i < 2; ++i) { int R, C; stage_rc(tid * 16 + i * 8192, R, C); const int Rb = Epi::PERM ? ((R & ~31) + perm32(R & 31)) : R;
        voffA[i] = (unsigned)(R * K + C) * 2u; voffB[i] = (unsigned)(Rb * K + C) * 2u; }
    const size_t kstep = (size_t)(BK * 2);
    const size_t hstep = (size_t)HALF * K * 2;
    const size_t tstep = 2 * hstep;
    const unsigned ldsw = (unsigned)wid * 1024u;
    const int aoff = lds_byte(wr * 64 + fr, fq * 8), boff = lds_byte(wc * 32 + fr, fq * 8);
#define PG8_SA(b, h) (((b) * 2 + (h)) * HTB)
#define PG8_SB(b, h) ((4 + (b) * 2 + (h)) * HTB)
#define PG8_STAGE(bufoff, gbase, voff) do { _Pragma("unroll") for (int _i = 0; _i < 2; ++_i) \
        __builtin_amdgcn_global_load_lds((const unsigned*)((const char*)(gbase) + (voff)[_i]), (PG8_LAS unsigned*)(lds + (bufoff) + ldsw + _i * 8192), 16, 0, 0); } while (0)
#define PG8_LDA(dst, b, h) do { if constexpr (F8) { _Pragma("unroll") for (int m = 0; m < 4; ++m) dst##8[m] = cat16(*(const PG8_LAS bf16x8*)(lds + PG8_SA(b, h) + aoff + m * 2048), *(const PG8_LAS bf16x8*)(lds + PG8_SA(b, h) + aoff + m * 2048 + 1024)); } \
        else { _Pragma("unroll") for (int m = 0; m < 4; ++m) _Pragma("unroll") for (int k = 0; k < 2; ++k) dst[m][k] = *(const PG8_LAS bf16x8*)(lds + PG8_SA(b, h) + aoff + m * 2048 + k * 1024); } } while (0)
#define PG8_LDB(dst, b, h) do { if constexpr (F8) { _Pragma("unroll") for (int n = 0; n < 2; ++n) dst##8[n] = cat16(*(const PG8_LAS bf16x8*)(lds + PG8_SB(b, h) + boff + n * 2048), *(const PG8_LAS bf16x8*)(lds + PG8_SB(b, h) + boff + n * 2048 + 1024)); } \
        else { _Pragma("unroll") for (int n = 0; n < 2; ++n) _Pragma("unroll") for (int k = 0; k < 2; ++k) dst[n][k] = *(const PG8_LAS bf16x8*)(lds + PG8_SB(b, h) + boff + n * 2048 + k * 1024); } } while (0)
#define PG8_MMA(ai, bj, At, Bt) do { __builtin_amdgcn_s_setprio(1); \
        if constexpr (F8) { _Pragma("unroll") for (int m = 0; m < 4; ++m) _Pragma("unroll") for (int n = 0; n < 2; ++n) \
            asm volatile("v_mfma_f32_16x16x128_f8f6f4 %0, %1, %2, %0" : "+v"(acc[ai][bj][m][n]) : "v"(Bt##8[n]), "v"(At##8[m])); } \
        else { _Pragma("unroll") for (int m = 0; m < 4; ++m) _Pragma("unroll") for (int n = 0; n < 2; ++n) _Pragma("unroll") for (int k = 0; k < 2; ++k) \
            acc[ai][bj][m][n] = __builtin_amdgcn_mfma_f32_16x16x32_bf16(Bt[n][k], At[m][k], acc[ai][bj][m][n], 0, 0, 0); } \
        __builtin_amdgcn_s_setprio(0); } while (0)
#define PG8_WAIT_V(n) asm volatile("s_waitcnt vmcnt(" #n ")" ::: "memory")
#define PG8_WAIT_L(n) asm volatile("s_waitcnt lgkmcnt(" #n ")" ::: "memory")
#define PG8_BAR __builtin_amdgcn_s_barrier()
#define PG8_SCHED __builtin_amdgcn_sched_barrier(0)
    Unit cur, nxt; int ui = 0;
    if (!S.next(0, cur)) return;
    f32x4 acc[2][2][4][2];
#pragma unroll
    for (int a = 0; a < 2; ++a)
#pragma unroll
        for (int b = 0; b < 2; ++b)
#pragma unroll
            for (int m = 0; m < 4; ++m)
#pragma unroll
                for (int n = 0; n < 2; ++n) acc[a][b][m][n] = (f32x4){0.f, 0.f, 0.f, 0.f};
    bf16x8 At[4][2], B0[2][2], B1[2][2]; v8i_t At8[4], B08[2], B18[2];
    const char* cA = (const char*)g.A + (size_t)cur.pm * tstep + (size_t)cur.koff * 2; const char* cB = (const char*)g.Bt + (size_t)cur.pn * tstep + (size_t)cur.koff * 2;
    S.a_ready(cur);
    if constexpr (SP2) {
        PG8_STAGE(PG8_SB(0, 0), cB, voffB); PG8_STAGE(PG8_SB(0, 1), cB + hstep, voffB); PG8_STAGE(PG8_SA(0, 0), cA, voffA); PG8_STAGE(PG8_SA(0, 1), cA + hstep, voffA);
        if (wr == 1) PG8_BAR;
        PG8_WAIT_V(2); PG8_BAR;
        PG8_STAGE(PG8_SB(1, 0), cB + kstep, voffB); PG8_STAGE(PG8_SA(1, 0), cA + kstep, voffA); PG8_STAGE(PG8_SB(1, 1), cB + hstep + kstep, voffB);
        PG8_WAIT_V(6); PG8_BAR;
    } else {
        PG8_STAGE(PG8_SB(0, 0), cB, voffB); PG8_STAGE(PG8_SA(0, 0), cA, voffA); PG8_STAGE(PG8_SB(0, 1), cB + hstep, voffB); PG8_STAGE(PG8_SA(0, 1), cA + hstep, voffA);
        if (wr == 1) PG8_BAR;
        PG8_WAIT_V(4); PG8_BAR;
        PG8_STAGE(PG8_SB(1, 0), cB + kstep, voffB); PG8_STAGE(PG8_SA(1, 0), cA + kstep, voffA); PG8_STAGE(PG8_SB(1, 1), cB + hstep + kstep, voffB);
        PG8_WAIT_V(6); PG8_BAR;
    }
    for (;;) {
        const bool has_next = S.next(ui + 1, nxt);
        const char* nA = has_next ? (const char*)g.A + (size_t)nxt.pm * tstep + (size_t)nxt.koff * 2 : cA; const char* nB = has_next ? (const char*)g.Bt + (size_t)nxt.pn * tstep + (size_t)nxt.koff * 2 : cB;
        const int ntu = cur.kn > 0 ? cur.kn : nt;
        for (int t = 0; t < ntu; t += 2) {
            const bool last = (t == ntu - 2);
            const char* a1 = cA + (size_t)(t + 1) * kstep;
            const char* a2 = last ? nA : cA + (size_t)(t + 2) * kstep; const char* b2 = last ? nB : cB + (size_t)(t + 2) * kstep;
            const char* a3 = a2 + kstep; const char* b3 = b2 + kstep;
            if (last && has_next) S.a_ready(nxt);
            if constexpr (SP2) {
            PG8_LDB(B0, 0, 0); PG8_LDB(B1, 0, 1); PG8_SCHED; PG8_LDA(At, 0, 0); PG8_STAGE(PG8_SA(1, 1), a1 + hstep, voffA);
            PG8_WAIT_V(8); PG8_WAIT_L(0); PG8_BAR; PG8_MMA(0, 0, At, B0); PG8_MMA(0, 1, At, B1); PG8_BAR; PG8_SCHED;
            PG8_LDA(At, 0, 1); PG8_STAGE(PG8_SB(0, 0), b2, voffB); PG8_STAGE(PG8_SB(0, 1), b2 + hstep, voffB); PG8_STAGE(PG8_SA(0, 0), a2, voffA);
            PG8_WAIT_V(8); PG8_WAIT_L(0); PG8_BAR; PG8_MMA(1, 0, At, B0); PG8_MMA(1, 1, At, B1); PG8_BAR; PG8_SCHED;
            PG8_LDB(B0, 1, 0); PG8_LDB(B1, 1, 1); PG8_SCHED; PG8_LDA(At, 1, 0); PG8_STAGE(PG8_SA(0, 1), a2 + hstep, voffA);
            PG8_WAIT_V(8); PG8_WAIT_L(0); PG8_BAR; PG8_MMA(0, 0, At, B0); PG8_MMA(0, 1, At, B1); PG8_BAR; PG8_SCHED;
            PG8_LDA(At, 1, 1); PG8_STAGE(PG8_SB(1, 0), b3, voffB); PG8_STAGE(PG8_SB(1, 1), b3 + hstep, voffB); PG8_STAGE(PG8_SA(1, 0), a3, voffA);
            PG8_WAIT_V(8); PG8_WAIT_L(0); PG8_BAR; PG8_MMA(1, 0, At, B0); PG8_MMA(1, 1, At, B1); PG8_BAR; PG8_SCHED;
            } else {
            PG8_LDB(B0, 0, 0); PG8_SCHED; PG8_LDA(At, 0, 0); PG8_STAGE(PG8_SA(1, 1), a1 + hstep, voffA);
            PG8_WAIT_L(8); PG8_BAR; PG8_WAIT_L(0); PG8_MMA(0, 0, At, B0); PG8_BAR; PG8_SCHED;
            PG8_LDB(B1, 0, 1); PG8_STAGE(PG8_SB(0, 0), b2, voffB);
            PG8_BAR; PG8_WAIT_L(0); PG8_MMA(0, 1, At, B1); PG8_BAR;
            PG8_LDA(At, 0, 1); PG8_STAGE(PG8_SA(0, 0), a2, voffA);
            PG8_BAR; PG8_WAIT_L(0); PG8_MMA(1, 0, At, B0); PG8_BAR; PG8_SCHED;
            PG8_STAGE(PG8_SB(0, 1), b2 + hstep, voffB);
            PG8_WAIT_V(6); PG8_BAR; PG8_MMA(1, 1, At, B1); PG8_BAR;
            PG8_LDB(B0, 1, 0); PG8_SCHED; PG8_LDA(At, 1, 0); PG8_STAGE(PG8_SA(0, 1), a2 + hstep, voffA);
            PG8_WAIT_L(8); PG8_BAR; PG8_WAIT_L(0); PG8_MMA(0, 0, At, B0); PG8_BAR; PG8_SCHED;
            PG8_LDB(B1, 1, 1); PG8_STAGE(PG8_SB(1, 0), b3, voffB);
            PG8_BAR; PG8_WAIT_L(0); PG8_MMA(0, 1, At, B1); PG8_BAR;
            PG8_LDA(At, 1, 1); PG8_STAGE(PG8_SA(1, 0), a3, voffA);
            PG8_BAR; PG8_WAIT_L(0); PG8_MMA(1, 0, At, B0); PG8_BAR; PG8_SCHED;
            PG8_STAGE(PG8_SB(1, 1), b3 + hstep, voffB);
            PG8_WAIT_V(6); PG8_BAR; PG8_MMA(1, 1, At, B1); PG8_BAR;
            }
        }
        if constexpr (F8) asm volatile("s_nop 15\n\ts_nop 15" ::: "memory");
        if constexpr (ALIGN_EPI) { if (wr == 0) PG8_BAR; }
        if constexpr (!Epi::AFTER_DRAIN) { E(acc, cur, wr, wc, fr, fq); S.done(cur); }
        if (!has_next) break;
#pragma unroll
        for (int a = 0; a < 2; ++a)
#pragma unroll
            for (int b = 0; b < 2; ++b)
#pragma unroll
                for (int m = 0; m < 4; ++m)
#pragma unroll
                    for (int n = 0; n < 2; ++n) acc[a][b][m][n] = (f32x4){0.f, 0.f, 0.f, 0.f};
        cur = nxt; cA = nA; cB = nB; ++ui;
        if constexpr (ALIGN_EPI) { if (wr == 1) PG8_BAR; }
    }
    PG8_WAIT_V(0);
    if constexpr (!ALIGN_EPI) { if (wr == 0) PG8_BAR; }
    PG8_BAR;
    if constexpr (Epi::AFTER_DRAIN) { E.fused(acc, cur, wr, wc, fr, fq, lds, wid, lane); S.done(cur); }
#undef PG8_SA
#undef PG8_SB
#undef PG8_STAGE
#undef PG8_LDA
#undef PG8_LDB
#undef PG8_MMA
#undef PG8_WAIT_V
#undef PG8_WAIT_L
#undef PG8_BAR
#undef PG8_SCHED
}
}

#define GAS __attribute__((address_space(1)))
#define LAS __attribute__((address_space(3)))
typedef unsigned short bf16;
typedef unsigned v4u __attribute__((ext_vector_type(4)));
typedef unsigned v2u __attribute__((ext_vector_type(2)));
typedef float f32x4 __attribute__((ext_vector_type(4)));
typedef float f32x2 __attribute__((ext_vector_type(2)));
typedef short bf16x8 __attribute__((ext_vector_type(8)));
typedef GAS unsigned gu32;

constexpr int NWAVES = 8;
constexpr int DM = 4096;
constexpr int NPROW = 16384, NSROW = 2048, MTOK = NPROW + NSROW;
constexpr int PSEQ = 2048, SSEQ = 64, PAST = 1024, NPB = 8, NSB = 32;
#ifndef LDX_PAD
#define LDX_PAD 0
#endif
constexpr int LDX = 4096 + LDX_PAD;
constexpr int LDH = 12544;
constexpr int HQ = 0, HK = 2048, HV = 2560, HIQ = 3072, HQKV = 4096, HZ = 10240, HSM = 12288;
constexpr int NIN = 12400, CQKV = 6144, DFF = 11008, DFF2 = 22016;
constexpr int TOPK = 256;
constexpr float LN_EPS = 1e-5f;
constexpr float ALPHA = 1.189207115002721f;
constexpr float IDX_SCALE = 0.03125f;
constexpr float QSCALE = 0.08838834764831845f;

constexpr size_t O_Y = 0;
constexpr size_t O_PK = (size_t)MTOK * DM;
constexpr size_t O_PV = O_PK + (size_t)NPROW * 512;
constexpr size_t O_PIK = O_PV + (size_t)NPROW * 512;
constexpr size_t O_PDELTA = O_PIK + (size_t)NPROW * 64;
constexpr size_t O_PCONV = O_PDELTA + (size_t)NPB * 16 * 128 * 128;
constexpr size_t O_PFFN = O_PCONV + (size_t)NPB * 3 * CQKV;
constexpr size_t O_SK = O_PFFN + (size_t)NPB * 2 * DFF2;
constexpr size_t O_SV = O_SK + (size_t)NSROW * 512;
constexpr size_t O_SIK = O_SV + (size_t)NSROW * 512;
constexpr size_t O_SDELTA = O_SIK + (size_t)NSROW * 64;
constexpr size_t O_SCONV = O_SDELTA + (size_t)NSB * 16 * 128 * 128;
constexpr size_t O_SFFN = O_SCONV + (size_t)NSB * 3 * CQKV;
constexpr size_t O_END = O_SFFN + (size_t)NSB * 2 * DFF2;
static_assert(O_END == 108535808ull, "d_out map");
constexpr size_t OS_SC = 0;
constexpr size_t OS_SM = (size_t)MTOK * 2048;
constexpr size_t OS_VTP = OS_SM + (size_t)MTOK * 128;
constexpr size_t OS_VTS = OS_VTP + (size_t)NPB * 4 * 128 * PSEQ / 2;
constexpr int SLEN = PAST + SSEQ;
constexpr int NDU = 9216;
constexpr size_t OS_TBF = ((OS_VTS + (size_t)NSB * 4 * 128 * SLEN / 2) + 3) & ~(size_t)3;
constexpr size_t OS_TGF = OS_TBF + (size_t)NDU * 512;
constexpr size_t OS_MFF = OS_TGF + (size_t)NDU * 512;
constexpr size_t OS_GB = OS_MFF + (size_t)NDU * 512;
constexpr size_t OS_MSK = OS_GB + (size_t)MTOK * 16;
static_assert(OS_MSK % 4 == 0 && OS_MSK + (size_t)MTOK * 64 <= O_PK, "scratch in y region");


constexpr size_t MiB = 1u << 20;
constexpr size_t WS_CTL = 0, CTL_ZERO_BYTES = 64 * 1024;
constexpr size_t WS_WO = 1 * MiB;
constexpr size_t WS_XN = WS_WO + 32 * MiB;
constexpr size_t WS_CAT = WS_XN + 150 * MiB;
constexpr size_t WS_WIN = WS_CAT + 144 * MiB;
constexpr size_t WS_H = WS_WIN + 102 * MiB;
constexpr size_t WS_QKVC = WS_H + 441 * MiB;
constexpr size_t WS_END = WS_QKVC + 216 * MiB;
#ifndef WUP_EARLY
#define WUP_EARLY 1
#endif
#if WUP_EARLY
constexpr size_t WS_WUP = WS_CAT + 72 * MiB;
constexpr size_t WS_WDN = WS_CAT;
static_assert((size_t)MTOK * DM <= 72 * MiB && (size_t)DM * DFF <= 72 * MiB && WS_WUP + (size_t)DFF2 * LDX * 2 <= WS_H, "early w_up layout");
#else
constexpr size_t WS_WUP = WS_CAT;
constexpr size_t WS_WDN = WS_WUP + 178 * MiB;
#endif
constexpr size_t WS_ACT = WS_CAT + 264 * MiB;
constexpr size_t WS_P2 = WS_CAT + 706 * MiB;
constexpr size_t WS_PRE1 = WS_ACT;
constexpr size_t WS_PRE2 = WS_WUP;
constexpr size_t WS_P3 = WS_ACT + 194 * MiB;
constexpr size_t WS_UPS = WS_ACT + 388 * MiB;
static_assert((size_t)MTOK * LDH * 2 <= 441 * MiB && (size_t)LDH * LDX * 2 <= 102 * MiB && (size_t)MTOK * LDX * 2 <= 150 * MiB && (size_t)MTOK * CQKV * 2 <= 216 * MiB, "ws sizes");
static_assert((size_t)DFF2 * LDX * 2 <= 178 * MiB && (size_t)DM * DFF * 2 <= 86 * MiB && (size_t)MTOK * DFF * 2 <= 388 * MiB && WS_UPS + (size_t)288 * 4 * DFF2 * 2 <= WS_P2 && WS_P2 + (size_t)128 * 65536 * 4 <= WS_END, "ffn ws sizes");

constexpr int CW_QT1 = 1024, CW_QT6 = 1088, CW_QT5 = 1152, CW_T3 = 13312;
constexpr int CW_Q2 = 64, CW_Q3 = 128;
constexpr int CW_BAR = 4096;
constexpr int CW_XR = 12288;
constexpr int CW_TIX2 = 8192, CW_TIX4 = 8192 + 1152;

constexpr int RING_BYTES = 131072;
constexpr int LDSCTL_OFF = RING_BYTES, MISC_OFF = LDSCTL_OFF + 320;
constexpr int LDS_BYTES = 147456;
constexpr int EPIW_OFF = LDSCTL_OFF + 4096;
static_assert(EPIW_OFF + 8192 <= LDS_BYTES, "lds map");

#define RLX_AGENT __ATOMIC_RELAXED, __HIP_MEMORY_SCOPE_AGENT
#define LDS_WAIT() asm volatile("s_waitcnt lgkmcnt(0)" ::: "memory")
__device__ __forceinline__ unsigned f2bf(float f) { unsigned u = __builtin_bit_cast(unsigned, f); return (u + 0x7fffu + ((u >> 16) & 1u)) >> 16; }
typedef float f32x2_t __attribute__((ext_vector_type(2))); typedef __bf16 bf16x2_t __attribute__((ext_vector_type(2)));
__device__ __forceinline__ unsigned pk2(float lo, float hi) { f32x2_t v = {lo, hi}; bf16x2_t b = __builtin_convertvector(v, bf16x2_t); return __builtin_bit_cast(unsigned, b); }
__device__ __forceinline__ float bflo(unsigned w) { return __uint_as_float(w << 16); }
__device__ __forceinline__ float bfhi(unsigned w) { return __uint_as_float(w & 0xffff0000u); }
#define DPPF(x, ctrl) __int_as_float(__builtin_amdgcn_mov_dpp(__float_as_int(x), (ctrl), 0xf, 0xf, true))
__device__ __forceinline__ float wave_sum(float v) {
    v += DPPF(v, 0xB1); v += DPPF(v, 0x4E); v += DPPF(v, 0x141); v += DPPF(v, 0x140);
    const float s0 = __int_as_float(__builtin_amdgcn_readlane(__float_as_int(v), 0)), s1 = __int_as_float(__builtin_amdgcn_readlane(__float_as_int(v), 16));
    const float s2 = __int_as_float(__builtin_amdgcn_readlane(__float_as_int(v), 32)), s3 = __int_as_float(__builtin_amdgcn_readlane(__float_as_int(v), 48));
    return (s0 + s1) + (s2 + s3);
}
__device__ __forceinline__ float wave_max(float v) {
#pragma unroll
    for (int o = 1; o < 64; o <<= 1) v = fmaxf(v, __shfl_xor(v, o));
    return v;
}
__device__ __forceinline__ int wave_sum_i(int v) {
#pragma unroll
    for (int o = 1; o < 64; o <<= 1) v += __shfl_xor(v, o);
    return v;
}
#define DS_RD128(dst, addr, off) asm volatile("ds_read_b128 %0, %1 offset:%c2" : "=v"(dst) : "v"(addr), "i"(off))
#define DS_RDTR(dst, addr, off) asm volatile("ds_read_b64_tr_b16 %0, %1 offset:%c2" : "=v"(dst) : "v"(addr), "i"(off))
#define DS_RD64(dst, addr, off) asm volatile("ds_read_b64 %0, %1 offset:%c2" : "=v"(dst) : "v"(addr), "i"(off))
__device__ __forceinline__ float silu_f(float x) { return x * __builtin_amdgcn_rcpf(1.f + __expf(-x)); }

#define GLD32(dst, ptr, off) asm volatile("global_load_dword %0, %1, off offset:%c2 sc1" : "=&v"(dst) : "v"(ptr), "i"(off) : "memory")
#define GLD128(dst, ptr) asm volatile("global_load_dwordx4 %0, %1, off" : "=&v"(dst) : "v"(ptr) : "memory")
#define GLD128S(dst, voff, sptr, imm) asm volatile("global_load_dwordx4 %0, %1, %2 offset:%c3" : "=&v"(dst) : "v"(voff), "s"(sptr), "i"(imm) : "memory")
#ifndef FFN_DOWN_FP8
#define FFN_DOWN_FP8 1
#endif
#ifndef MIX_FP8
#define MIX_FP8 1
#endif
constexpr float CAT_Q = 16.f, WO_Q = 512.f;
constexpr float ACT_Q = 2.f, WDN_Q = 1024.f;
__device__ __forceinline__ unsigned pk4_fp8(float a, float b, float c_, float d) {
    a = __builtin_amdgcn_fmed3f(a, -448.f, 448.f); b = __builtin_amdgcn_fmed3f(b, -448.f, 448.f); c_ = __builtin_amdgcn_fmed3f(c_, -448.f, 448.f); d = __builtin_amdgcn_fmed3f(d, -448.f, 448.f);
    int w = 0; w = __builtin_amdgcn_cvt_pk_fp8_f32(a, b, w, false); w = __builtin_amdgcn_cvt_pk_fp8_f32(c_, d, w, true); return (unsigned)w;
}
#ifndef EPI_NT
#define EPI_NT 0
#endif
#if EPI_NT
#define EPI_ST(ptr, val) __builtin_nontemporal_store((val), (ptr))
#else
#define EPI_ST(ptr, val) (*(ptr) = (val))
#endif
__device__ __forceinline__ void st8f(float* p, pg8::f32x4 a, pg8::f32x4 b) { EPI_ST((pg8::f32x4*)p, a); EPI_ST((pg8::f32x4*)(p + 4), b); }
__device__ __forceinline__ void st8b(bf16* p, pg8::f32x4 a, pg8::f32x4 b) { pg8::u32x4 w; w.x = pg8::cvt_pk_bf16(a[0], a[1]); w.y = pg8::cvt_pk_bf16(a[2], a[3]); w.z = pg8::cvt_pk_bf16(b[0], b[1]); w.w = pg8::cvt_pk_bf16(b[2], b[3]); EPI_ST((pg8::u32x4*)p, w); }

struct Epi1 {
    static constexpr bool PERM = true, AFTER_DRAIN = false;
    bf16* H; float* SM; float* out;
    __device__ __forceinline__ void operator()(const pg8::f32x4 (&acc)[2][2][4][2], const pg8::Unit& u, int wr, int wc, int fr, int fq) const {
        const int pn = u.pn;
#pragma unroll
        for (int ai = 0; ai < 2; ++ai)
#pragma unroll
            for (int m = 0; m < 4; ++m) {
                const int row = u.pm * 256 + ai * 128 + wr * 64 + m * 16 + fr;
                const bool prompt = row < NPROW; const int r2 = row - NPROW;
                const int b = prompt ? (row >> 11) : (r2 >> 6), t = prompt ? (row & 2047) : (r2 & 63);
#pragma unroll
                for (int bj = 0; bj < 2; ++bj) {
                    const int col = pn * 256 + bj * 128 + wc * 32 + 8 * fq;
                    const pg8::f32x4 v0 = acc[ai][bj][m][0], v1 = acc[ai][bj][m][1];
                    st8b(H + (size_t)row * LDH + col, v0, v1);
                    if (pn >= 8 && pn < 12) {
                        int c = col - HK; const bool isv = c >= 512; if (isv) c -= 512;
                        float* dst = out + (prompt ? (isv ? O_PV : O_PK) + (size_t)row * 512 : (isv ? O_SV : O_SK) + (size_t)r2 * 512) + c;
                        st8f(dst, v0, v1);
                    } else if (pn >= 16 && pn < 40) {
                        const int tl = prompt ? t - (PSEQ - 3) : t - (SSEQ - 3);
                        if (tl >= 0) st8f(out + (prompt ? O_PCONV : O_SCONV) + (size_t)(b * 3 + tl) * CQKV + (col - HQKV), v0, v1);
                    } else if (pn == 48) {
                        const int c = col - HSM;
                        if (c < 128) st8f(SM + (size_t)row * 128 + c, v0, v1);
                        if (c < 64) st8f(out + (prompt ? O_PIK + (size_t)row * 64 : O_SIK + (size_t)r2 * 64) + c, v0, v1);
                    }
                }
            }
    }
};
struct EpiRes {
    static constexpr bool PERM = true, AFTER_DRAIN = false;
    const bf16* res; bf16* out; int row0; float sc;
    float* p2; unsigned* tix;
    __device__ __forceinline__ void operator()(const pg8::f32x4 (&acc)[2][2][4][2], const pg8::Unit& u, int wr, int wc, int fr, int fq) const {
        const int rowb = row0 + u.pm * 256 + wr * 64 + fr, colb = u.pn * 256 + wc * 32 + 8 * fq;
        if (u.part != 0) {
            float* pt = p2 + (size_t)u.tidx * 65536 + (size_t)(wr * 64 + fr) * 256 + wc * 32 + 8 * fq;
#pragma unroll
            for (int ai = 0; ai < 2; ++ai)
#pragma unroll
                for (int m = 0; m < 4; ++m)
#pragma unroll
                    for (int bj = 0; bj < 2; ++bj) st8f(pt + (size_t)(ai * 128 + m * 16) * 256 + bj * 128, acc[ai][bj][m][0] * sc, acc[ai][bj][m][1] * sc);
            if (wr == 0 && wc == 0 && fr == 0 && fq == 0) tix[u.pm * 16 + u.pn] = (unsigned)u.tidx + 1u;
            return;
        }
        pg8::u32x4 r[2][4][2];
#pragma unroll
        for (int ai = 0; ai < 2; ++ai)
#pragma unroll
            for (int m = 0; m < 4; ++m)
#pragma unroll
                for (int bj = 0; bj < 2; ++bj) GLD128(r[ai][m][bj], res + (size_t)(rowb + ai * 128 + m * 16) * LDX + colb + bj * 128);
        asm volatile("s_waitcnt vmcnt(0)" : "+v"(r[0][0][0]), "+v"(r[0][0][1]), "+v"(r[0][1][0]), "+v"(r[0][1][1]), "+v"(r[0][2][0]), "+v"(r[0][2][1]), "+v"(r[0][3][0]), "+v"(r[0][3][1]),
                                            "+v"(r[1][0][0]), "+v"(r[1][0][1]), "+v"(r[1][1][0]), "+v"(r[1][1][1]), "+v"(r[1][2][0]), "+v"(r[1][2][1]), "+v"(r[1][3][0]), "+v"(r[1][3][1]));
#pragma unroll
        for (int ai = 0; ai < 2; ++ai) {
#pragma unroll
            for (int m = 0; m < 4; ++m) {
                const int row = rowb + ai * 128 + m * 16;
#pragma unroll
                for (int bj = 0; bj < 2; ++bj) {
                    const int col = colb + bj * 128;
                    const pg8::u32x4 rr = r[ai][m][bj];
                    pg8::f32x4 v0 = acc[ai][bj][m][0] * sc, v1 = acc[ai][bj][m][1] * sc;
                    v0[0] += ALPHA * bflo(rr.x); v0[1] += ALPHA * bfhi(rr.x); v0[2] += ALPHA * bflo(rr.y); v0[3] += ALPHA * bfhi(rr.y);
                    v1[0] += ALPHA * bflo(rr.z); v1[1] += ALPHA * bfhi(rr.z); v1[2] += ALPHA * bflo(rr.w); v1[3] += ALPHA * bfhi(rr.w);
                    st8b(out + (size_t)row * DM + col, v0, v1);
                }
            }
        }
    }
};
__device__ __forceinline__ float dpp_ror1(float x) { return __int_as_float(__builtin_amdgcn_mov_dpp(__float_as_int(x), 0x121, 0xf, 0xf, true)); }
__device__ __forceinline__ float dpp_ror2(float x) { return __int_as_float(__builtin_amdgcn_mov_dpp(__float_as_int(x), 0x122, 0xf, 0xf, true)); }
#ifndef UPT_NS
#define UPT_NS 4
#endif
struct EpiUpAct {
    static constexpr bool PERM = true, AFTER_DRAIN = false;
    bf16* ACT; bf16* UPS; float* out; const float* fw; const float* fb; LAS float* wl;
    float* part; unsigned* cnt;
    __device__ __forceinline__ void operator()(const pg8::f32x4 (&acc)[2][2][4][2], const pg8::Unit& u, int wr, int wc, int fr, int fq) const {
        const int colb = u.pn * 128 + wc * 32 + 8 * fq;
        if (u.kn > 0) {
            pg8::f32x4 (&A)[2][2][4][2] = const_cast<pg8::f32x4 (&)[2][2][4][2]>(acc);
            const int lane_ = fq * 16 + fr, ws_ = wr * 4 + wc;
            float* pb = part + (size_t)u.tidx * (UPT_NS * 65536) + ws_ * 8192 + lane_ * 4;
            float* mine = pb + (size_t)u.part * 65536;
#pragma unroll
            for (int ai = 0; ai < 2; ++ai)
#pragma unroll
                for (int bj = 0; bj < 2; ++bj)
#pragma unroll
                    for (int m = 0; m < 4; ++m)
#pragma unroll
                        for (int n = 0; n < 2; ++n) asm volatile("global_store_dwordx4 %0, %1, off sc1" :: "v"(mine + (((ai * 2 + bj) * 4 + m) * 2 + n) * 256), "v"(A[ai][bj][m][n]) : "memory");
            asm volatile("s_waitcnt vmcnt(0)" ::: "memory");
            unsigned old_ = 0u;
            if (lane_ == 0) old_ = __hip_atomic_fetch_add(cnt + u.tidx * 8 + ws_, 1u, __ATOMIC_RELAXED, __HIP_MEMORY_SCOPE_AGENT);
            old_ = __builtin_amdgcn_readfirstlane(old_);
            if (old_ != (unsigned)(UPT_NS - 1)) return;
            __builtin_amdgcn_fence(__ATOMIC_ACQUIRE, "agent");
#pragma unroll 1
            for (int j = 1; j < UPT_NS; ++j) {
                const float* op = pb + (size_t)((u.part + j) % UPT_NS) * 65536;
#pragma unroll
                for (int ai = 0; ai < 2; ++ai)
#pragma unroll
                    for (int bj = 0; bj < 2; ++bj)
#pragma unroll
                        for (int m = 0; m < 4; ++m)
#pragma unroll
                            for (int n = 0; n < 2; ++n) A[ai][bj][m][n] += *(const pg8::f32x4*)(op + (((ai * 2 + bj) * 4 + m) * 2 + n) * 256);
            }
        }
        LAS float* wl_ = wl + (wr * 4 + wc) * 256;
        {
            const int lane_ = fq * 16 + fr, k = lane_ >> 3, c4 = lane_ & 7;
            const float* src = ((k & 3) == 3 ? fb : fw + (k & 3) * DFF2) + (k >> 2) * DFF + u.pn * 128 + wc * 32 + 4 * c4;
            const pg8::f32x4 wv_ = *(const pg8::f32x4*)src * ((FFN_DOWN_FP8 && k >= 4) ? ACT_Q : 1.f);
            *(LAS pg8::f32x4*)(wl_ + lane_ * 4) = wv_;
            LDS_WAIT(); asm volatile("" ::: "memory");
        }
#pragma unroll
        for (int n = 0; n < 2; ++n) {
            const int cg = colb + 4 * n;
            pg8::f32x4 W[1][8];
#pragma unroll
            for (int k = 0; k < 8; ++k) W[0][k] = *(const LAS pg8::f32x4*)(wl_ + (k * 8 + 2 * fq + n) * 4);
            const pg8::f32x4 wg0 = W[0][0], wg1 = W[0][1], wg2 = W[0][2], bg = W[0][3], wv0 = W[0][4], wv1 = W[0][5], wv2 = W[0][6], bv = W[0][7];
#pragma unroll
            for (int ai = 0; ai < 2; ++ai) {
                pg8::f32x4 g1p = {0.f, 0.f, 0.f, 0.f}, g2p = g1p, v1p = g1p, v2p = g1p;
#pragma unroll
                for (int m = 0; m < 4; ++m) {
                    const int row = u.pm * 256 + ai * 128 + wr * 64 + m * 16 + fr;
                    const pg8::f32x4 G = acc[ai][0][m][n], V = acc[ai][1][m][n];
                    pg8::f32x4 g1, g2, v1, v2, a;
#pragma unroll
                    for (int e2 = 0; e2 < 4; e2 += 2) {
                        typedef float f2_t __attribute__((ext_vector_type(2)));
                        f2_t pg1, pg2, pv1, pv2;
#pragma unroll
                        for (int q = 0; q < 2; ++q) { const int e = e2 + q;
                            g1[e] = dpp_ror1(G[e]); g2[e] = dpp_ror2(G[e]); v1[e] = dpp_ror1(V[e]); v2[e] = dpp_ror2(V[e]);
                            pg1[q] = fr == 0 ? g1p[e] : g1[e]; pg2[q] = fr < 2 ? g2p[e] : g2[e]; pv1[q] = fr == 0 ? v1p[e] : v1[e]; pv2[q] = fr < 2 ? v2p[e] : v2[e]; }
                        const f2_t G2 = {G[e2], G[e2 + 1]}, V2 = {V[e2], V[e2 + 1]};
                        const f2_t cg2 = (f2_t){bg[e2], bg[e2 + 1]} + (f2_t){wg0[e2], wg0[e2 + 1]} * pg2 + (f2_t){wg1[e2], wg1[e2 + 1]} * pg1 + (f2_t){wg2[e2], wg2[e2 + 1]} * G2;
                        const f2_t cv2 = (f2_t){bv[e2], bv[e2 + 1]} + (f2_t){wv0[e2], wv0[e2 + 1]} * pv2 + (f2_t){wv1[e2], wv1[e2 + 1]} * pv1 + (f2_t){wv2[e2], wv2[e2 + 1]} * V2;
#pragma unroll
                        for (int q = 0; q < 2; ++q) a[e2 + q] = cg2[q] * __builtin_amdgcn_rcpf(1.f + __expf(-cg2[q])) * cv2[q];
                    }
                    g1p = g1; g2p = g2; v1p = v1; v2p = v2;
                    const bool first2 = (m == 0) && fr < 2;
#if FFN_DOWN_FP8
                    if (!first2) *(unsigned*)((unsigned char*)ACT + (size_t)row * DFF + cg) = pk4_fp8(a[0], a[1], a[2], a[3]);
#else
                    if (!first2) { pg8::u32x4 t; t.x = pg8::cvt_pk_bf16(a[0], a[1]); t.y = pg8::cvt_pk_bf16(a[2], a[3]); *(unsigned long long*)(ACT + (size_t)row * DFF + cg) = (unsigned long long)t.x | ((unsigned long long)t.y << 32); }
#endif
                    if (first2 || ((m == 3) && fr >= 14)) {
                        bf16* us = UPS + (size_t)((row >> 6) * 4 + (((row & 63) + 2) & 63)) * DFF2;
                        *(unsigned long long*)(us + cg) = (unsigned long long)pg8::cvt_pk_bf16(G[0], G[1]) | ((unsigned long long)pg8::cvt_pk_bf16(G[2], G[3]) << 32);
                        *(unsigned long long*)(us + DFF + cg) = (unsigned long long)pg8::cvt_pk_bf16(V[0], V[1]) | ((unsigned long long)pg8::cvt_pk_bf16(V[2], V[3]) << 32);
                    }
                    {
                        const bool prompt = row < NPROW; const int r2 = row - NPROW;
                        const int b = prompt ? (row >> 11) : (r2 >> 6), t = prompt ? (row & 2047) : (r2 & 63);
                        const int tl = prompt ? t - (PSEQ - 2) : t - (SSEQ - 2);
                        if (tl >= 0) { float* so = out + (prompt ? O_PFFN : O_SFFN) + (size_t)(b * 2 + tl) * DFF2; *(pg8::f32x4*)(so + cg) = G; *(pg8::f32x4*)(so + DFF + cg) = V; }
                    }
                }
            }
        }
    }
};

#define XB_TMO      128
#define XB_XCNT(j)  (256  + 64 * (j))
#define XB_XSUB(j)  (1280 + 64 * (j))
#define XB_XGEN(j)  (2304 + 64 * (j))
#define XB_TOP      3328
#define XB_TOPGEN   3392
#define XCD_BAR_WORDS 3456
#define XB_SPIN_CAP (1u << 18)

__device__ __forceinline__ unsigned xb_ld(unsigned* p)              { return __hip_atomic_load(p, __ATOMIC_RELAXED, __HIP_MEMORY_SCOPE_AGENT); }
__device__ __forceinline__ unsigned xb_add(unsigned* p, unsigned v) { return __hip_atomic_fetch_add(p, v, __ATOMIC_RELAXED, __HIP_MEMORY_SCOPE_AGENT); }
__device__ __forceinline__ unsigned xb_xcc_id() { return (unsigned)__builtin_amdgcn_s_getreg((3 << 11) | 20) & 0xFu; }
#define XB_SPIN(cond, bar) do { unsigned _sp = 0; while (cond) { __builtin_amdgcn_s_sleep(1); \
    if ((++_sp & 255u) == 0u) { if (xb_ld(&(bar)[XB_TMO])) break; if (_sp > XB_SPIN_CAP) { atomicAdd(&(bar)[XB_TMO], 1u); break; } } } } while (0)

struct XcdBarrier {
    unsigned* bar; unsigned x;
    volatile LAS unsigned* st;
};

__device__ __forceinline__ XcdBarrier xcd_barrier_post(unsigned* bar, volatile LAS unsigned* st) {
    XcdBarrier b; b.bar = bar; b.x = xb_xcc_id(); b.st = st;
    if (threadIdx.x == 0) (void)xb_add(&bar[XB_XCNT(b.x)], 1u);
    return b;
}
__device__ __forceinline__ void xcd_barrier_complete(unsigned* bar, unsigned x, unsigned& nloc, unsigned& nx) {
    const unsigned G = gridDim.x * gridDim.y * gridDim.z;
    unsigned sum, cnt, mine, sp = 0u;
    for (;;) {
        sum = 0u; cnt = 0u; mine = 0u;
#pragma unroll
        for (unsigned j = 0; j < 16; ++j) { const unsigned c = xb_ld(&bar[XB_XCNT(j)]); sum += c; cnt += (c > 0u) ? 1u : 0u; mine = (j == x) ? c : mine; }
        if (sum == G) break;
        __builtin_amdgcn_s_sleep(1);
        if ((++sp & 255u) == 0u) { if (xb_ld(&bar[XB_TMO])) break; if (sp > XB_SPIN_CAP) { atomicAdd(&bar[XB_TMO], 1u); break; } }
    }
    nloc = mine > 0u ? mine : 1u; nx = cnt > 0u ? cnt : 1u;
}

__device__ __forceinline__ void xcd_barrier(const XcdBarrier& b) {
    asm volatile("s_waitcnt vmcnt(0)" ::: "memory");
    __syncthreads();
    if (threadIdx.x == 0) {
        unsigned* bar = b.bar;
        __builtin_amdgcn_s_waitcnt(0);
        unsigned nloc = b.st[0], nx = b.st[1];
        if (nloc == 0u) { xcd_barrier_complete(bar, b.x, nloc, nx); b.st[0] = nloc; b.st[1] = nx; }
        const unsigned old = xb_add(&bar[XB_XSUB(b.x)], 1u);
        const unsigned gen = old / nloc;
        if (old + 1u == (gen + 1u) * nloc) {
            __builtin_amdgcn_fence(__ATOMIC_RELEASE, "agent");
            asm volatile("s_waitcnt vmcnt(0)" ::: "memory");
            const unsigned og = xb_add(&bar[XB_TOP], 1u);
            const unsigned tg = og / nx;
            if (og + 1u == (tg + 1u) * nx) xb_add(&bar[XB_TOPGEN], 1u);
            else XB_SPIN(xb_ld(&bar[XB_TOPGEN]) == tg, bar);
            __builtin_amdgcn_fence(__ATOMIC_ACQUIRE, "agent");
            xb_add(&bar[XB_XGEN(b.x)], 1u);
            asm volatile("s_waitcnt vmcnt(0)" ::: "memory");
        } else {
            XB_SPIN(xb_ld(&bar[XB_XGEN(b.x)]) == gen, bar);
            __builtin_amdgcn_fence(__ATOMIC_ACQUIRE, "agent");
            asm volatile("s_waitcnt vmcnt(0)" ::: "memory");
        }
    }
    __syncthreads();
}

struct Ctx {
    float* out; unsigned char* ws;
    LAS unsigned char* lds; gu32* ctl;
    int tid, lane, wave, G, bid;
};
enum { I_XP = 0, I_XS, I_CK, I_CV, I_CIK, I_SDELTA, I_SCONV, I_SFFN, I_LNG, I_LNB, I_WIN, I_CQW, I_CQB, I_ALOG, I_DTB, I_DNG, I_RELB, I_WO, I_LN1G, I_LN1B, I_WUP, I_FCW, I_FCB, I_WDN, I_LN2G, I_LN2B };

constexpr int PTAB_OFF = LDSCTL_OFF + 1024;
__device__ __forceinline__ const float* inp(const Ctx& C, int i) {
    const unsigned long long v = ((const LAS unsigned long long*)(C.lds + PTAB_OFF))[i];
    const unsigned lo = __builtin_amdgcn_readfirstlane((unsigned)v), hi = __builtin_amdgcn_readfirstlane((unsigned)(v >> 32));
    return (const float*)(const GAS float*)(size_t)(((unsigned long long)hi << 32) | lo);
}
__device__ __forceinline__ int q_next(const Ctx& C, int cw) {
    volatile LAS unsigned* slot = (volatile LAS unsigned*)(C.lds + MISC_OFF) + 16;
    __syncthreads();
    if (C.tid == 0) *slot = __hip_atomic_fetch_add((unsigned*)(C.ctl + cw), 1u, __ATOMIC_RELAXED, __HIP_MEMORY_SCOPE_AGENT);
    __syncthreads();
    return (int)*slot;
}

template <int MODE> __device__ __forceinline__ int dst_row_map(int n) {
    if (MODE == 0 || MODE == 3 || MODE == 4) return n;
    if (MODE == 2) { const int v = n >= DFF, j = v ? n - DFF : n; return (j >> 7) * 256 + v * 128 + (j & 127); }
    if (n < 4096) return n;
    if (n < 4160) return HSM + (n - 4096);
    if (n < 4176) return HSM + 64 + (n - 4160);
    if (n < 12368) return n - 80;
    return n;
}
__device__ __forceinline__ void tr_load(const float* W, int K, int N, int item, int lane, float (&v)[32]) {
    const int nblk = (N + 31) / 32, kb = item / nblk, nb = item % nblk, k0 = 64 * kb, n0 = 32 * nb;
    const int nn = min(n0 + (lane & 31), N - 1);
    const float* src = W + (size_t)(k0 + (lane >> 5)) * N + nn;
#pragma unroll
    for (int i = 0; i < 32; ++i) v[i] = src[(size_t)(2 * i) * N];
}
template <int MODE> __device__ __forceinline__ void tr_store(int K, int N, bf16* WT, LAS float* scr, int item, int lane, const float (&v)[32]) {
    const int ldw = (MODE == 1 || MODE == 2) ? LDX : K;
    const int nblk = (N + 31) / 32, kb = item / nblk, nb = item % nblk, k0 = 64 * kb, n0 = 32 * nb;
#pragma unroll
    for (int i = 0; i < 32; ++i) scr[(2 * i + (lane >> 5)) * 33 + (lane & 31)] = v[i];
    LDS_WAIT(); asm volatile("" ::: "memory");
    const int c = lane & 7;
#pragma unroll
    for (int j = 0; j < 4; ++j) { const int n = (lane >> 3) + 8 * j; const LAS float* s = scr + (8 * c) * 33 + n;
        v4u o; o.x = pk2(s[0 * 33], s[1 * 33]); o.y = pk2(s[2 * 33], s[3 * 33]); o.z = pk2(s[4 * 33], s[5 * 33]); o.w = pk2(s[6 * 33], s[7 * 33]);
        if (MODE == 3 || MODE == 4) { const float WQ_ = MODE == 3 ? WDN_Q : WO_Q; if (n0 + n < N) { v2u q; q.x = pk4_fp8(s[0 * 33] * WQ_, s[1 * 33] * WQ_, s[2 * 33] * WQ_, s[3 * 33] * WQ_); q.y = pk4_fp8(s[4 * 33] * WQ_, s[5 * 33] * WQ_, s[6 * 33] * WQ_, s[7 * 33] * WQ_);
                                          *(v2u*)((unsigned char*)WT + (size_t)(n0 + n) * K + k0 + 8 * c) = q; } }
        else if (n0 + n < N) *(v4u*)(WT + (size_t)dst_row_map<MODE>(n0 + n) * ldw + k0 + 8 * c) = o; }
    LDS_WAIT(); asm volatile("" ::: "memory");
}
template <int MODE> __device__ __forceinline__ void transpose_static(const float* W, int K, int N, bf16* WT, int total, LAS float* scr, int gw, int NGW, int lane) {
    float a[32], b[32];
    int it = gw;
    if (it >= total) return;
    tr_load(W, K, N, it, lane, a);
#pragma unroll 1
    for (;;) {
        const int it1 = it + NGW, it2 = it1 + NGW;
        tr_load(W, K, N, min(it1, total - 1), lane, b);
        tr_store<MODE>(K, N, WT, scr, it, lane, a);
        if (it1 >= total) break;
        tr_load(W, K, N, min(it2, total - 1), lane, a);
        tr_store<MODE>(K, N, WT, scr, it1, lane, b);
        if (it2 >= total) break;
        it = it2;
    }
}
template <int MODE> __device__ __forceinline__ void transpose_queue(const Ctx& C, const float* W, int K, int N, bf16* WT, int nitems, int cw, int g_lo = 0, int g_hi = 1 << 30, int scr_base = 0, int scr_stride = 16384) {
    LAS float* scr = (LAS float*)(C.lds + scr_base + C.wave * scr_stride);
    volatile LAS unsigned* slot = (volatile LAS unsigned*)(C.lds + MISC_OFF) + 16;
    const int ngrab = min((nitems + 15) / 16, g_hi);
    int g = g_lo + q_next(C, cw);
    if (g >= ngrab) return;
    float a[32], b[32];
    tr_load(W, K, N, min(g * 16 + C.wave, nitems - 1), C.lane, a);
#pragma unroll 1
    for (;;) {
        const int i0 = g * 16 + C.wave, i1 = i0 + 8;
        unsigned tk = 0u;
        if (C.tid == 0) tk = __hip_atomic_fetch_add((unsigned*)(C.ctl + cw), 1u, __ATOMIC_RELAXED, __HIP_MEMORY_SCOPE_AGENT);
        tr_load(W, K, N, min(i1, nitems - 1), C.lane, b);
        if (i0 < nitems) tr_store<MODE>(K, N, WT, scr, i0, C.lane, a);
        __syncthreads();
        if (C.tid == 0) *slot = tk;
        __syncthreads();
        const int gn = g_lo + (int)*slot;
        tr_load(W, K, N, min(gn * 16 + C.wave, nitems - 1), C.lane, a);
        if (i1 < nitems) tr_store<MODE>(K, N, WT, scr, i1, C.lane, b);
        if (gn >= ngrab) break;
        g = gn;
    }
}
template <int MODE> __device__ __forceinline__ bool transpose_grabs(const Ctx& C, const float* W, int K, int N, bf16* WT, int nitems, int cw, int g_lo, int g_hi, int scr_base, int scr_stride, int ngr) {
    LAS float* scr = (LAS float*)(C.lds + scr_base + C.wave * scr_stride);
    const int ngrab = min((nitems + 15) / 16, g_hi);
#pragma unroll 1
    for (int j = 0; j < ngr; ++j) {
        const int g = g_lo + q_next(C, cw); if (g >= ngrab) return false;
        const int i0 = g * 16 + C.wave, i1 = i0 + 8;
        float a[32], b[32];
        tr_load(W, K, N, min(i0, nitems - 1), C.lane, a);
        tr_load(W, K, N, min(i1, nitems - 1), C.lane, b);
        if (i0 < nitems) tr_store<MODE>(K, N, WT, scr, i0, C.lane, a);
        if (i1 < nitems) tr_store<MODE>(K, N, WT, scr, i1, C.lane, b);
    }
    return true;
}
struct LnP { f32x4 g[16], b[16]; };
__device__ __forceinline__ void ln_params(LnP& P, const float* g, const float* bta, int lane) {
#pragma unroll
    for (int j = 0; j < 16; ++j) { P.g[j] = ((const f32x4*)g)[lane + 64 * j]; P.b[j] = ((const f32x4*)bta)[lane + 64 * j]; }
}
template <bool F32OUT, bool TAIL = false, bool INBF = false> __device__ __forceinline__ void ln_row(const void* xrow, const LnP& P, void* orow, int lane, const unsigned* tix16 = nullptr, const float* p2 = nullptr, int rin = 0) {
    f32x4 v[16]; float s = 0.f;
    if (INBF) {
        const v2u* xr = (const v2u*)xrow + lane;
#pragma unroll
        for (int j = 0; j < 16; ++j) { const v2u w = xr[64 * j]; v[j] = (f32x4){bflo(w.x), bfhi(w.x), bflo(w.y), bfhi(w.y)}; }
    } else {
        const f32x4* xr = (const f32x4*)xrow + lane;
#pragma unroll
        for (int j = 0; j < 16; ++j) v[j] = xr[64 * j];
    }
    if (TAIL) {
        unsigned tt[16], any = 0u;
#pragma unroll
        for (int j = 0; j < 16; ++j) { tt[j] = __builtin_amdgcn_readfirstlane(tix16[j]); any |= tt[j]; }
        if (any) {
#pragma unroll
            for (int h = 0; h < 4; ++h) {
                f32x4 pv[4];
#pragma unroll
                for (int j = 0; j < 4; ++j) { const unsigned t = tt[4 * h + j]; pv[j] = *(const f32x4*)(p2 + (size_t)(t ? t - 1u : 0u) * 65536 + (size_t)rin * 256 + lane * 4); }
#pragma unroll
                for (int j = 0; j < 4; ++j) { const float on = tt[4 * h + j] ? 1.f : 0.f; v[4 * h + j] += pv[j] * on; }
            }
        }
    }
#pragma unroll
    for (int j = 0; j < 16; ++j) s += (v[j].x + v[j].y) + (v[j].z + v[j].w);
    const float mean = wave_sum(s) * (1.f / DM); float s2 = 0.f;
#pragma unroll
    for (int j = 0; j < 16; ++j) { v[j] = v[j] - mean; s2 += (v[j].x * v[j].x + v[j].y * v[j].y) + (v[j].z * v[j].z + v[j].w * v[j].w); }
    const float rstd = 1.f / sqrtf(wave_sum(s2) * (1.f / DM) + LN_EPS);
#pragma unroll
    for (int j = 0; j < 16; ++j) {
        const f32x4 y = v[j] * rstd * P.g[j] + P.b[j];
        if (F32OUT) ((f32x4*)orow)[lane + 64 * j] = y;
        else { v2u w; w.x = pk2(y.x, y.y); w.y = pk2(y.z, y.w); ((v2u*)orow)[lane + 64 * j] = w; }
    }
}

#ifndef LN_PIPE
#define LN_PIPE 0
#endif
__device__ __forceinline__ void ln_ld(f32x4 (&v)[16], const float* xrow, int lane) {
    const unsigned vo = 16u * (unsigned)lane;
#pragma unroll
    for (int j = 0; j < 16; ++j) GLD128S(v[j], vo + 4096u * (j >> 2), xrow, 1024 * (j & 3));
}
#define LN_WAIT(N, v) asm volatile("s_waitcnt vmcnt(" #N ")" : "+v"(v[0]), "+v"(v[1]), "+v"(v[2]), "+v"(v[3]), "+v"(v[4]), "+v"(v[5]), "+v"(v[6]), "+v"(v[7]), "+v"(v[8]), "+v"(v[9]), "+v"(v[10]), "+v"(v[11]), "+v"(v[12]), "+v"(v[13]), "+v"(v[14]), "+v"(v[15]))
__device__ __forceinline__ void ln_fin(f32x4 (&v)[16], const LAS f32x4* gl, const LAS f32x4* bl, bf16* orow, int lane) {
    float s = 0.f;
#pragma unroll
    for (int j = 0; j < 16; ++j) s += (v[j].x + v[j].y) + (v[j].z + v[j].w);
    const float mean = wave_sum(s) * (1.f / DM); float s2 = 0.f;
#pragma unroll
    for (int j = 0; j < 16; ++j) { v[j] = v[j] - mean; s2 += (v[j].x * v[j].x + v[j].y * v[j].y) + (v[j].z * v[j].z + v[j].w * v[j].w); }
    const float rstd = 1.f / sqrtf(wave_sum(s2) * (1.f / DM) + LN_EPS);
    const unsigned ga = (unsigned)(size_t)gl + 16u * lane;
#pragma unroll
    for (int q = 0; q < 4; ++q) {
        f32x4 g4[4], b4[4];
#pragma unroll
        for (int j = 0; j < 4; ++j) { DS_RD128(g4[j], ga, 1024 * (4 * q + j)); DS_RD128(b4[j], ga, 16384 + 1024 * (4 * q + j)); }
        asm volatile("s_waitcnt lgkmcnt(0)" : "+v"(g4[0]), "+v"(g4[1]), "+v"(g4[2]), "+v"(g4[3]), "+v"(b4[0]), "+v"(b4[1]), "+v"(b4[2]), "+v"(b4[3]));
#pragma unroll
        for (int j = 0; j < 4; ++j) {
            const f32x4 y = v[4 * q + j] * rstd * g4[j] + b4[j];
            v2u w; w.x = pk2(y.x, y.y); w.y = pk2(y.z, y.w); ((v2u*)orow)[lane + 64 * (4 * q + j)] = w;
        }
    }
    (void)bl;
}
__device__ __forceinline__ void phase0(const Ctx& C) {
    LAS float* scr = (LAS float*)(C.lds + C.wave * 16384);
    const int gw = C.bid * NWAVES + C.wave, NGW = C.G * NWAVES;
    bf16* WinT = (bf16*)(C.ws + WS_WIN); bf16* WoT = (bf16*)(C.ws + WS_WO); bf16* XN = (bf16*)(C.ws + WS_XN);
    constexpr int I_IN = (DM / 64) * ((NIN + 31) / 32), I_O = (DM / 64) * (DM / 32);
    transpose_static<1>(inp(C, I_WIN), DM, NIN, WinT, I_IN, scr, gw, NGW, C.lane);
    (void)WoT; (void)I_O;
    for (int i = gw * 64 + C.lane; i < 144 * (LDX / 8); i += NGW * 64) ((v4u*)(WinT + (size_t)NIN * LDX))[i] = (v4u){0u, 0u, 0u, 0u};
#if defined(PROBE_DUP) && PROBE_DUP == 13
    transpose_static<1>(inp(C, I_WIN), DM, NIN, WinT, I_IN, scr, gw, NGW, C.lane);
#endif
#if LN_PIPE
    {
        __syncthreads();
        LAS f32x4* gl = (LAS f32x4*)C.lds; LAS f32x4* bl = gl + DM / 4;
        for (int i = C.tid; i < DM / 4; i += NWAVES * 64) { gl[i] = ((const f32x4*)inp(C, I_LNG))[i]; bl[i] = ((const f32x4*)inp(C, I_LNB))[i]; }
        __syncthreads();
        const float* xp = inp(C, I_XP); const float* xs = inp(C, I_XS);
        f32x4 va[16], vb[16];
        int m = gw;
        if (m < MTOK) {
            ln_ld(va, m < NPROW ? xp + (size_t)m * DM : xs + (size_t)(m - NPROW) * DM, C.lane);
            LN_WAIT(0, va);
#pragma unroll 1
            for (;;) {
                const int m1 = m + NGW, m1c = min(m1, MTOK - 1), m2 = m1 + NGW, m2c = min(m2, MTOK - 1);
                ln_ld(vb, m1c < NPROW ? xp + (size_t)m1c * DM : xs + (size_t)(m1c - NPROW) * DM, C.lane);
                LN_WAIT(32, va);
                ln_fin(va, gl, bl, XN + (size_t)m * LDX, C.lane);
                if (m1 >= MTOK) break;
                ln_ld(va, m2c < NPROW ? xp + (size_t)m2c * DM : xs + (size_t)(m2c - NPROW) * DM, C.lane);
                LN_WAIT(32, vb);
                ln_fin(vb, gl, bl, XN + (size_t)m1 * LDX, C.lane);
                if (m2 >= MTOK) break;
                m = m2;
            }
            asm volatile("s_waitcnt vmcnt(0)" ::: "memory");
        }
    }
#else
    LnP P; ln_params(P, inp(C, I_LNG), inp(C, I_LNB), C.lane);
#pragma unroll 1
    for (int m = gw; m < MTOK; m += NGW) {
        const float* xr = m < NPROW ? inp(C, I_XP) + (size_t)m * DM : inp(C, I_XS) + (size_t)(m - NPROW) * DM;
        ln_row<false>(xr, P, XN + (size_t)m * LDX, C.lane);
    }
#endif
#if defined(PROBE_DUP) && PROBE_DUP == 14
#pragma unroll 1
    for (int m = gw; m < MTOK; m += NGW) {
        const float* xr = m < NPROW ? inp(C, I_XP) + (size_t)m * DM : inp(C, I_XS) + (size_t)(m - NPROW) * DM;
        ln_row<false>(xr, P, XN + (size_t)m * LDX, C.lane);
    }
#endif
}

__device__ __forceinline__ void select_row(const Ctx& C, int row, int L, unsigned long long* msk, int lane) {
    const float* SC = C.out + OS_SC;
    if (L <= TOPK) { if (lane < 32) msk[lane] = (64 * lane < L) ? ~0ull : 0ull; return; }
    unsigned v[32];
    {
        const float* p0 = SC + (size_t)row * 2048 + lane; const float* p1 = p0 + 1024;
#pragma unroll
        for (int i = 0; i < 16; ++i) { GLD32(v[i], p0, i * 256); GLD32(v[16 + i], p1, i * 256); }
        asm volatile("s_waitcnt vmcnt(0)" : "+v"(v[0]), "+v"(v[1]), "+v"(v[2]), "+v"(v[3]), "+v"(v[4]), "+v"(v[5]), "+v"(v[6]), "+v"(v[7]), "+v"(v[8]), "+v"(v[9]), "+v"(v[10]), "+v"(v[11]), "+v"(v[12]), "+v"(v[13]), "+v"(v[14]), "+v"(v[15]));
        asm volatile("" : "+v"(v[16]), "+v"(v[17]), "+v"(v[18]), "+v"(v[19]), "+v"(v[20]), "+v"(v[21]), "+v"(v[22]), "+v"(v[23]), "+v"(v[24]), "+v"(v[25]), "+v"(v[26]), "+v"(v[27]), "+v"(v[28]), "+v"(v[29]), "+v"(v[30]), "+v"(v[31]));
        int Lr = L; asm volatile("" : "+s"(Lr));
#pragma unroll
        for (int i = 0; i < 32; ++i) { unsigned u = v[i]; u = (u & 0x80000000u) ? ~u : (u | 0x80000000u); v[i] = (lane + 64 * i < Lr) ? u : 0u; }
    }
    unsigned T = 0u;
    for (int bit = 31; bit >= 0; --bit) {
        const unsigned cand = T | (1u << bit); int cnt = 0;
#pragma unroll
        for (int i = 0; i < 32; ++i) cnt += __popcll(__ballot(v[i] >= cand));
        if (cnt >= TOPK) { T = cand; if (cnt == TOPK) break; }
    }
    int cgt = 0;
#pragma unroll
    for (int i = 0; i < 32; ++i) cgt += __popcll(__ballot(v[i] > T));
    const int need = TOPK - cgt;
    const unsigned long long ltm = (1ull << lane) - 1ull;
    int eqb = 0;
#pragma unroll
    for (int i = 0; i < 32; ++i) {
        const bool gt = v[i] > T, eq = v[i] == T;
        const unsigned long long eqm = __ballot(eq);
        const int myeq = eqb + __popcll(eqm & ltm);
        const unsigned long long sm = __ballot(gt || (eq && myeq < need));
        if (lane == 0) msk[i] = sm;
        eqb += __popcll(eqm);
    }
}
__device__ __forceinline__ float relu_i(float x) { const int b = __builtin_bit_cast(int, x); return __builtin_bit_cast(float, b > 0 ? b : 0); }
__device__ __forceinline__ float relu_f(float x) { return __builtin_amdgcn_fmed3f(x, 0.f, __builtin_inff()); }
template <bool DOSEL = true> __device__ __forceinline__ void idx_unit(const Ctx& C, int item) {
    bool prompt; int b, c;
    if (item < 120) { prompt = true; c = 31 - item / 8; b = item % 8; }
    else if (item < 152) { prompt = false; c = 0; b = item - 120; }
    else { prompt = true; const int j = item - 152; c = 16 - j / 8; b = j % 8; }
    const bf16* H = (const bf16*)(C.ws + WS_H);
    const float* SM = C.out + OS_SM; float* SC = C.out + OS_SC;
    const int row0 = prompt ? b * PSEQ + c * 64 : NPROW + b * SSEQ;
    const int nkt = prompt ? c + 1 : (PAST + SSEQ) / 64;
    int lane_ = C.lane; asm volatile("" : "+v"(lane_));
    const int lane = lane_, l15 = lane & 15, l4 = lane >> 4;
    LAS float* wl = (LAS float*)(C.lds + EPIW_OFF);
    LAS unsigned char* QL = C.lds;
    __syncthreads();
    for (int i = C.tid; i < 1024; i += NWAVES * 64) wl[i] = SM[(size_t)(row0 + (i >> 4)) * 128 + 64 + (i & 15)] * IDX_SCALE;
    {
        const bf16* qsrc = H + (size_t)(row0 + (C.tid >> 7)) * LDH + HIQ + (C.tid & 127) * 8;
        v4u qv[16];
#pragma unroll
        for (int k = 0; k < 16; ++k) qv[k] = *(const v4u*)(qsrc + (size_t)(4 * k) * LDH);
#pragma unroll
        for (int k = 0; k < 16; ++k) { const int row = (C.tid >> 7) + 4 * k, p = C.tid & 127; *(LAS v4u*)(QL + row * 2048 + ((p ^ (row & 15)) << 4)) = qv[k]; }
    }
    __syncthreads();
    const unsigned qrb = (unsigned)(size_t)QL + (unsigned)l15 * 2048u;
    const unsigned qlo00 = qrb + (unsigned)(((0 + l4) ^ l15) << 4), qlo01 = qrb + (unsigned)(((4 + l4) ^ l15) << 4), qlo10 = qrb + (unsigned)(((8 + l4) ^ l15) << 4), qlo11 = qrb + (unsigned)(((12 + l4) ^ l15) << 4);
#define IDX_QRD(dst, a0, a1) do { const unsigned b0_ = (a0) + 65536u, b1_ = (a1) + 65536u; \
        DS_RD128(dst[0][0], a0, 0); DS_RD128(dst[0][1], a1, 0); DS_RD128(dst[1][0], a0, 32768); DS_RD128(dst[1][1], a1, 32768); \
        DS_RD128(dst[2][0], b0_, 0); DS_RD128(dst[2][1], b1_, 0); DS_RD128(dst[3][0], b0_, 32768); DS_RD128(dst[3][1], b1_, 32768); } while (0)
#define IDX_QWAIT(f) asm volatile("s_waitcnt lgkmcnt(0)" : "+v"(f[0][0]), "+v"(f[0][1]), "+v"(f[1][0]), "+v"(f[1][1]), "+v"(f[2][0]), "+v"(f[2][1]), "+v"(f[3][0]), "+v"(f[3][1]))
#define IDX_HEAD(f, HH) do { float w[4]; \
        _Pragma("unroll") for (int qb = 0; qb < 4; ++qb) w[qb] = wl[(qb * 16 + l15) * 16 + (HH)]; \
        _Pragma("unroll") for (int kb = 0; kb < 4; ++kb) {     \
            f32x4 a[4]; \
            _Pragma("unroll") for (int qb = 0; qb < 4; ++qb) a[qb] = __builtin_amdgcn_mfma_f32_16x16x32_bf16(afr[kb][0], f[qb][0], (f32x4){0.f, 0.f, 0.f, 0.f}, 0, 0, 0); \
            _Pragma("unroll") for (int qb = 0; qb < 4; ++qb) a[qb] = __builtin_amdgcn_mfma_f32_16x16x32_bf16(afr[kb][1], f[qb][1], a[qb], 0, 0, 0); \
            __builtin_amdgcn_sched_barrier(0); \
            _Pragma("unroll") for (int qb = 0; qb < 4; ++qb) { const f32x4 av = a[qb]; \
                  \
                const f32x4 rv = (f32x4){relu_i(av[0]), relu_i(av[1]), relu_i(av[2]), relu_i(av[3])}; \
                idx[kb][qb] += rv * w[qb]; } \
            __builtin_amdgcn_sched_barrier(0); } } while (0)
    for (int kt = C.wave; kt < nkt; kt += NWAVES) {
        bf16x8 afr[4][2];
        if (prompt || kt == nkt - 1) {
            const int krow0 = prompt ? b * PSEQ + kt * 64 : NPROW + b * SSEQ;
#pragma unroll
            for (int kb = 0; kb < 4; ++kb)
#pragma unroll
                for (int ks = 0; ks < 2; ++ks) afr[kb][ks] = *(const bf16x8*)(H + (size_t)(krow0 + kb * 16 + l15) * LDH + HSM + ks * 32 + l4 * 8);
        } else {
            const float* ck = inp(C, I_CIK) + ((size_t)b * PAST + kt * 64) * 64;
#pragma unroll
            for (int kb = 0; kb < 4; ++kb)
#pragma unroll
                for (int ks = 0; ks < 2; ++ks) {
                    const f32x4* p = (const f32x4*)(ck + (size_t)(kb * 16 + l15) * 64 + ks * 32 + l4 * 8);
                    const f32x4 x0 = p[0], x1 = p[1]; v4u w; w.x = pk2(x0.x, x0.y); w.y = pk2(x0.z, x0.w); w.z = pk2(x1.x, x1.y); w.w = pk2(x1.z, x1.w);
                    afr[kb][ks] = __builtin_bit_cast(bf16x8, w);
                }
        }
        f32x4 idx[4][4];
#pragma unroll
        for (int kb = 0; kb < 4; ++kb)
#pragma unroll
            for (int qb = 0; qb < 4; ++qb) idx[kb][qb] = (f32x4){0.f, 0.f, 0.f, 0.f};
        bf16x8 bfr[4][2], bnx[4][2];
        IDX_QRD(bfr, qlo00, qlo01); IDX_QWAIT(bfr);
#pragma unroll 1
        for (int hp = 0; hp < 8; ++hp) {
            const unsigned ho = (unsigned)hp * 256u, hn = (unsigned)(hp < 7 ? hp + 1 : 7) * 256u;
            IDX_QRD(bnx, qlo10 + ho, qlo11 + ho);
            __builtin_amdgcn_sched_barrier(0);
            IDX_HEAD(bfr, 2 * hp);
            __builtin_amdgcn_sched_barrier(0);
            IDX_QWAIT(bnx);
            IDX_QRD(bfr, qlo00 + hn, qlo01 + hn);
            __builtin_amdgcn_sched_barrier(0);
            IDX_HEAD(bnx, 2 * hp + 1);
            __builtin_amdgcn_sched_barrier(0);
            IDX_QWAIT(bfr);
        }
#pragma unroll
        for (int kb = 0; kb < 4; ++kb)
#pragma unroll
            for (int qb = 0; qb < 4; ++qb)
                *(f32x4*)(SC + (size_t)(row0 + qb * 16 + l15) * 2048 + kt * 64 + kb * 16 + l4 * 4) = idx[kb][qb];
    }
#undef IDX_QRD
#undef IDX_QWAIT
#undef IDX_HEAD
    __syncthreads();
    if (DOSEL) {
        unsigned long long* MG = (unsigned long long*)(C.out + OS_MSK);
        const int Lq = prompt ? (c + 1) * 64 : SLEN;
#pragma unroll 1
        for (int j = 0; j < 8; ++j) { const int row = row0 + C.wave * 8 + j; select_row(C, row, Lq, MG + (size_t)row * 32, lane); }
    }
}
__device__ __forceinline__ void prep_unit(const Ctx& C, int tb) {
    const bf16* H = (const bf16*)(C.ws + WS_H); bf16* QKVC = (bf16*)(C.ws + WS_QKVC);
    const int R0 = tb * 16; const bool prompt = R0 < NPROW; const int r2 = R0 - NPROW;
    const int b = prompt ? (R0 >> 11) : (r2 >> 6), t0 = prompt ? (R0 & 2047) : (r2 & 63);
    const float* cw = inp(C, I_CQW); const float* cb = inp(C, I_CQB); const float* st = inp(C, I_SCONV);
    for (int seg = C.wave; seg < 48; seg += NWAVES) {
        const int c = seg * 128 + 2 * C.lane;
        const f32x2 w0 = *(const f32x2*)(cw + c), w1 = *(const f32x2*)(cw + CQKV + c), w2 = *(const f32x2*)(cw + 2 * CQKV + c), w3 = *(const f32x2*)(cw + 3 * CQKV + c), bi = *(const f32x2*)(cb + c);
        f32x2 xm3, xm2, xm1;
        if (t0 > 0) {
            const unsigned a = *(const unsigned*)(H + (size_t)(R0 - 3) * LDH + HQKV + c), bq = *(const unsigned*)(H + (size_t)(R0 - 2) * LDH + HQKV + c), cq = *(const unsigned*)(H + (size_t)(R0 - 1) * LDH + HQKV + c);
            xm3 = (f32x2){bflo(a), bfhi(a)}; xm2 = (f32x2){bflo(bq), bfhi(bq)}; xm1 = (f32x2){bflo(cq), bfhi(cq)};
        } else if (prompt) { xm3 = xm2 = xm1 = (f32x2){0.f, 0.f}; }
        else { xm3 = *(const f32x2*)(st + (size_t)(b * 3 + 0) * CQKV + c); xm2 = *(const f32x2*)(st + (size_t)(b * 3 + 1) * CQKV + c); xm1 = *(const f32x2*)(st + (size_t)(b * 3 + 2) * CQKV + c); }
        const float post = seg < 16 ? QSCALE : 1.f;
#pragma unroll 4
        for (int i = 0; i < 16; ++i) {
            const unsigned xw = *(const unsigned*)(H + (size_t)(R0 + i) * LDH + HQKV + c);
            const f32x2 x0 = (f32x2){bflo(xw), bfhi(xw)};
            f32x2 y = bi + w0 * xm3 + w1 * xm2 + w2 * xm1 + w3 * x0;
            y.x = silu_f(y.x); y.y = silu_f(y.y);
            if (seg < 32) { const float ss = wave_sum(y.x * y.x + y.y * y.y); const float sc = post / sqrtf(ss + 1e-6f); y.x *= sc; y.y *= sc; }
            *(unsigned*)(QKVC + (size_t)(R0 + i) * CQKV + c) = pk2(y.x, y.y);
            xm3 = xm2; xm2 = xm1; xm1 = x0;
        }
    }
}

constexpr int DCH = 32;
__device__ __forceinline__ void delta_unit(const Ctx& C, int item) {
    const bool prompt = item < 128; const int j2 = item - 128;
    const int b = prompt ? item >> 4 : j2 >> 4, h = item & 15;
    const int T = prompt ? PSEQ : SSEQ, rowbase = prompt ? b * PSEQ : NPROW + b * SSEQ;
    const bf16* H = (const bf16*)(C.ws + WS_H); const bf16* QKVC = (const bf16*)(C.ws + WS_QKVC); bf16* CAT = (bf16*)(C.ws + WS_CAT);
    const float* SM = C.out + OS_SM;
    LAS float* qs = (LAS float*)(C.lds + 16384);
    LAS float* ks = qs + DCH * 128;
    LAS float* vs = ks + DCH * 128;
    LAS float* os = vs + DCH * 128;
    LAS float* xch = os + DCH * 128;
    LAS float* sc = xch + 2 * 4 * 128 * 2;
    int tid_ = C.tid; asm volatile("" : "+v"(tid_));
    const int tid = tid_, e = tid & 127, part = __builtin_amdgcn_readfirstlane(tid >> 7), lane = tid & 63, wave = __builtin_amdgcn_readfirstlane(tid >> 6);
    float S[32];
    if (prompt) {
#pragma unroll
        for (int i = 0; i < 32; ++i) S[i] = 0.f;
    } else {
        const float* s0 = inp(C, I_SDELTA) + ((size_t)(b * 16 + h) * 128 + part * 32) * 128 + e;
#pragma unroll
        for (int i = 0; i < 32; ++i) S[i] = s0[(size_t)i * 128];
    }
    const float Aexp = expf(inp(C, I_ALOG)[h]), dtb = inp(C, I_DTB)[h];
    const f32x2 gn = *(const f32x2*)(inp(C, I_DNG) + 2 * lane);
    for (int c0 = 0; c0 < T; c0 += DCH) {
        __syncthreads();
        for (int idx = tid; idx < DCH * 192; idx += NWAVES * 64) {
            const int r = idx / 192, p = idx % 192, which = p >> 6, pp = p & 63;
            const unsigned w = *(const unsigned*)(QKVC + (size_t)(rowbase + c0 + r) * CQKV + which * 2048 + h * 128 + 2 * pp);
            LAS float* dst = (which == 0 ? qs : which == 1 ? ks : vs) + r * 128 + 2 * pp;
            dst[0] = bflo(w); dst[1] = bfhi(w);
        }
        if (tid < DCH) {
            const size_t row = (size_t)(rowbase + c0 + tid);
            const float a_in = SM[row * 128 + 96 + h], b_in = SM[row * 128 + 80 + h];
            const float x = a_in + dtb; const float sp = x > 20.f ? x : log1pf(expf(x));
            sc[tid * 4 + 0] = expf(-Aexp * sp); sc[tid * 4 + 1] = 1.f / (1.f + expf(-b_in));
        }
        __syncthreads();
        for (int r = wave; r < DCH; r += NWAVES) {
            const float d = qs[r * 128 + 2 * lane] * ks[r * 128 + 2 * lane] + qs[r * 128 + 2 * lane + 1] * ks[r * 128 + 2 * lane + 1];
            const float s = wave_sum(d); if (lane == 0) sc[r * 4 + 2] = s;
        }
        __syncthreads();
        for (int t = 0; t < DCH; ++t) {
            const LAS float* kt = ks + t * 128 + part * 32; const LAS float* qt = qs + t * 128 + part * 32;
            float kreg[32]; float pk = 0.f, pq = 0.f;
#pragma unroll
            for (int i = 0; i < 32; ++i) { kreg[i] = kt[i]; pk += kreg[i] * S[i]; pq += qt[i] * S[i]; }
            LAS f32x2* xb = (LAS f32x2*)xch + (t & 1) * 512;
            xb[part * 128 + e] = (f32x2){pk, pq};
            __syncthreads();
            const f32x2 x0 = xb[e], x1 = xb[128 + e], x2 = xb[256 + e], x3 = xb[384 + e];
            const float kS = (x0.x + x1.x) + (x2.x + x3.x), qS = (x0.y + x1.y) + (x2.y + x3.y);
            const float eg = sc[t * 4 + 0], beta = sc[t * 4 + 1], qk = sc[t * 4 + 2];
            const float vn = beta * (vs[t * 128 + e] - eg * kS);
            const float o = eg * qS + qk * vn;
#pragma unroll
            for (int i = 0; i < 32; ++i) S[i] = eg * S[i] + kreg[i] * vn;
            if (part == 0) os[t * 128 + e] = o;
        }
        __syncthreads();
        for (int r = wave; r < DCH; r += NWAVES) {
            const size_t row = (size_t)(rowbase + c0 + r);
            const float o0 = os[r * 128 + 2 * lane], o1 = os[r * 128 + 2 * lane + 1];
            const float ss = wave_sum(o0 * o0 + o1 * o1);
            const float rs = 1.f / sqrtf(ss * (1.f / 128.f) + LN_EPS);
            const unsigned zw = *(const unsigned*)(H + row * LDH + HZ + h * 128 + 2 * lane);
            const float y0 = o0 * rs * gn.x * silu_f(bflo(zw)), y1 = o1 * rs * gn.y * silu_f(bfhi(zw));
            *(unsigned*)(CAT + row * DM + 2048 + h * 128 + 2 * lane) = pk2(y0, y1);
        }
    }
    float* so = C.out + (prompt ? O_PDELTA : O_SDELTA) + ((size_t)(b * 16 + h) * 128 + part * 32) * 128 + e;
#pragma unroll
    for (int i = 0; i < 32; ++i) so[(size_t)i * 128] = S[i];
    __syncthreads();
}

__device__ __forceinline__ void vt_item(const Ctx& C, int item) {
    const bf16* H = (const bf16*)(C.ws + WS_H);
    LAS unsigned char* scr = C.lds + C.wave * 16384;
    int lane_ = C.lane; asm volatile("" : "+v"(lane_)); const int lane = lane_;
    bool prompt; int b, n, kt;
    if (item < NPB * 4 * 32) { prompt = true; b = item >> 7; n = (item >> 5) & 3; kt = item & 31; }
    else { prompt = false; const int j = item - NPB * 4 * 32; b = j / 68; n = (j % 68) / 17; kt = j % 17; }
    if (prompt || kt == 16) {
        const bf16* src = H + (size_t)(prompt ? b * PSEQ + kt * 64 + lane : NPROW + b * SSEQ + lane) * LDH + HV + n * 128;
#pragma unroll
        for (int c = 0; c < 16; ++c) *(LAS v4u*)(scr + lane * 256 + c * 16) = *(const v4u*)(src + c * 8);
    } else {
        const float* src = inp(C, I_CV) + ((size_t)(b * PAST + kt * 64 + lane) * 4 + n) * 128;
#pragma unroll
        for (int c = 0; c < 16; ++c) { const f32x4 x0 = *(const f32x4*)(src + c * 8), x1 = *(const f32x4*)(src + c * 8 + 4);
            v4u w; w.x = pk2(x0.x, x0.y); w.y = pk2(x0.z, x0.w); w.z = pk2(x1.x, x1.y); w.w = pk2(x1.z, x1.w); *(LAS v4u*)(scr + lane * 256 + c * 16) = w; }
    }
    LDS_WAIT(); asm volatile("" ::: "memory");
    bf16* VT = (bf16*)(C.out + (prompt ? OS_VTP : OS_VTS));
    const int ntile = prompt ? PSEQ / 64 : SLEN / 64;
#pragma unroll 4
    for (int c = 0; c < 16; ++c) {
        const int cid = lane + 64 * c, d = cid >> 3, kc = cid & 7;
        const LAS unsigned short* s = (const LAS unsigned short*)(scr + (kc * 8) * 256 + d * 2);
        v4u w;
        w.x = (unsigned)s[0 * 128] | ((unsigned)s[1 * 128] << 16); w.y = (unsigned)s[2 * 128] | ((unsigned)s[3 * 128] << 16);
        w.z = (unsigned)s[4 * 128] | ((unsigned)s[5 * 128] << 16); w.w = (unsigned)s[6 * 128] | ((unsigned)s[7 * 128] << 16);
        *(v4u*)(VT + ((size_t)(((b * 4 + n) * ntile + kt) * 128 + d)) * 64 + kc * 8) = w;
    }
    LDS_WAIT(); asm volatile("" ::: "memory");
}

typedef float f32x16 __attribute__((ext_vector_type(16)));
constexpr int A_LUT = 0, A_MSK = 16384, A_KS = 32768, A_VS = A_KS + 64 * 272, A_BUF = 2 * 64 * 272, A_END = A_KS + 2 * A_BUF;
static_assert(A_END <= RING_BYTES, "attention LDS map");
constexpr float LOG2E = 1.4426950408889634f;
__device__ __forceinline__ int t5_bucket(int rel) {
    const int n = rel < 0 ? -rel : rel; int bk;
    if (n < 8) bk = n; else bk = n < 12 ? 8 : n < 16 ? 9 : n < 23 ? 10 : n < 32 ? 11 : n < 46 ? 12 : n < 64 ? 13 : n < 91 ? 14 : 15;
    return (rel > 0 ? 16 : 0) + bk;
}
__device__ __forceinline__ void attn_lut(const Ctx& C) {
    LAS float* lut = (LAS float*)(C.lds + A_LUT);
    for (int i = C.tid; i < 16 * 256; i += NWAVES * 64) { const int head = i >> 8, rel = (i & 255) - 191; lut[i] = inp(C, I_RELB)[t5_bucket(rel) * 16 + head] * LOG2E; }
}
__device__ __forceinline__ float max3f(float a, float b, float c) { float r; asm("v_max3_f32 %0, %1, %2, %3" : "=v"(r) : "v"(a), "v"(b), "v"(c)); return r; }
#ifndef ATT_PP
#define ATT_PP 1
#endif
#if !ATT_PP
__device__ __forceinline__ void attn_unit_seq(const Ctx& C, int item) {
    bool prompt; int b, c, n;
    if (item < 480) { prompt = true; c = 31 - (item >> 5); b = (item & 31) >> 2; n = item & 3; }
    else if (item < 608) { prompt = false; c = 0; const int j = item - 480; b = j >> 2; n = j & 3; }
    else { prompt = true; const int j = item - 608; c = 16 - (j >> 5); b = (j & 31) >> 2; n = j & 3; }
    const bf16* H = (const bf16*)(C.ws + WS_H); bf16* CAT = (bf16*)(C.ws + WS_CAT);
    int tid_ = C.tid; asm volatile("" : "+v"(tid_));
    const int tid = tid_, lane = tid & 63, wave = __builtin_amdgcn_readfirstlane(tid >> 6);
    const int row0 = prompt ? b * PSEQ + c * 64 : NPROW + b * SSEQ;
    const int past = prompt ? 0 : PAST, t0 = prompt ? c * 64 : 0;
    const int L = prompt ? (c + 1) * 64 : SLEN, nkt = L / 64;
    const int ntile = prompt ? PSEQ / 64 : SLEN / 64;
    LAS unsigned long long* MSK = (LAS unsigned long long*)(C.lds + A_MSK);
    LAS unsigned char* KS = C.lds + A_KS; LAS unsigned char* VS = C.lds + A_VS;
    const LAS float* LUT = (const LAS float*)(C.lds + A_LUT);
    __syncthreads();
    {
        const v4u* mg = (const v4u*)(C.out + OS_MSK + (size_t)row0 * 64);
        ((LAS v4u*)MSK)[tid] = mg[tid]; ((LAS v4u*)MSK)[tid + 512] = mg[tid + 512];
    }
    const int g = wave & 3, qh = wave >> 2, h = lane >> 5, l31 = lane & 31;
    const int ql = qh * 32 + l31, qpos = past + t0 + ql, qpos_min = past + t0 + qh * 32;
    const float SC2 = QSCALE * LOG2E;
    const int head = n * 4 + g;
    bf16x8 qf[8];
#pragma unroll
    for (int s = 0; s < 8; ++s) qf[s] = *(const bf16x8*)(H + (size_t)(row0 + ql) * LDH + HQ + head * 128 + 16 * s + 8 * h);
    f32x16 oacc[4];
#pragma unroll
    for (int db = 0; db < 4; ++db)
#pragma unroll
        for (int r = 0; r < 16; ++r) oacc[db][r] = 0.f;
    float m_run = -INFINITY, l_run = 0.f;
    const float bfar = inp(C, I_RELB)[15 * 16 + head] * LOG2E;
    const LAS float* lut = LUT + head * 256;
    v4u kreg[2], vreg[2];
    const unsigned koffH0 = (unsigned)(tid >> 4) * LDH + (unsigned)(tid & 15) * 8u, koffH1 = koffH0 + 32u * LDH;
    const unsigned koffC0 = (unsigned)(tid >> 4) * 512u + (unsigned)(tid & 15) * 8u, koffC1 = koffC0 + 32u * 512u;
#define ATT_LOAD(KT) do { const int kt_ = (KT); \
        if (prompt || kt_ == 16) { const bf16* kb_ = H + (size_t)(prompt ? b * PSEQ + kt_ * 64 : NPROW + b * SSEQ) * LDH + HK + n * 128; kreg[0] = *(const v4u*)(kb_ + koffH0); kreg[1] = *(const v4u*)(kb_ + koffH1); } \
        else { const float* cb_ = inp(C, I_CK) + ((size_t)(b * PAST + kt_ * 64) * 4 + n) * 128; \
               const f32x4 x0 = *(const f32x4*)(cb_ + koffC0), x1 = *(const f32x4*)(cb_ + koffC0 + 4), y0 = *(const f32x4*)(cb_ + koffC1), y1 = *(const f32x4*)(cb_ + koffC1 + 4); \
               kreg[0].x = pk2(x0.x, x0.y); kreg[0].y = pk2(x0.z, x0.w); kreg[0].z = pk2(x1.x, x1.y); kreg[0].w = pk2(x1.z, x1.w); \
               kreg[1].x = pk2(y0.x, y0.y); kreg[1].y = pk2(y0.z, y0.w); kreg[1].z = pk2(y1.x, y1.y); kreg[1].w = pk2(y1.z, y1.w); } \
        if (prompt || kt_ == 16) { const bf16* vb_ = H + (size_t)(prompt ? b * PSEQ + kt_ * 64 : NPROW + b * SSEQ) * LDH + HV + n * 128; vreg[0] = *(const v4u*)(vb_ + koffH0); vreg[1] = *(const v4u*)(vb_ + koffH1); } \
        else { const float* cb_ = inp(C, I_CV) + ((size_t)(b * PAST + kt_ * 64) * 4 + n) * 128; \
               const f32x4 x0 = *(const f32x4*)(cb_ + koffC0), x1 = *(const f32x4*)(cb_ + koffC0 + 4), y0 = *(const f32x4*)(cb_ + koffC1), y1 = *(const f32x4*)(cb_ + koffC1 + 4); \
               vreg[0].x = pk2(x0.x, x0.y); vreg[0].y = pk2(x0.z, x0.w); vreg[0].z = pk2(x1.x, x1.y); vreg[0].w = pk2(x1.z, x1.w); \
               vreg[1].x = pk2(y0.x, y0.y); vreg[1].y = pk2(y0.z, y0.w); vreg[1].z = pk2(y1.x, y1.y); vreg[1].w = pk2(y1.z, y1.w); } } while (0)
    ATT_LOAD(0);
#pragma unroll 1
    for (int kt = 0; kt < nkt; ++kt) {
        __syncthreads();
#pragma unroll
        for (int i = 0; i < 2; ++i) { const int cid = tid + 512 * i;
            *(LAS v4u*)(KS + (cid >> 4) * 272 + (cid & 15) * 16) = kreg[i];
            *(LAS v4u*)(VS + (cid >> 4) * 272 + (cid & 15) * 16) = vreg[i]; }
        __syncthreads();
        if (kt + 1 < nkt) ATT_LOAD(kt + 1);
        f32x16 s0, s1;
#pragma unroll
        for (int r = 0; r < 16; ++r) { s0[r] = 0.f; s1[r] = 0.f; }
        {
            const unsigned kaddr = (unsigned)(size_t)(KS + l31 * 272 + 16 * h);
            asm volatile("" ::: "memory");
#pragma unroll
            for (int s4 = 0; s4 < 2; ++s4) {
                bf16x8 kA[4], kB[4];
#pragma unroll
                for (int s = 0; s < 4; ++s) { DS_RD128(kA[s], kaddr, 32 * (4 * s4 + s)); DS_RD128(kB[s], kaddr, 32 * 272 + 32 * (4 * s4 + s)); }
                asm volatile("s_waitcnt lgkmcnt(0)" : "+v"(kA[0]), "+v"(kA[1]), "+v"(kA[2]), "+v"(kA[3]), "+v"(kB[0]), "+v"(kB[1]), "+v"(kB[2]), "+v"(kB[3]));
#pragma unroll
                for (int s = 0; s < 4; ++s) {
                    s0 = __builtin_amdgcn_mfma_f32_32x32x16_bf16(kA[s], qf[4 * s4 + s], s0, 0, 0, 0);
                    s1 = __builtin_amdgcn_mfma_f32_32x32x16_bf16(kB[s], qf[4 * s4 + s], s1, 0, 0, 0);
                }
            }
        }
        asm volatile("s_nop 7\n\ts_nop 7\n\ts_nop 3" : "+v"(s0), "+v"(s1));
        const unsigned long long mw = MSK[ql * 32 + kt];
        const unsigned wlo = (unsigned)mw >> (4 * h), whi = (unsigned)(mw >> 32) >> (4 * h);
        const bool far = (kt * 64 + 63 - qpos_min) <= -91;
        float mx;
        if (far) {
            float a = max3f(s0[0], s0[1], s0[2]), bq = max3f(s1[0], s1[1], s1[2]);
#pragma unroll
            for (int r = 3; r < 15; r += 2) { a = max3f(a, s0[r], s0[r + 1]); bq = max3f(bq, s1[r], s1[r + 1]); }
            mx = fmaf(max3f(a, bq, fmaxf(s0[15], s1[15])), SC2, bfar);
        } else {
            const int relb0 = kt * 64 + 4 * h - qpos + 191;
#pragma unroll
            for (int r = 0; r < 16; ++r) { const int cr = (r & 3) + 8 * (r >> 2);
                s0[r] = fmaf(s0[r], SC2, lut[relb0 + cr]); s1[r] = fmaf(s1[r], SC2, lut[relb0 + 32 + cr]); }
            float a = max3f(s0[0], s0[1], s0[2]), bq = max3f(s1[0], s1[1], s1[2]);
#pragma unroll
            for (int r = 3; r < 15; r += 2) { a = max3f(a, s0[r], s0[r + 1]); bq = max3f(bq, s1[r], s1[r + 1]); }
            mx = max3f(a, bq, fmaxf(s0[15], s1[15]));
        }
        mx = fmaxf(mx, __shfl_xor(mx, 32));
        const float m_new = fmaxf(m_run, mx);
        if (__any(m_new != m_run)) {
            const float alpha = __builtin_amdgcn_exp2f(m_run - m_new);
            l_run *= alpha;
#pragma unroll
            for (int db = 0; db < 4; ++db)
#pragma unroll
                for (int r = 0; r < 16; ++r) oacc[db][r] *= alpha;
        }
        m_run = m_new;
        const float sc = far ? SC2 : 1.f, sb = far ? bfar - m_new : -m_new;
        float psum = 0.f;
#pragma unroll
        for (int r = 0; r < 16; ++r) { const int cr = (r & 3) + 8 * (r >> 2);
            const float p0 = __builtin_amdgcn_exp2f(fmaf(s0[r], sc, sb)), p1 = __builtin_amdgcn_exp2f(fmaf(s1[r], sc, sb));
            unsigned m0, m1;
            asm("v_bfe_i32 %0, %1, %c2, 1" : "=v"(m0) : "v"(wlo), "i"(cr)); asm("v_bfe_i32 %0, %1, %c2, 1" : "=v"(m1) : "v"(whi), "i"(cr));
            s0[r] = __uint_as_float(__float_as_uint(p0) & m0); s1[r] = __uint_as_float(__float_as_uint(p1) & m1);
            psum += s0[r] + s1[r]; }
        l_run += psum;
        bf16x8 pb[2][2];
#pragma unroll
        for (int s = 0; s < 2; ++s) {
            v4u w0, w1;
            w0.x = pk2(s0[8 * s + 0], s0[8 * s + 1]); w0.y = pk2(s0[8 * s + 2], s0[8 * s + 3]); w0.z = pk2(s0[8 * s + 4], s0[8 * s + 5]); w0.w = pk2(s0[8 * s + 6], s0[8 * s + 7]);
            w1.x = pk2(s1[8 * s + 0], s1[8 * s + 1]); w1.y = pk2(s1[8 * s + 2], s1[8 * s + 3]); w1.z = pk2(s1[8 * s + 4], s1[8 * s + 5]); w1.w = pk2(s1[8 * s + 6], s1[8 * s + 7]);
            pb[0][s] = __builtin_bit_cast(bf16x8, w0); pb[1][s] = __builtin_bit_cast(bf16x8, w1);
        }
        {
            const unsigned vaddr = (unsigned)(size_t)(VS + (4 * h + ((lane & 15) >> 2)) * 272 + (16 * ((lane >> 4) & 1) + 4 * (lane & 3)) * 2);
#pragma unroll
            for (int d2 = 0; d2 < 2; ++d2) {
                v2u vlo[8], vhi[8];
#pragma unroll
                for (int dd = 0; dd < 2; ++dd)
#pragma unroll
                    for (int ks = 0; ks < 4; ++ks) { DS_RDTR(vlo[dd * 4 + ks], vaddr, ks * 4352 + (2 * d2 + dd) * 64); DS_RDTR(vhi[dd * 4 + ks], vaddr, ks * 4352 + 2176 + (2 * d2 + dd) * 64); }
                asm volatile("s_waitcnt lgkmcnt(0)" : "+v"(vlo[0]), "+v"(vlo[1]), "+v"(vlo[2]), "+v"(vlo[3]), "+v"(vlo[4]), "+v"(vlo[5]), "+v"(vlo[6]), "+v"(vlo[7]),
                                                      "+v"(vhi[0]), "+v"(vhi[1]), "+v"(vhi[2]), "+v"(vhi[3]), "+v"(vhi[4]), "+v"(vhi[5]), "+v"(vhi[6]), "+v"(vhi[7]));
#pragma unroll
                for (int dd = 0; dd < 2; ++dd)
#pragma unroll
                    for (int ks = 0; ks < 4; ++ks) {
                        const bf16x8 a = __builtin_bit_cast(bf16x8, (v4u){vlo[dd * 4 + ks].x, vlo[dd * 4 + ks].y, vhi[dd * 4 + ks].x, vhi[dd * 4 + ks].y});
                        oacc[2 * d2 + dd] = __builtin_amdgcn_mfma_f32_32x32x16_bf16(a, pb[ks >> 1][ks & 1], oacc[2 * d2 + dd], 0, 0, 0);
                    }
            }
        }
    }
#undef ATT_LOAD
    const float inv = 1.f / (l_run + __shfl_xor(l_run, 32));
    bf16* op = CAT + (size_t)(row0 + ql) * DM + head * 128 + 4 * h;
#pragma unroll
    for (int db = 0; db < 4; ++db)
#pragma unroll
        for (int q4 = 0; q4 < 4; ++q4) {
#if MIX_FP8
            *(unsigned*)((unsigned char*)CAT + (size_t)(row0 + ql) * DM + head * 128 + 4 * h + 32 * db + 8 * q4) = pk4_fp8(oacc[db][4 * q4 + 0] * (inv * CAT_Q), oacc[db][4 * q4 + 1] * (inv * CAT_Q), oacc[db][4 * q4 + 2] * (inv * CAT_Q), oacc[db][4 * q4 + 3] * (inv * CAT_Q));
#else
            v2u w; w.x = pk2(oacc[db][4 * q4 + 0] * inv, oacc[db][4 * q4 + 1] * inv); w.y = pk2(oacc[db][4 * q4 + 2] * inv, oacc[db][4 * q4 + 3] * inv);
            *(v2u*)(op + 32 * db + 8 * q4) = w;
#endif
        }
}
#define attn_unit attn_unit_seq
#else
__device__ __forceinline__ void attn_unit(const Ctx& C, int item) {
    bool prompt; int b, c, n;
    if (item < 480) { prompt = true; c = 31 - (item >> 5); b = (item & 31) >> 2; n = item & 3; }
    else if (item < 608) { prompt = false; c = 0; const int j = item - 480; b = j >> 2; n = j & 3; }
    else { prompt = true; const int j = item - 608; c = 16 - (j >> 5); b = (j & 31) >> 2; n = j & 3; }
    const bf16* H = (const bf16*)(C.ws + WS_H); bf16* CAT = (bf16*)(C.ws + WS_CAT);
    int tid_ = C.tid; asm volatile("" : "+v"(tid_));
    const int tid = tid_, lane = tid & 63, wave = __builtin_amdgcn_readfirstlane(tid >> 6);
    const int row0 = prompt ? b * PSEQ + c * 64 : NPROW + b * SSEQ;
    const int past = prompt ? 0 : PAST, t0 = prompt ? c * 64 : 0;
    const int L = prompt ? (c + 1) * 64 : SLEN, nkt = L / 64;
    const int ntile = prompt ? PSEQ / 64 : SLEN / 64;
    LAS unsigned long long* MSK = (LAS unsigned long long*)(C.lds + A_MSK);
    LAS unsigned char* KS = C.lds + A_KS; LAS unsigned char* VS = C.lds + A_VS;
    const LAS float* LUT = (const LAS float*)(C.lds + A_LUT);
    __syncthreads();
    {
        const v4u* mg = (const v4u*)(C.out + OS_MSK + (size_t)row0 * 64);
        ((LAS v4u*)MSK)[tid] = mg[tid]; ((LAS v4u*)MSK)[tid + 512] = mg[tid + 512];
    }
    const int g = wave & 3, qh = wave >> 2, h = lane >> 5, l31 = lane & 31;
    const int ql = qh * 32 + l31, qpos = past + t0 + ql, qpos_min = past + t0 + qh * 32;
    const float SC2 = QSCALE * LOG2E;
    const int head = n * 4 + g;
    bf16x8 qf[8];
#pragma unroll
    for (int s = 0; s < 8; ++s) qf[s] = *(const bf16x8*)(H + (size_t)(row0 + ql) * LDH + HQ + head * 128 + 16 * s + 8 * h);
    f32x16 oacc[4];
#pragma unroll
    for (int db = 0; db < 4; ++db)
#pragma unroll
        for (int r = 0; r < 16; ++r) oacc[db][r] = 0.f;
    float m_run = -INFINITY, l_run = 0.f;
    const float bfar = inp(C, I_RELB)[15 * 16 + head] * LOG2E;
    const LAS float* lut = LUT + head * 256;
    v4u kreg[2], vreg[2];
    const unsigned koffH0 = (unsigned)(tid >> 4) * LDH + (unsigned)(tid & 15) * 8u, koffH1 = koffH0 + 32u * LDH;
    const unsigned koffC0 = (unsigned)(tid >> 4) * 512u + (unsigned)(tid & 15) * 8u, koffC1 = koffC0 + 32u * 512u;
#define ATT_LOADK(KT) do { const int kt_ = (KT); \
        if (prompt || kt_ == 16) { const bf16* kb_ = H + (size_t)(prompt ? b * PSEQ + kt_ * 64 : NPROW + b * SSEQ) * LDH + HK + n * 128; kreg[0] = *(const v4u*)(kb_ + koffH0); kreg[1] = *(const v4u*)(kb_ + koffH1); } \
        else { const float* cb_ = inp(C, I_CK) + ((size_t)(b * PAST + kt_ * 64) * 4 + n) * 128; \
               const f32x4 x0 = *(const f32x4*)(cb_ + koffC0), x1 = *(const f32x4*)(cb_ + koffC0 + 4), y0 = *(const f32x4*)(cb_ + koffC1), y1 = *(const f32x4*)(cb_ + koffC1 + 4); \
               kreg[0].x = pk2(x0.x, x0.y); kreg[0].y = pk2(x0.z, x0.w); kreg[0].z = pk2(x1.x, x1.y); kreg[0].w = pk2(x1.z, x1.w); \
               kreg[1].x = pk2(y0.x, y0.y); kreg[1].y = pk2(y0.z, y0.w); kreg[1].z = pk2(y1.x, y1.y); kreg[1].w = pk2(y1.z, y1.w); } } while (0)
#define ATT_LOADV(KT) do { const int kt_ = (KT); \
        if (prompt || kt_ == 16) { const bf16* vb_ = H + (size_t)(prompt ? b * PSEQ + kt_ * 64 : NPROW + b * SSEQ) * LDH + HV + n * 128; vreg[0] = *(const v4u*)(vb_ + koffH0); vreg[1] = *(const v4u*)(vb_ + koffH1); } \
        else { const float* cb_ = inp(C, I_CV) + ((size_t)(b * PAST + kt_ * 64) * 4 + n) * 128; \
               const f32x4 x0 = *(const f32x4*)(cb_ + koffC0), x1 = *(const f32x4*)(cb_ + koffC0 + 4), y0 = *(const f32x4*)(cb_ + koffC1), y1 = *(const f32x4*)(cb_ + koffC1 + 4); \
               vreg[0].x = pk2(x0.x, x0.y); vreg[0].y = pk2(x0.z, x0.w); vreg[0].z = pk2(x1.x, x1.y); vreg[0].w = pk2(x1.z, x1.w); \
               vreg[1].x = pk2(y0.x, y0.y); vreg[1].y = pk2(y0.z, y0.w); vreg[1].z = pk2(y1.x, y1.y); vreg[1].w = pk2(y1.z, y1.w); } } while (0)
    f32x16 s0, s1; bf16x8 pb[2][2];
    auto STK = [&](const int slot) __attribute__((always_inline)) {
#pragma unroll
        for (int i = 0; i < 2; ++i) { const int cid = tid + 512 * i; *(LAS v4u*)(KS + slot * A_BUF + (cid >> 4) * 272 + (cid & 15) * 16) = kreg[i]; } };
    auto STV = [&](const int slot) __attribute__((always_inline)) {
#pragma unroll
        for (int i = 0; i < 2; ++i) { const int cid = tid + 512 * i; *(LAS v4u*)(VS + slot * A_BUF + (cid >> 4) * 272 + (cid & 15) * 16) = vreg[i]; } };
    auto QK = [&](const int kt) __attribute__((always_inline)) {
        LAS unsigned char* KSk = KS + (kt & 1) * A_BUF;
#pragma unroll
        for (int r = 0; r < 16; ++r) { s0[r] = 0.f; s1[r] = 0.f; }
        {
            const unsigned kaddr = (unsigned)(size_t)(KSk + l31 * 272 + 16 * h);
            asm volatile("" ::: "memory");
#pragma unroll
            for (int s4 = 0; s4 < 2; ++s4) {
                bf16x8 kA[4], kB[4];
#pragma unroll
                for (int s = 0; s < 4; ++s) { DS_RD128(kA[s], kaddr, 32 * (4 * s4 + s)); DS_RD128(kB[s], kaddr, 32 * 272 + 32 * (4 * s4 + s)); }
                asm volatile("s_waitcnt lgkmcnt(0)" : "+v"(kA[0]), "+v"(kA[1]), "+v"(kA[2]), "+v"(kA[3]), "+v"(kB[0]), "+v"(kB[1]), "+v"(kB[2]), "+v"(kB[3]));
#pragma unroll
                for (int s = 0; s < 4; ++s) {
                    s0 = __builtin_amdgcn_mfma_f32_32x32x16_bf16(kA[s], qf[4 * s4 + s], s0, 0, 0, 0);
                    s1 = __builtin_amdgcn_mfma_f32_32x32x16_bf16(kB[s], qf[4 * s4 + s], s1, 0, 0, 0);
                }
            }
        }
        asm volatile("s_nop 7\n\ts_nop 7\n\ts_nop 3" : "+v"(s0), "+v"(s1));
    };
    auto SM = [&](const int kt) __attribute__((always_inline)) {
        const unsigned long long mw = MSK[ql * 32 + kt];
        const unsigned wlo = (unsigned)mw >> (4 * h), whi = (unsigned)(mw >> 32) >> (4 * h);
        const bool far = (kt * 64 + 63 - qpos_min) <= -91;
        float mx;
        if (far) {
            float a = max3f(s0[0], s0[1], s0[2]), bq = max3f(s1[0], s1[1], s1[2]);
#pragma unroll
            for (int r = 3; r < 15; r += 2) { a = max3f(a, s0[r], s0[r + 1]); bq = max3f(bq, s1[r], s1[r + 1]); }
            mx = fmaf(max3f(a, bq, fmaxf(s0[15], s1[15])), SC2, bfar);
        } else {
            const int relb0 = kt * 64 + 4 * h - qpos + 191;
#pragma unroll
            for (int r = 0; r < 16; ++r) { const int cr = (r & 3) + 8 * (r >> 2);
                s0[r] = fmaf(s0[r], SC2, lut[relb0 + cr]); s1[r] = fmaf(s1[r], SC2, lut[relb0 + 32 + cr]); }
            float a = max3f(s0[0], s0[1], s0[2]), bq = max3f(s1[0], s1[1], s1[2]);
#pragma unroll
            for (int r = 3; r < 15; r += 2) { a = max3f(a, s0[r], s0[r + 1]); bq = max3f(bq, s1[r], s1[r + 1]); }
            mx = max3f(a, bq, fmaxf(s0[15], s1[15]));
        }
        mx = fmaxf(mx, __shfl_xor(mx, 32));
        const float m_new = fmaxf(m_run, mx);
        if (__any(m_new != m_run)) {
            const float alpha = __builtin_amdgcn_exp2f(m_run - m_new);
            l_run *= alpha;
#pragma unroll
            for (int db = 0; db < 4; ++db)
#pragma unroll
                for (int r = 0; r < 16; ++r) oacc[db][r] *= alpha;
        }
        m_run = m_new;
        const float sc = far ? SC2 : 1.f, sb = far ? bfar - m_new : -m_new;
        float psum = 0.f;
#pragma unroll
        for (int r = 0; r < 16; ++r) { const int cr = (r & 3) + 8 * (r >> 2);
            const float p0 = __builtin_amdgcn_exp2f(fmaf(s0[r], sc, sb)), p1 = __builtin_amdgcn_exp2f(fmaf(s1[r], sc, sb));
            unsigned m0, m1;
            asm("v_bfe_i32 %0, %1, %c2, 1" : "=v"(m0) : "v"(wlo), "i"(cr)); asm("v_bfe_i32 %0, %1, %c2, 1" : "=v"(m1) : "v"(whi), "i"(cr));
            s0[r] = __uint_as_float(__float_as_uint(p0) & m0); s1[r] = __uint_as_float(__float_as_uint(p1) & m1);
            psum += s0[r] + s1[r]; }
        l_run += psum;
#pragma unroll
        for (int s = 0; s < 2; ++s) {
            v4u w0, w1;
            w0.x = pk2(s0[8 * s + 0], s0[8 * s + 1]); w0.y = pk2(s0[8 * s + 2], s0[8 * s + 3]); w0.z = pk2(s0[8 * s + 4], s0[8 * s + 5]); w0.w = pk2(s0[8 * s + 6], s0[8 * s + 7]);
            w1.x = pk2(s1[8 * s + 0], s1[8 * s + 1]); w1.y = pk2(s1[8 * s + 2], s1[8 * s + 3]); w1.z = pk2(s1[8 * s + 4], s1[8 * s + 5]); w1.w = pk2(s1[8 * s + 6], s1[8 * s + 7]);
            pb[0][s] = __builtin_bit_cast(bf16x8, w0); pb[1][s] = __builtin_bit_cast(bf16x8, w1);
        }
    };
    auto PV = [&](const int kt) __attribute__((always_inline)) {
        LAS unsigned char* VSk = VS + (kt & 1) * A_BUF;
        {
            const unsigned vaddr = (unsigned)(size_t)(VSk + (4 * h + ((lane & 15) >> 2)) * 272 + (16 * ((lane >> 4) & 1) + 4 * (lane & 3)) * 2);
#pragma unroll
            for (int d2 = 0; d2 < 2; ++d2) {
                v2u vlo[8], vhi[8];
#pragma unroll
                for (int dd = 0; dd < 2; ++dd)
#pragma unroll
                    for (int ks = 0; ks < 4; ++ks) { DS_RDTR(vlo[dd * 4 + ks], vaddr, ks * 4352 + (2 * d2 + dd) * 64); DS_RDTR(vhi[dd * 4 + ks], vaddr, ks * 4352 + 2176 + (2 * d2 + dd) * 64); }
                asm volatile("s_waitcnt lgkmcnt(0)" : "+v"(vlo[0]), "+v"(vlo[1]), "+v"(vlo[2]), "+v"(vlo[3]), "+v"(vlo[4]), "+v"(vlo[5]), "+v"(vlo[6]), "+v"(vlo[7]),
                                                      "+v"(vhi[0]), "+v"(vhi[1]), "+v"(vhi[2]), "+v"(vhi[3]), "+v"(vhi[4]), "+v"(vhi[5]), "+v"(vhi[6]), "+v"(vhi[7]));
#pragma unroll
                for (int dd = 0; dd < 2; ++dd)
#pragma unroll
                    for (int ks = 0; ks < 4; ++ks) {
                        const bf16x8 a = __builtin_bit_cast(bf16x8, (v4u){vlo[dd * 4 + ks].x, vlo[dd * 4 + ks].y, vhi[dd * 4 + ks].x, vhi[dd * 4 + ks].y});
                        oacc[2 * d2 + dd] = __builtin_amdgcn_mfma_f32_32x32x16_bf16(a, pb[ks >> 1][ks & 1], oacc[2 * d2 + dd], 0, 0, 0);
                    }
            }
        }
    };
    ATT_LOADK(0); STK(0);
    ATT_LOADK(nkt > 1 ? 1 : 0); ATT_LOADV(0);
#define ATT_STAGE(t) do { if ((t) + 1 < nkt) STK(((t) + 1) & 1); STV((t) & 1); if ((t) + 2 < nkt) ATT_LOADK((t) + 2); if ((t) + 1 < nkt) ATT_LOADV((t) + 1); } while (0)
    if (qh == 0) {
#pragma unroll 1
        for (int t = 0; t < nkt; ++t) {
            __syncthreads(); ATT_STAGE(t);
            __builtin_amdgcn_s_setprio(2);
            if (t > 0) PV(t - 1);
            QK(t);
            __builtin_amdgcn_s_setprio(0);
            __syncthreads();
            SM(t);
        }
        __syncthreads();
        PV(nkt - 1);
        __syncthreads();
    } else {
#pragma unroll 1
        for (int t = 0; t < nkt; ++t) {
            __syncthreads(); ATT_STAGE(t);
            if (t > 0) SM(t - 1);
            __syncthreads();
            __builtin_amdgcn_s_setprio(2);
            if (t > 0) PV(t - 1);
            QK(t);
            __builtin_amdgcn_s_setprio(0);
        }
        __syncthreads();
        SM(nkt - 1);
        __syncthreads();
        PV(nkt - 1);
    }
#undef ATT_STAGE
#undef ATT_LOADK
#undef ATT_LOADV
    const float inv = 1.f / (l_run + __shfl_xor(l_run, 32));
    bf16* op = CAT + (size_t)(row0 + ql) * DM + head * 128 + 4 * h;
#pragma unroll
    for (int db = 0; db < 4; ++db)
#pragma unroll
        for (int q4 = 0; q4 < 4; ++q4) {
#if MIX_FP8
            *(unsigned*)((unsigned char*)CAT + (size_t)(row0 + ql) * DM + head * 128 + 4 * h + 32 * db + 8 * q4) = pk4_fp8(oacc[db][4 * q4 + 0] * (inv * CAT_Q), oacc[db][4 * q4 + 1] * (inv * CAT_Q), oacc[db][4 * q4 + 2] * (inv * CAT_Q), oacc[db][4 * q4 + 3] * (inv * CAT_Q));
#else
            v2u w; w.x = pk2(oacc[db][4 * q4 + 0] * inv, oacc[db][4 * q4 + 1] * inv); w.y = pk2(oacc[db][4 * q4 + 2] * inv, oacc[db][4 * q4 + 3] * inv);
            *(v2u*)(op + 32 * db + 8 * q4) = w;
#endif
        }
}
#endif

__device__ __forceinline__ void phase5(const Ctx& C) {
    LAS float* scr = (LAS float*)(C.lds + C.wave * 16384);
    const int gw = C.bid * NWAVES + C.wave, NGW = C.G * NWAVES;
    bf16* WupT = (bf16*)(C.ws + WS_WUP); bf16* WdnT = (bf16*)(C.ws + WS_WDN); bf16* X1 = (bf16*)(C.ws + WS_XN);
    { LnP P; ln_params(P, inp(C, I_LN1G), inp(C, I_LN1B), C.lane);
#pragma unroll 1
      for (int m = gw; m < MTOK; m += NGW) ln_row<false, true, true>((const bf16*)(C.ws + WS_PRE1) + (size_t)m * DM, P, X1 + (size_t)m * LDX, C.lane, (const unsigned*)(C.ctl + CW_TIX2) + (m >> 8) * 16, (const float*)(C.ws + WS_P2), m & 255); }
#if defined(PROBE_DUP) && PROBE_DUP == 9
    { LnP P; ln_params(P, inp(C, I_LN1G), inp(C, I_LN1B), C.lane);
#pragma unroll 1
      for (int m = gw; m < MTOK; m += NGW) ln_row<false, true, true>((const bf16*)(C.ws + WS_PRE1) + (size_t)m * DM, P, X1 + (size_t)m * LDX, C.lane, (const unsigned*)(C.ctl + CW_TIX2) + (m >> 8) * 16, (const float*)(C.ws + WS_P2), m & 255); }
#endif
    constexpr int I_UP = (DM / 64) * (DFF2 / 32), I_DN = (DFF / 64) * (DM / 32);
#if !WUP_EARLY
    transpose_static<2>(inp(C, I_WUP), DM, DFF2, WupT, I_UP, scr, gw, NGW, C.lane); (void)WdnT; (void)I_DN;
#else
    (void)scr; (void)WupT; (void)WdnT; (void)I_UP; (void)I_DN;
#endif
}
__device__ __forceinline__ void ffn_fixup(const Ctx& C) {
    const bf16* UPS = (const bf16*)(C.ws + WS_UPS); bf16* ACT = (bf16*)(C.ws + WS_ACT);
    const float* fw = inp(C, I_FCW); const float* fb = inp(C, I_FCB); const float* st = inp(C, I_SFFN);
    const int gt = C.bid * (NWAVES * 64) + C.tid, NGT = C.G * NWAVES * 64;
    for (int it = gt; it < 576 * (DFF / 4); it += NGT) {
        const int ri = it / (DFF / 4), j = (it % (DFF / 4)) * 4, blk = ri >> 1, w = ri & 1, row = blk * 64 + w;
        const bool prompt = row < NPROW; const int r2 = row - NPROW;
        const int b = prompt ? (row >> 11) : (r2 >> 6), t = prompt ? (row & 2047) : (r2 & 63);
        f32x4 g[3], v[3];
        v2u ua[3], uc[3]; f32x4 sg[3], sv[3];
#pragma unroll
        for (int k = 0; k < 3; ++k) {
            const int dt = k - 2, tt = t + dt;
            const int rr = max(row + dt, 0), bb = rr >> 6, idx = ((rr & 63) + 2) & 63;
            ua[k] = *(const v2u*)(UPS + (size_t)(bb * 4 + idx) * DFF2 + j); uc[k] = *(const v2u*)(UPS + (size_t)(bb * 4 + idx) * DFF2 + DFF + j);
            const int si = min(max(2 + tt, 0), 1), bs = prompt ? 0 : b;
            sg[k] = *(const f32x4*)(st + (size_t)(bs * 2 + si) * DFF2 + j); sv[k] = *(const f32x4*)(st + (size_t)(bs * 2 + si) * DFF2 + DFF + j);
        }
        asm volatile("" : "+v"(ua[0]), "+v"(ua[1]), "+v"(ua[2]), "+v"(uc[0]), "+v"(uc[1]), "+v"(uc[2]), "+v"(sg[0]), "+v"(sg[1]), "+v"(sg[2]), "+v"(sv[0]), "+v"(sv[1]), "+v"(sv[2]));
#pragma unroll
        for (int k = 0; k < 3; ++k) {
            const int tt = t + k - 2;
            const float ks = (tt < 0 && !prompt) ? 1.f : 0.f;
            const f32x4 gu = (f32x4){bflo(ua[k].x), bfhi(ua[k].x), bflo(ua[k].y), bfhi(ua[k].y)}, vu = (f32x4){bflo(uc[k].x), bfhi(uc[k].x), bflo(uc[k].y), bfhi(uc[k].y)};
            g[k] = tt >= 0 ? gu : sg[k] * ks; v[k] = tt >= 0 ? vu : sv[k] * ks;
        }
        f32x4 G = *(const f32x4*)(fb + j), V = *(const f32x4*)(fb + DFF + j);
#pragma unroll
        for (int k = 0; k < 3; ++k) { G += *(const f32x4*)(fw + (size_t)k * DFF2 + j) * g[k]; V += *(const f32x4*)(fw + (size_t)k * DFF2 + DFF + j) * v[k]; }
#if FFN_DOWN_FP8
        *(unsigned*)((unsigned char*)ACT + (size_t)row * DFF + j) = pk4_fp8(silu_f(G.x) * V.x * ACT_Q, silu_f(G.y) * V.y * ACT_Q, silu_f(G.z) * V.z * ACT_Q, silu_f(G.w) * V.w * ACT_Q);
#else
        v2u o; o.x = pk2(silu_f(G.x) * V.x, silu_f(G.y) * V.y); o.y = pk2(silu_f(G.z) * V.z, silu_f(G.w) * V.w);
        *(v2u*)(ACT + (size_t)row * DFF + j) = o;
#endif
    }
}

__device__ __forceinline__ int crow16(int r, int h) { return (r & 3) + 8 * (r >> 2) + 4 * h; }
__device__ __forceinline__ bf16x8 pack8(float a0, float a1, float a2, float a3, float a4, float a5, float a6, float a7) {
    v4u w; w.x = pk2(a0, a1); w.y = pk2(a2, a3); w.z = pk2(a4, a5); w.w = pk2(a6, a7); return __builtin_bit_cast(bf16x8, w);
}
typedef short v4i16_t __attribute__((ext_vector_type(4)));
__device__ __forceinline__ v2u tr4(LAS unsigned char* tile, int row0, int col0, int lane) {
    const int q = (lane & 15) >> 2, p = lane & 3, blk = (lane >> 4) & 1;
    const v4i16_t r = __builtin_amdgcn_ds_read_tr16_b64_v4i16((LAS v4i16_t*)(tile + (row0 + q) * 272 + (col0 + 16 * blk + 4 * p) * 2));
    return __builtin_bit_cast(v2u, r);
}

template <int SIDX> __device__ __forceinline__ void dprep_pass(const Ctx& C, const bf16* H, bf16* QKVC, const float* cw, const float* cb, const float* st, LAS unsigned char* tile, int R0, int t0, bool prompt, int b, int h, int lane) {
    const int cch = SIDX * 2048 + h * 128 + 2 * lane;
    const f32x2 w0 = *(const f32x2*)(cw + cch), w1 = *(const f32x2*)(cw + CQKV + cch), w2 = *(const f32x2*)(cw + 2 * CQKV + cch), w3 = *(const f32x2*)(cw + 3 * CQKV + cch), bi = *(const f32x2*)(cb + cch);
    f32x2 xm3, xm2, xm1;
    const int Rh = R0 >= 3 ? R0 - 3 : 0, bs = prompt ? 0 : b;
    unsigned ha = *(const unsigned*)(H + (size_t)Rh * LDH + HQKV + cch), hb = *(const unsigned*)(H + (size_t)(Rh + 1) * LDH + HQKV + cch), hc = *(const unsigned*)(H + (size_t)(Rh + 2) * LDH + HQKV + cch);
    f32x2 s3 = *(const f32x2*)(st + (size_t)(bs * 3 + 0) * CQKV + cch), s2 = *(const f32x2*)(st + (size_t)(bs * 3 + 1) * CQKV + cch), s1 = *(const f32x2*)(st + (size_t)(bs * 3 + 2) * CQKV + cch);
    const float post = SIDX == 0 ? QSCALE : 1.f;
    unsigned xws[32];
#pragma unroll
    for (int i = 0; i < 32; ++i) xws[i] = *(const unsigned*)(H + (size_t)(R0 + i) * LDH + HQKV + cch);
    asm volatile("" : "+v"(ha), "+v"(hb), "+v"(hc), "+v"(s3), "+v"(s2), "+v"(s1));
    {
        const bool fromH = t0 > 0; const float ks = (!fromH && !prompt) ? 1.f : 0.f;
        xm3 = fromH ? (f32x2){bflo(ha), bfhi(ha)} : s3 * ks; xm2 = fromH ? (f32x2){bflo(hb), bfhi(hb)} : s2 * ks; xm1 = fromH ? (f32x2){bflo(hc), bfhi(hc)} : s1 * ks;
    }
#pragma unroll
    for (int i0 = 0; i0 < 32; i0 += 8) {
        f32x2 y[8];
#pragma unroll
        for (int j = 0; j < 8; ++j) {
            const unsigned xw = xws[i0 + j];
            const f32x2 x0 = (f32x2){bflo(xw), bfhi(xw)};
            y[j] = bi + w0 * xm3 + w1 * xm2 + w2 * xm1 + w3 * x0;
            xm3 = xm2; xm2 = xm1; xm1 = x0;
        }
#pragma unroll
        for (int j = 0; j < 8; ++j) { y[j].x = silu_f(y[j].x); y[j].y = silu_f(y[j].y); }
        if (SIDX < 2) {
            float ss[8];
#pragma unroll
            for (int j = 0; j < 8; ++j) ss[j] = wave_sum(y[j].x * y[j].x + y[j].y * y[j].y);
#pragma unroll
            for (int j = 0; j < 8; ++j) { const float sc = post * __builtin_amdgcn_rsqf(ss[j] + 1e-6f); y[j].x *= sc; y[j].y *= sc; }
        }
#pragma unroll
        for (int j = 0; j < 8; ++j) {
            const unsigned pw = pk2(y[j].x, y[j].y);
            *(unsigned*)(QKVC + (size_t)(R0 + i0 + j) * CQKV + cch) = pw;
            if (SIDX < 2) *(LAS unsigned*)(tile + (i0 + j) * 272 + 4 * lane) = pw;
        }
    }
}

__device__ __forceinline__ void dprep_unit(const Ctx& C, int u, int lane_in, LAS unsigned char* scr, const int pmode = 0) {
    int lane = lane_in; asm volatile("" : "+v"(lane));
    const bool prompt = u < 8192; const int u2 = u - 8192;
    const int bh = prompt ? (u >> 6) : (u2 >> 1), c = prompt ? (u & 63) : (u2 & 1), b = bh >> 4, h = bh & 15;
    const int R0 = (prompt ? b * PSEQ : NPROW + b * SSEQ) + c * 32, t0 = c * 32;
    const bf16* H = (const bf16*)(C.ws + WS_H); bf16* QKVC = (bf16*)(C.ws + WS_QKVC);
    const float* SM = C.out + OS_SM;
    const float* cw = inp(C, I_CQW); const float* cb = inp(C, I_CQB); const float* st = inp(C, I_SCONV);
    LAS unsigned char* tile = scr;
    LAS float* LT = (LAS float*)(scr + 8704);
    LAS float* Gs = LT + 32 * 36;
    LAS float* Bs = Gs + 32;
    const int l31 = lane & 31, hh = lane >> 5;
    bf16x8 kf[8], qf[8];
    if (pmode != 2)
    dprep_pass<1>(C, H, QKVC, cw, cb, st, tile, R0, t0, prompt, b, h, lane);
#pragma unroll
    for (int s = 0; s < 8; ++s) kf[s] = *(const LAS bf16x8*)(tile + l31 * 272 + 32 * s + 16 * hh);
    LDS_WAIT(); asm volatile("" ::: "memory");
    if (pmode != 2)
    dprep_pass<0>(C, H, QKVC, cw, cb, st, tile, R0, t0, prompt, b, h, lane);
#pragma unroll
    for (int s = 0; s < 8; ++s) qf[s] = *(const LAS bf16x8*)(tile + l31 * 272 + 32 * s + 16 * hh);
    LDS_WAIT(); asm volatile("" ::: "memory");
    if (pmode != 2)
    dprep_pass<2>(C, H, QKVC, cw, cb, st, tile, R0, t0, prompt, b, h, lane);
    LDS_WAIT(); asm volatile("" ::: "memory");
    if (pmode == 1) return;
    const size_t grow = (size_t)(R0 + l31);
    const float Aexp = expf(inp(C, I_ALOG)[h]), dtb = inp(C, I_DTB)[h];
    const float xg = SM[grow * 128 + 96 + h] + dtb; const float sp = xg > 20.f ? xg : log1pf(expf(xg));
    float G = -Aexp * sp;
#pragma unroll
    for (int off = 1; off < 32; off <<= 1) { const float t = __shfl_up(G, off, 32); if (l31 >= off) G += t; }
    const float beta = 1.f / (1.f + expf(-SM[grow * 128 + 80 + h]));
    if (lane < 32) { Gs[lane] = G; Bs[lane] = beta; (C.out + OS_GB)[grow * 16 + h] = G; }
    f32x16 KK, KQ;
#pragma unroll
    for (int r = 0; r < 16; ++r) { KK[r] = 0.f; KQ[r] = 0.f; }
#pragma unroll
    for (int s = 0; s < 8; ++s) { KK = __builtin_amdgcn_mfma_f32_32x32x16_bf16(kf[s], kf[s], KK, 0, 0, 0); KQ = __builtin_amdgcn_mfma_f32_32x32x16_bf16(kf[s], qf[s], KQ, 0, 0, 0); }
    LDS_WAIT(); asm volatile("" ::: "memory");
    float mfv[16];
#pragma unroll
    for (int q4 = 0; q4 < 4; ++q4) {
        const f32x4 Gm = *(const LAS f32x4*)(Gs + 8 * q4 + 4 * hh), Bm = *(const LAS f32x4*)(Bs + 8 * q4 + 4 * hh);
        f32x4 lv;
#pragma unroll
        for (int e = 0; e < 4; ++e) {
            const int r = 4 * q4 + e, m = 8 * q4 + 4 * hh + e;
            lv[e] = (m > l31) ? Bm[e] * KK[r] * __expf(Gm[e] - G) : 0.f;
            mfv[r] = (l31 >= m) ? KQ[r] * __expf(G - Gm[e]) : 0.f;
        }
        *(LAS f32x4*)(LT + l31 * 36 + 8 * q4 + 4 * hh) = lv;
    }
    {
        float* mff = C.out + OS_MFF + (size_t)u * 512;
        *(bf16x8*)(mff + (0 * 64 + lane) * 4) = pack8(mfv[0], mfv[1], mfv[2], mfv[3], mfv[4], mfv[5], mfv[6], mfv[7]);
        *(bf16x8*)(mff + (1 * 64 + lane) * 4) = pack8(mfv[8], mfv[9], mfv[10], mfv[11], mfv[12], mfv[13], mfv[14], mfv[15]);
    }
    LDS_WAIT(); asm volatile("" ::: "memory");
    LAS float* Tm = (LAS float*)scr + l31 * 33;
    for (int j = 31; j >= 0; --j) {
        float p = 0.f;
        const LAS float* lrow = LT + j * 36;
#pragma unroll 4
        for (int i2 = j + 1 + hh; i2 < 32; i2 += 2) p += Tm[i2] * lrow[i2];
        const auto rr = __builtin_amdgcn_permlane32_swap(__float_as_uint(p), __float_as_uint(p), false, false);
        Tm[j] = ((l31 == j) ? 1.f : 0.f) - (__uint_as_float(rr[0]) + __uint_as_float(rr[1]));
    }
    const float eG = __expf(G);
    if (lane < 32) Gs[lane] = beta * eG;
    LDS_WAIT(); asm volatile("" ::: "memory");
    float* tbf = C.out + OS_TBF + (size_t)u * 512; float* tgf = C.out + OS_TGF + (size_t)u * 512;
#pragma unroll
    for (int s = 0; s < 2; ++s) {
        float a[8], g8[8];
#pragma unroll
        for (int jj = 0; jj < 8; ++jj) {
            const int jn = 16 * s + 8 * hh + jj;
            const int jk = 16 * s + 8 * (jj >> 2) + 4 * hh + (jj & 3);
            a[jj] = Tm[jn] * Bs[jn]; g8[jj] = Tm[jk] * Gs[jk];
        }
        *(bf16x8*)(tbf + (s * 64 + lane) * 4) = pack8(a[0], a[1], a[2], a[3], a[4], a[5], a[6], a[7]);
        *(bf16x8*)(tgf + (s * 64 + lane) * 4) = pack8(g8[0], g8[1], g8[2], g8[3], g8[4], g8[5], g8[6], g8[7]);
    }
    LDS_WAIT(); asm volatile("" ::: "memory");
}

constexpr int DS_BASE = 16384, DS_TILE = 32 * 272, DS_FR = 3 * DS_TILE, DS_SCL = DS_FR + 6144, DS_OB = DS_SCL + 320, DS_HALF = DS_OB + 32 * 132 * 4;
static_assert(DS_BASE + 2 * DS_HALF <= RING_BYTES && DS_HALF % 16 == 0, "dscan LDS map");
__device__ __forceinline__ void dscan_unit(const Ctx& C, int item, const int HOT = 0) {
    int tid_ = C.tid; asm volatile("" : "+v"(tid_));
    const int tid = tid_, lane = tid & 63, wave = __builtin_amdgcn_readfirstlane(tid >> 6);
    const bool prompt = item < 64;
    const int half = wave >> 2, eb = wave & 3, ht = tid & 255;
    const int bh = prompt ? item * 2 + half : (item - 64) * 2 + half, b = bh >> 4, h = bh & 15;
    const int nch = prompt ? 64 : 2, rowbase = prompt ? b * PSEQ : NPROW + b * SSEQ, ubase = prompt ? bh * 64 : 8192 + bh * 2;
    const bf16* H = (const bf16*)(C.ws + WS_H); const bf16* QKVC = (const bf16*)(C.ws + WS_QKVC); bf16* CAT = (bf16*)(C.ws + WS_CAT);
    LAS unsigned char* hb = C.lds + DS_BASE + half * DS_HALF;
    LAS unsigned char* QT = hb; LAS unsigned char* KT = hb + DS_TILE; LAS unsigned char* VT_ = hb + 2 * DS_TILE;
    LAS unsigned char* FR = hb + DS_FR; LAS float* SCL = (LAS float*)(hb + DS_SCL); LAS float* OB = (LAS float*)(hb + DS_OB);
    const int l31 = lane & 31, hh = lane >> 5;
    f32x16 S[4];
    if (prompt) {
#pragma unroll
        for (int db = 0; db < 4; ++db)
#pragma unroll
            for (int r = 0; r < 16; ++r) S[db][r] = 0.f;
    } else {
        const float* s0 = inp(C, I_SDELTA) + (size_t)bh * 128 * 128 + 32 * eb + l31;
#pragma unroll
        for (int db = 0; db < 4; ++db)
#pragma unroll
            for (int r = 0; r < 16; ++r) S[db][r] = s0[(size_t)(32 * db + crow16(r, hh)) * 128];
    }
    const f32x2 gn = *(const f32x2*)(inp(C, I_DNG) + 2 * lane);
    v4u sreg[8]; float gi = 0.f, gl_ = 0.f;
#define DS_REQ(CH) do { const int R0_ = rowbase + (HOT ? 0 : (CH)) * 32, u_ = ubase + (HOT ? 0 : (CH)); \
        const bf16* qb_ = QKVC + (size_t)R0_ * CQKV + h * 128; const float* fb_ = C.out + (size_t)u_ * 512;     \
        _Pragma("unroll") for (int k_ = 0; k_ < 6; ++k_) { const unsigned idx = (unsigned)ht + 256u * k_, which = idx >> 9, r = (idx & 511u) >> 4, pc = idx & 15u; \
            sreg[k_] = *(const v4u*)(qb_ + (r * (unsigned)CQKV + which * 2048u + pc * 8u)); } \
        _Pragma("unroll") for (int k_ = 0; k_ < 2; ++k_) { const unsigned idx = (unsigned)ht + 256u * k_; if (idx < 384u) { const unsigned f = idx >> 7, rest = idx & 127u; \
            sreg[6 + k_] = *(const v4u*)(fb_ + ((f == 0 ? OS_TBF : f == 1 ? OS_TGF : OS_MFF) + rest * 4u)); } } \
        if (ht < 32) { const float* gb = C.out + OS_GB + (size_t)R0_ * 16 + h; gi = gb[ht * 16]; gl_ = gb[31 * 16]; } } while (0)
    DS_REQ(0);
#pragma unroll 1
    for (int ch = 0; ch < nch; ++ch) {
        const int R0 = rowbase + ch * 32;
#pragma unroll
        for (int k_ = 0; k_ < 6; ++k_) { const int idx = ht + 256 * k_, which = idx >> 9, r = (idx & 511) >> 4, pc = idx & 15; *(LAS v4u*)(hb + which * DS_TILE + r * 272 + pc * 16) = sreg[k_]; }
#pragma unroll
        for (int k_ = 0; k_ < 2; ++k_) { const int idx = ht + 256 * k_; if (idx < 384) *(LAS v4u*)(FR + idx * 16) = sreg[6 + k_]; }
        if (ht < 32) { SCL[ht] = __expf(gi); SCL[32 + ht] = __expf(gl_ - gi); if (ht == 0) SCL[64] = __expf(gl_); }
        __syncthreads();
        if (ch + 1 < nch) DS_REQ(ch + 1);
        f32x16 un;
#pragma unroll
        for (int r = 0; r < 16; ++r) un[r] = 0.f;
        {
            const bf16x8 tb0 = *(const LAS bf16x8*)(FR + lane * 16), tb1 = *(const LAS bf16x8*)(FR + (64 + lane) * 16);
            const v2u a0 = tr4(VT_, 8 * hh, 32 * eb, lane), a1 = tr4(VT_, 8 * hh + 4, 32 * eb, lane), b0 = tr4(VT_, 16 + 8 * hh, 32 * eb, lane), b1 = tr4(VT_, 16 + 8 * hh + 4, 32 * eb, lane);
            un = __builtin_amdgcn_mfma_f32_32x32x16_bf16(tb0, __builtin_bit_cast(bf16x8, (v4u){a0.x, a0.y, a1.x, a1.y}), un, 0, 0, 0);
            un = __builtin_amdgcn_mfma_f32_32x32x16_bf16(tb1, __builtin_bit_cast(bf16x8, (v4u){b0.x, b0.y, b1.x, b1.y}), un, 0, 0, 0);
        }
        {
            const bf16x8 tg0 = *(const LAS bf16x8*)(FR + 2048 + lane * 16), tg1 = *(const LAS bf16x8*)(FR + 2048 + (64 + lane) * 16);
#pragma unroll
            for (int db = 0; db < 4; ++db) {
                const v2u l0 = tr4(KT, 4 * hh, 32 * db, lane), h0 = tr4(KT, 8 + 4 * hh, 32 * db, lane), l1 = tr4(KT, 16 + 4 * hh, 32 * db, lane), h1 = tr4(KT, 24 + 4 * hh, 32 * db, lane);
                f32x16 w;
#pragma unroll
                for (int r = 0; r < 16; ++r) w[r] = 0.f;
                w = __builtin_amdgcn_mfma_f32_32x32x16_bf16(__builtin_bit_cast(bf16x8, (v4u){l0.x, l0.y, h0.x, h0.y}), tg0, w, 0, 0, 0);
                w = __builtin_amdgcn_mfma_f32_32x32x16_bf16(__builtin_bit_cast(bf16x8, (v4u){l1.x, l1.y, h1.x, h1.y}), tg1, w, 0, 0, 0);
                const bf16x8 wA0 = pack8(-w[0], -w[1], -w[2], -w[3], -w[4], -w[5], -w[6], -w[7]), wA1 = pack8(-w[8], -w[9], -w[10], -w[11], -w[12], -w[13], -w[14], -w[15]);
                const bf16x8 SB0 = pack8(S[db][0], S[db][1], S[db][2], S[db][3], S[db][4], S[db][5], S[db][6], S[db][7]);
                const bf16x8 SB1 = pack8(S[db][8], S[db][9], S[db][10], S[db][11], S[db][12], S[db][13], S[db][14], S[db][15]);
                un = __builtin_amdgcn_mfma_f32_32x32x16_bf16(wA0, SB0, un, 0, 0, 0);
                un = __builtin_amdgcn_mfma_f32_32x32x16_bf16(wA1, SB1, un, 0, 0, 0);
            }
        }
        bf16x8 vnB0, vnB1, vnS0, vnS1;
        {
            float vn[16], dc[16];
#pragma unroll
            for (int q4 = 0; q4 < 4; ++q4) {
                const f32x4 d4 = *(const LAS f32x4*)(SCL + 32 + 8 * q4 + 4 * hh);
#pragma unroll
                for (int e = 0; e < 4; ++e) { dc[4 * q4 + e] = d4[e]; vn[4 * q4 + e] = un[4 * q4 + e]; }
            }
            vnB0 = pack8(vn[0], vn[1], vn[2], vn[3], vn[4], vn[5], vn[6], vn[7]); vnB1 = pack8(vn[8], vn[9], vn[10], vn[11], vn[12], vn[13], vn[14], vn[15]);
            vnS0 = pack8(vn[0] * dc[0], vn[1] * dc[1], vn[2] * dc[2], vn[3] * dc[3], vn[4] * dc[4], vn[5] * dc[5], vn[6] * dc[6], vn[7] * dc[7]);
            vnS1 = pack8(vn[8] * dc[8], vn[9] * dc[9], vn[10] * dc[10], vn[11] * dc[11], vn[12] * dc[12], vn[13] * dc[13], vn[14] * dc[14], vn[15] * dc[15]);
        }
        unsigned zreg[8];
#pragma unroll
        for (int jr = 0; jr < 8; ++jr) zreg[jr] = *(const unsigned*)(H + (size_t)((HOT ? rowbase : R0) + eb * 8 + jr) * LDH + HZ + h * 128 + 2 * lane);
        f32x16 qs, o2;
#pragma unroll
        for (int r = 0; r < 16; ++r) { qs[r] = 0.f; o2[r] = 0.f; }
        const float gl = SCL[64];
#pragma unroll
        for (int db = 0; db < 4; ++db) {
            const bf16x8 SB0 = pack8(S[db][0], S[db][1], S[db][2], S[db][3], S[db][4], S[db][5], S[db][6], S[db][7]);
            const bf16x8 SB1 = pack8(S[db][8], S[db][9], S[db][10], S[db][11], S[db][12], S[db][13], S[db][14], S[db][15]);
            const LAS unsigned char* qp = QT + l31 * 272 + (32 * db + 4 * hh) * 2;
            const v2u ql0 = *(const LAS v2u*)qp, qh0 = *(const LAS v2u*)(qp + 16), ql1 = *(const LAS v2u*)(qp + 32), qh1 = *(const LAS v2u*)(qp + 48);
            qs = __builtin_amdgcn_mfma_f32_32x32x16_bf16(__builtin_bit_cast(bf16x8, (v4u){ql0.x, ql0.y, qh0.x, qh0.y}), SB0, qs, 0, 0, 0);
            qs = __builtin_amdgcn_mfma_f32_32x32x16_bf16(__builtin_bit_cast(bf16x8, (v4u){ql1.x, ql1.y, qh1.x, qh1.y}), SB1, qs, 0, 0, 0);
            const v2u l0 = tr4(KT, 4 * hh, 32 * db, lane), h0 = tr4(KT, 8 + 4 * hh, 32 * db, lane), l1 = tr4(KT, 16 + 4 * hh, 32 * db, lane), h1 = tr4(KT, 24 + 4 * hh, 32 * db, lane);
#pragma unroll
            for (int r = 0; r < 16; ++r) S[db][r] *= gl;
            S[db] = __builtin_amdgcn_mfma_f32_32x32x16_bf16(__builtin_bit_cast(bf16x8, (v4u){l0.x, l0.y, h0.x, h0.y}), vnS0, S[db], 0, 0, 0);
            S[db] = __builtin_amdgcn_mfma_f32_32x32x16_bf16(__builtin_bit_cast(bf16x8, (v4u){l1.x, l1.y, h1.x, h1.y}), vnS1, S[db], 0, 0, 0);
        }
        {
            const bf16x8 mf0 = *(const LAS bf16x8*)(FR + 4096 + lane * 16), mf1 = *(const LAS bf16x8*)(FR + 4096 + (64 + lane) * 16);
            o2 = __builtin_amdgcn_mfma_f32_32x32x16_bf16(mf0, vnB0, o2, 0, 0, 0);
            o2 = __builtin_amdgcn_mfma_f32_32x32x16_bf16(mf1, vnB1, o2, 0, 0, 0);
        }
        float eg[16];
#pragma unroll
        for (int q4 = 0; q4 < 4; ++q4) { const f32x4 e4 = *(const LAS f32x4*)(SCL + 8 * q4 + 4 * hh); eg[4 * q4] = e4[0]; eg[4 * q4 + 1] = e4[1]; eg[4 * q4 + 2] = e4[2]; eg[4 * q4 + 3] = e4[3]; }
#pragma unroll
        for (int r = 0; r < 16; ++r) OB[crow16(r, hh) * 132 + 32 * eb + l31] = qs[r] * eg[r] + o2[r];
        __syncthreads();
        f32x2 ovv[8]; float ssq[8];
#pragma unroll
        for (int jr = 0; jr < 8; ++jr) ovv[jr] = *(const LAS f32x2*)(OB + (eb * 8 + jr) * 132 + 2 * lane);
#pragma unroll
        for (int jr = 0; jr < 8; ++jr) ssq[jr] = wave_sum(ovv[jr].x * ovv[jr].x + ovv[jr].y * ovv[jr].y);
#pragma unroll
        for (int jr = 0; jr < 8; ++jr) {
            const int i = eb * 8 + jr; const size_t row = (size_t)(R0 + i);
            const f32x2 ov = ovv[jr];
            const float rs = __builtin_amdgcn_rsqf(ssq[jr] * (1.f / 128.f) + LN_EPS);
            const unsigned zw = zreg[jr];
#if MIX_FP8
            *(unsigned short*)((unsigned char*)(HOT ? (bf16*)(C.ws + 427 * MiB) : CAT) + (HOT ? (size_t)i : row) * DM + 2048 + h * 128 + 2 * lane) = (unsigned short)pk4_fp8(ov.x * rs * gn.x * silu_f(bflo(zw)) * CAT_Q, ov.y * rs * gn.y * silu_f(bfhi(zw)) * CAT_Q, 0.f, 0.f);
#else
            *(unsigned*)(CAT + row * DM + 2048 + h * 128 + 2 * lane) = pk2(ov.x * rs * gn.x * silu_f(bflo(zw)), ov.y * rs * gn.y * silu_f(bfhi(zw)));
#endif
        }
    }
#undef DS_REQ
    float* so = HOT ? (float*)(C.ws + 427 * MiB + 262144) + (size_t)(bh & 15) * 128 * 128 + 32 * eb + l31 : C.out + (prompt ? O_PDELTA : O_SDELTA) + (size_t)bh * 128 * 128 + 32 * eb + l31;
#pragma unroll
    for (int db = 0; db < 4; ++db)
#pragma unroll
        for (int r = 0; r < 16; ++r) so[(size_t)(32 * db + crow16(r, hh)) * 128] = S[db][r];
}

#ifndef MK_PER_PHASE
#define MK_PER_PHASE 0
#endif
constexpr int N_PHASES = 10;
#ifndef GEMM_XS
#define GEMM_XS 0
#endif
#ifndef UP_TAIL_SPLIT
#define UP_TAIL_SPLIT 0
#endif
#ifndef WUP_MIX
#define WUP_MIX 0
#endif
#ifndef WUP_SPLIT
#define WUP_SPLIT 0
#endif
#ifndef GEMM_WGM_RES
#define GEMM_WGM_RES 4
#endif
#ifndef GEMM_WGM
#define GEMM_WGM 4
#endif
struct Args { const float* in[26]; float* out; unsigned char* ws; int ph_lo, ph_hi; };
static_assert(sizeof(Args) == 26 * 8 + 8 + 8 + 8, "Args has no padding");

struct HotOrder { pg8::StaticOrder S; __device__ bool next(int i, pg8::Unit& u) const { pg8::Unit t; if (!S.next(i, t)) return false; u.pm = S.c & 3; u.pn = (S.c >> 2) & 7; u.koff = 0; u.part = 0; u.kn = 0; u.tidx = 0; return true; }
                  __device__ void a_ready(const pg8::Unit&) const {} __device__ void done(const pg8::Unit&) const {} };
struct EpiNull { static constexpr bool PERM = true, AFTER_DRAIN = false; float* sink;
                 __device__ __forceinline__ void operator()(const pg8::f32x4 (&acc)[2][2][4][2], const pg8::Unit& u, int wr, int wc, int fr, int fq) const {
                     float s = 0.f;
#pragma unroll
                     for (int a = 0; a < 2; ++a)
#pragma unroll
                         for (int b = 0; b < 2; ++b)
#pragma unroll
                             for (int m = 0; m < 4; ++m) s += acc[a][b][m][0][0] + acc[a][b][m][1][3];
                     if (s == 123456.789f) sink[0] = s; } };
__global__ void __launch_bounds__(NWAVES * 64, 2) fwd_kernel(Args args) {
    extern __shared__ __attribute__((aligned(16))) unsigned char lds_raw[];
    Ctx C;
    C.out = args.out; C.ws = args.ws;
    C.lds = (LAS unsigned char*)lds_raw; C.ctl = (gu32*)(args.ws + WS_CTL);
    C.tid = threadIdx.x; C.lane = C.tid & 63; C.wave = __builtin_amdgcn_readfirstlane(C.tid >> 6); C.G = gridDim.x; C.bid = blockIdx.x;
    for (int u = C.tid; u < (LDS_BYTES - LDSCTL_OFF) / 4; u += NWAVES * 64) ((LAS unsigned*)(C.lds + LDSCTL_OFF))[u] = 0u;
    __syncthreads();
    if (C.tid < 26) ((LAS unsigned long long*)(C.lds + PTAB_OFF))[C.tid] = (unsigned long long)(size_t)args.in[C.tid];
    __syncthreads();
    XcdBarrier bar; bar.bar = (unsigned*)(C.ctl + CW_BAR); bar.x = 0; bar.st = nullptr;
    if (!MK_PER_PHASE) bar = xcd_barrier_post((unsigned*)(C.ctl + CW_BAR), (volatile LAS unsigned*)(C.lds + MISC_OFF) + 8);
    const int lo = args.ph_lo, hi = args.ph_hi;
#define IN(k) (lo <= (k) && (k) < hi)
#define SEAM(k) do { if (IN(k) && IN((k) + 1)) xcd_barrier(bar); REFRESH_IDS(); } while (0)
#define REFRESH_IDS() do { int t_ = threadIdx.x; asm volatile("" : "+v"(t_)); C.tid = t_; C.lane = t_ & 63; C.wave = __builtin_amdgcn_readfirstlane(t_ >> 6); } while (0)

#ifndef PROBE_DUP
#define PROBE_DUP 0
#endif
    if (IN(0)) { phase0(C); if (PROBE_DUP == 1) { xcd_barrier(bar); phase0(C); } } SEAM(0);

    if (IN(1)) {
        pg8::Gemm g{(const pg8::bf16_t*)(C.ws + WS_XN), (const pg8::bf16_t*)(C.ws + WS_WIN), MTOK, LDH, DM, LDX};
        pg8::StaticOrder S; S.init(MTOK, LDH, C.G, C.bid); S.wgm = GEMM_WGM; S.xs = GEMM_XS;
        Epi1 E{(bf16*)(C.ws + WS_H), C.out + OS_SM, C.out};
#if defined(GEMM_STAGGER) && GEMM_STAGGER
        for (int d = 0; d < ((C.bid >> 5) & 7) * GEMM_STAGGER; ++d) __builtin_amdgcn_s_sleep(127);
#endif
        pg8::gemm_phase<Epi1, pg8::StaticOrder, true, true>(C.lds, g, S, E);
        REFRESH_IDS();
        transpose_queue<MIX_FP8 ? 4 : 0>(C, inp(C, I_WO), DM, DM, (bf16*)(C.ws + WS_WO), (DM / 64) * (DM / 32), CW_QT1);
        if (PROBE_DUP == 4) { xcd_barrier(bar); pg8::gemm_phase<Epi1, pg8::StaticOrder, true, true>(C.lds, g, S, E); }
        if (PROBE_DUP == 21) { xcd_barrier(bar); EpiNull EN{(float*)(C.ws + WS_P2)}; pg8::gemm_phase<EpiNull, pg8::StaticOrder, true, true>(C.lds, g, S, EN); }
        if (PROBE_DUP == 20) {
            xcd_barrier(bar);
            HotOrder HO{S}; EpiNull EN{(float*)(C.ws + WS_P2)};
            pg8::gemm_phase<EpiNull, HotOrder, true, true>(C.lds, g, HO, EN);
        }
    } SEAM(1);

    if (IN(2)) {
#if PROBE_DUP == 32 || PROBE_DUP == 33
        { const int pm = __builtin_amdgcn_readfirstlane(PROBE_DUP - 31); for (;;) { const int it = q_next(C, CW_Q2 + 256); if (it >= NDU / 8) break; dprep_unit(C, it * 8 + C.wave, C.lane, C.lds + C.wave * 13824, pm); } xcd_barrier(bar); REFRESH_IDS(); }
#endif
        for (;;) { const int it = q_next(C, CW_Q2); if (it >= 288 + NDU / 8) break; if (it < 288) idx_unit(C, it); else dprep_unit(C, (it - 288) * 8 + C.wave, C.lane, C.lds + C.wave * 13824); }
#if WUP_EARLY
        REFRESH_IDS();
        transpose_queue<2>(C, inp(C, I_WUP), DM, DFF2, (bf16*)(C.ws + WS_WUP), (DM / 64) * (DFF2 / 32), CW_QT5, 0, WUP_SPLIT, 16384, 8704);
#endif
        if (PROBE_DUP == 2) { xcd_barrier(bar); for (;;) { const int it = q_next(C, CW_Q2 + 256); if (it >= 288 + NDU / 8) break; if (it < 288) idx_unit(C, it); else dprep_unit(C, (it - 288) * 8 + C.wave, C.lane, C.lds + C.wave * 13824); } }
        if (PROBE_DUP == 12) { xcd_barrier(bar); for (;;) { const int it = q_next(C, CW_Q2 + 256); if (it >= 288) break; idx_unit<false>(C, it); } }
        if (PROBE_DUP == 10) { xcd_barrier(bar); for (;;) { const int it = q_next(C, CW_Q2 + 256); if (it >= 288) break; idx_unit(C, it); } }
        if (PROBE_DUP == 11) { xcd_barrier(bar); for (;;) { const int it = q_next(C, CW_Q2 + 256); if (it >= NDU / 8) break; dprep_unit(C, it * 8 + C.wave, C.lane, C.lds + C.wave * 13824); } }
    } SEAM(2);

    if (IN(3)) {
        attn_lut(C);
#if PROBE_DUP == 31
#pragma unroll 1
        for (int hot = 1; hot >= 0; --hot) { const int hv = __builtin_amdgcn_readfirstlane(hot); for (;;) { const int it = q_next(C, CW_Q3 + 256 * hv); if (it >= 320) break; dscan_unit(C, it, hv); } xcd_barrier(bar); }
#else
        for (;;) { const int it = q_next(C, CW_Q3); if (it >= 320) break; dscan_unit(C, it); }
#endif
        REFRESH_IDS();
#if WUP_EARLY && WUP_MIX > 0
        {
            bool more = true;
            for (;;) { const int it = q_next(C, CW_Q3 + 64); if (it >= 1152) break; attn_unit(C, it);
                if (more) { REFRESH_IDS(); more = transpose_grabs<2>(C, inp(C, I_WUP), DM, DFF2, (bf16*)(C.ws + WS_WUP), (DM / 64) * (DFF2 / 32), CW_QT5 + 64, WUP_SPLIT, 1 << 30, 16384, 8704, WUP_MIX); REFRESH_IDS(); } }
        }
#else
        for (;;) { const int it = q_next(C, CW_Q3 + 64); if (it >= 1152) break; attn_unit(C, it); }
#endif
#if WUP_EARLY
        REFRESH_IDS();
        transpose_queue<2>(C, inp(C, I_WUP), DM, DFF2, (bf16*)(C.ws + WS_WUP), (DM / 64) * (DFF2 / 32), CW_QT5 + 64, WUP_SPLIT, 1 << 30, 16384, 8704);
#endif
        if (PROBE_DUP == 3) { xcd_barrier(bar); for (;;) { const int it = q_next(C, CW_Q3 + 256); if (it >= 320) break; dscan_unit(C, it); } }
        if (PROBE_DUP == 6) { xcd_barrier(bar); for (;;) { const int it = q_next(C, CW_Q3 + 320); if (it >= 1152) break; attn_unit(C, it); } }
    } SEAM(3);

    if (IN(4)) {
        pg8::StaticOrder S; S.init(MTOK, DM, C.G, C.bid); S.wgm = GEMM_WGM_RES; S.xs = GEMM_XS;
#if MIX_FP8
        pg8::Gemm g{(const pg8::bf16_t*)(C.ws + WS_CAT), (const pg8::bf16_t*)(C.ws + WS_WO), MTOK, DM, DM / 2, DM / 2};
        EpiRes E{(const bf16*)(C.ws + WS_XN), (bf16*)(C.ws + WS_PRE1), 0, 1.f / (CAT_Q * WO_Q), (float*)(C.ws + WS_P2), (unsigned*)(C.ctl + CW_TIX2)};
        S.lim = 1024;
        pg8::gemm_phase<EpiRes, pg8::StaticOrder, true, true, true>(C.lds, g, S, E);
        { pg8::TailOrder T{S, 1024, 2, 16, 16}; pg8::gemm_phase<EpiRes, pg8::TailOrder, true, true, true>(C.lds, g, T, E); }
#else
        pg8::Gemm g{(const pg8::bf16_t*)(C.ws + WS_CAT), (const pg8::bf16_t*)(C.ws + WS_WO), MTOK, DM, DM, DM};
        EpiRes E{(const bf16*)(C.ws + WS_XN), (bf16*)(C.ws + WS_PRE1), 0, 1.f, nullptr, nullptr};
        pg8::gemm_phase<EpiRes, pg8::StaticOrder, true, true>(C.lds, g, S, E);
#endif
    } SEAM(4);

    if (IN(5)) { phase5(C); if (PROBE_DUP == 1) { xcd_barrier(bar); phase5(C); } } SEAM(5);

    if (IN(6)) {
        pg8::Gemm g{(const pg8::bf16_t*)(C.ws + WS_XN), (const pg8::bf16_t*)(C.ws + WS_WUP), MTOK, DFF2, DM, LDX};
        pg8::StaticOrder S; S.init(MTOK, DFF2, C.G, C.bid); S.wgm = GEMM_WGM; S.xs = GEMM_XS;
        EpiUpAct E{(bf16*)(C.ws + WS_ACT), (bf16*)(C.ws + WS_UPS), C.out, inp(C, I_FCW), inp(C, I_FCB), (LAS float*)(C.lds + EPIW_OFF), (float*)(C.ws + WS_P3), (unsigned*)(C.ctl + CW_T3)};
#if UP_TAIL_SPLIT
        S.lim = 6144;
        pg8::gemm_phase<EpiUpAct, pg8::StaticOrder, true, true>(C.lds, g, S, E);
        { pg8::TailOrder T{S, 6144, UPT_NS, 64 / UPT_NS, 64 / UPT_NS}; pg8::gemm_phase<EpiUpAct, pg8::TailOrder, true, true>(C.lds, g, T, E); }
#else
        pg8::gemm_phase<EpiUpAct, pg8::StaticOrder, true, true>(C.lds, g, S, E);
#endif
        REFRESH_IDS();
        if (PROBE_DUP == 40) { xcd_barrier(bar); pg8::gemm_phase<EpiUpAct, pg8::StaticOrder, true, true>(C.lds, g, S, E); REFRESH_IDS(); }
        if (PROBE_DUP == 41) { xcd_barrier(bar); EpiNull EN{(float*)(C.ws + WS_P2)}; pg8::gemm_phase<EpiNull, pg8::StaticOrder, true, true>(C.lds, g, S, EN); REFRESH_IDS(); }
        transpose_queue<FFN_DOWN_FP8 ? 3 : 0>(C, inp(C, I_WDN), DFF, DM, (bf16*)(C.ws + WS_WDN), (DFF / 64) * (DM / 32), CW_QT6);
    } SEAM(6);
    if (IN(7)) { ffn_fixup(C); } SEAM(7);
    if (IN(8)) {
#if FFN_DOWN_FP8
        pg8::Gemm g{(const pg8::bf16_t*)(C.ws + WS_ACT), (const pg8::bf16_t*)(C.ws + WS_WDN), MTOK, DM, DFF / 2, DFF / 2};
        pg8::StaticOrder S; S.init(MTOK, DM, C.G, C.bid); S.wgm = GEMM_WGM_RES; S.xs = GEMM_XS;
        EpiRes E{(const bf16*)(C.ws + WS_XN), (bf16*)(C.ws + WS_PRE2), 0, 1.f / (ACT_Q * WDN_Q), (float*)(C.ws + WS_P2), (unsigned*)(C.ctl + CW_TIX4)};
        S.lim = 1024;
        pg8::gemm_phase<EpiRes, pg8::StaticOrder, true, true, true>(C.lds, g, S, E);
        { pg8::TailOrder T{S, 1024, 2, 44, 42}; pg8::gemm_phase<EpiRes, pg8::TailOrder, true, true, true>(C.lds, g, T, E); }
#else
        pg8::Gemm g{(const pg8::bf16_t*)(C.ws + WS_ACT), (const pg8::bf16_t*)(C.ws + WS_WDN), MTOK, DM, DFF, DFF};
        pg8::StaticOrder S; S.init(MTOK, DM, C.G, C.bid); S.wgm = GEMM_WGM_RES; S.xs = GEMM_XS;
        EpiRes E{(const bf16*)(C.ws + WS_XN), (bf16*)(C.ws + WS_PRE2), 0, 1.f, nullptr, nullptr};
        pg8::gemm_phase<EpiRes, pg8::StaticOrder, true, true>(C.lds, g, S, E);
#endif
    } SEAM(8);

    if (IN(9)) {
        const int gw = C.bid * NWAVES + C.wave, NGW = C.G * NWAVES;
        LnP P; ln_params(P, inp(C, I_LN2G), inp(C, I_LN2B), C.lane);
#pragma unroll 1
        for (int m = gw; m < MTOK; m += NGW) ln_row<true, true, true>((const bf16*)(C.ws + WS_PRE2) + (size_t)m * DM, P, C.out + O_Y + (size_t)m * DM, C.lane, (const unsigned*)(C.ctl + CW_TIX4) + (m >> 8) * 16, (const float*)(C.ws + WS_P2), m & 255);
    }
#undef IN
#undef SEAM
}

extern "C" void kernel_launch(void* const* d_in, const int* in_sizes, int n_in, void* d_out, int out_size, void* d_ws, size_t ws_size, hipStream_t stream) {
    static int grid = 0;
    if (grid == 0) {
        if (n_in != 26 || (size_t)out_size != O_END || ws_size < WS_END) { fprintf(stderr, "kernel_launch: unexpected shapes: n_in %d out %d ws %zu (need %zu)\n", n_in, out_size, ws_size, (size_t)WS_END); grid = -1; return; }
        int dev = 0, cus = 0, per_cu = 0;
        if (hipGetDevice(&dev) != hipSuccess || hipDeviceGetAttribute(&cus, hipDeviceAttributeMultiprocessorCount, dev) != hipSuccess) { grid = -1; return; }
        if (hipFuncSetAttribute((const void*)fwd_kernel, hipFuncAttributeMaxDynamicSharedMemorySize, LDS_BYTES) != hipSuccess) { fprintf(stderr, "kernel_launch: hipFuncSetAttribute failed\n"); grid = -1; return; }
        if (hipOccupancyMaxActiveBlocksPerMultiprocessor(&per_cu, (const void*)fwd_kernel, NWAVES * 64, LDS_BYTES) != hipSuccess || per_cu < 1) { fprintf(stderr, "kernel_launch: occupancy query says %d\n", per_cu); }
        (void)hipGetLastError();
        grid = cus;
    }
    if (grid < 0) return;
    if (hipMemsetAsync((char*)d_ws + WS_CTL, 0, CTL_ZERO_BYTES, stream) != hipSuccess) return;
    Args a{};
    for (int i = 0; i < 26; ++i) a.in[i] = (const float*)d_in[i];
    a.out = (float*)d_out; a.ws = (unsigned char*)d_ws;
#if MK_PER_PHASE
    for (int p = 0; p < N_PHASES; ++p) { a.ph_lo = p; a.ph_hi = p + 1; hipLaunchKernelGGL(fwd_kernel, dim3(grid), dim3(NWAVES * 64), LDS_BYTES, stream, a); }
#else
    a.ph_lo = 0; a.ph_hi = N_PHASES;
    hipLaunchKernelGGL(fwd_kernel, dim3(grid), dim3(NWAVES * 64), LDS_BYTES, stream, a);
#endif
    const hipError_t le = hipPeekAtLastError();
    if (le != hipSuccess) fprintf(stderr, "kernel_launch: launch failed: %s\n", hipGetErrorName(le));
}
```

```cpp
#include <hip/hip_runtime.h>
#include <cstdio>
#include <cstdint>
#define WUP_P1 0
namespace pg8 {
#define PG8_LAS __attribute__((address_space(3)))
typedef unsigned short bf16_t;
typedef short bf16x8 __attribute__((ext_vector_type(8)));
typedef float f32x4 __attribute__((ext_vector_type(4)));
typedef unsigned u32x4 __attribute__((ext_vector_type(4)));
constexpr int BM = 256, BK = 64, HALF = 128, HTB = HALF * BK * 2  , STAGE_BYTES = 8 * HTB, NXCD = 8, WGM = 8;

__host__ __device__ __forceinline__ int lds_byte(int r, int c) { const int st = (r >> 4) * 2 + (c >> 5), rr = r & 15, cc = c & 31, ob = rr * 64 + cc * 2; return st * 1024 + (ob ^ (((ob >> 9) & 1) << 5)); }
__host__ __device__ __forceinline__ void stage_rc(int b, int& R, int& C) { const int st = b / 1024, sb = b % 1024, swz = sb ^ (((sb >> 9) & 1) << 5); R = (st >> 1) * 16 + swz / 64; C = (st & 1) * 32 + (swz % 64) / 2; }
__host__ __device__ __forceinline__ int perm32(int rho) { const int n = rho >> 4, i = rho & 15; return 8 * (i >> 2) + 4 * n + (i & 3); }

struct Unit { int pm, pn, koff, part, kn, tidx; };
struct Gemm { const bf16_t* A; const bf16_t* Bt; int M, N, K, lda; };

struct StaticOrder {
    int nM, nN, nwg, G, c, lim, wgm, xs;
    __host__ __device__ void init(int M, int N, int G_, int c_) { nM = M / BM; nN = N / BM; nwg = nM * nN; G = G_; c = c_; lim = nwg; wgm = WGM; xs = 0; }
    __host__ __device__ void map(long L, Unit& u) const {
        if (xs) {
            const int x = (int)(L % NXCD), e = (int)(L / NXCD), per = nM / NXCD, nig = wgm * nN, k = e / nig, w = e % nig;
            u.pm = x * per + k * wgm + w % wgm; u.pn = w / wgm; u.koff = 0; u.part = 0; u.kn = 0; u.tidx = 0; return;
        }
        int wgid = (int)L; { const int q = nwg / NXCD, r = nwg % NXCD, xcd = wgid % NXCD, off = wgid / NXCD; wgid = (xcd < r ? xcd * (q + 1) : r * (q + 1) + (xcd - r) * q) + off; }
        const int nig = wgm * nN, gid = wgid / nig, fm = gid * wgm, gsz = (nM - fm) < wgm ? (nM - fm) : wgm;
        u.pm = fm + ((wgid % nig) % gsz); u.pn = (wgid % nig) / gsz; u.koff = 0; u.part = 0; u.kn = 0; u.tidx = 0;
    }
    __host__ __device__ bool next(int i, Unit& u) const {
        const long L = (long)i * G + c; if (L >= lim) return false;
        map(L, u); return true;
    }
    __device__ __forceinline__ void a_ready(const Unit&) const {}
    __device__ __forceinline__ void done(const Unit&) const {}
};

struct TailOrder {
    StaticOrder S; int L0, nsplit, kt0, kt1;
    __host__ __device__ bool next(int i, Unit& u) const {
        if (i > 0) return false; const long L = L0 + S.c / nsplit; if (L >= S.nwg) return false;
        S.map(L, u); u.part = S.c % nsplit; u.koff = u.part == 0 ? 0 : (kt0 + (u.part - 1) * kt1) * BK; u.kn = u.part == 0 ? kt0 : kt1; u.tidx = (int)(L - L0); return true;
    }
    __device__ __forceinline__ void a_ready(const Unit&) const {}
    __device__ __forceinline__ void done(const Unit&) const {}
};
__device__ __forceinline__ unsigned cvt_pk_bf16(float lo, float hi) { unsigned r; asm volatile("v_cvt_pk_bf16_f32 %0, %1, %2" : "=v"(r) : "v"(lo), "v"(hi)); return r; }
typedef float f32x2 __attribute__((ext_vector_type(2)));

typedef int v8i_t __attribute__((ext_vector_type(8)));
__device__ __forceinline__ v8i_t cat16(bf16x8 lo, bf16x8 hi) { const u32x4 a = __builtin_bit_cast(u32x4, lo), b = __builtin_bit_cast(u32x4, hi); return (v8i_t){(int)a.x, (int)a.y, (int)a.z, (int)a.w, (int)b.x, (int)b.y, (int)b.z, (int)b.w}; }
template <class Epi, class Sched, bool ALIGN_EPI = false, bool SP2 = false, bool F8 = false>
__device__ __forceinline__ void gemm_phase(PG8_LAS unsigned char* lds, const Gemm g, const Sched& S, const Epi& E) {
    const int tid = threadIdx.x, wid = __builtin_amdgcn_readfirstlane(tid >> 6), lane = tid & 63, wr = wid >> 2, wc = wid & 3, fr = lane & 15, fq = lane >> 4;
    const int K = g.lda, nt = g.K / BK;
    unsigned voffA[2], voffB[2];
#pragma unroll
    for (int i = 0; i < 2; ++i) { int R, C; stage_rc(tid * 16 + i * 8192, R, C); const int Rb = Epi::PERM ? ((R & ~31) + perm32(R & 31)) : R;
        voffA[i] = (unsigned)(R * K + C) * 2u; voffB[i] = (unsigned)(Rb * K + C) * 2u; }
    const size_t kstep = (size_t)(BK * 2);
    const size_t hstep = (size_t)HALF * K * 2;
    const size_t tstep = 2 * hstep;
    const unsigned ldsw = (unsigned)wid * 1024u;
    const int aoff = lds_byte(wr * 64 + fr, fq * 8), boff = lds_byte(wc * 32 + fr, fq * 8);
#define PG8_SA(b, h) (((b) * 2 + (h)) * HTB)
#define PG8_SB(b, h) ((4 + (b) * 2 + (h)) * HTB)
#define PG8_STAGE(bufoff, gbase, voff) do { _Pragma("unroll") for (int _i = 0; _i < 2; ++_i) \
        __builtin_amdgcn_global_load_lds((const unsigned*)((const char*)(gbase) + (voff)[_i]), (PG8_LAS unsigned*)(lds + (bufoff) + ldsw + _i * 8192), 16, 0, 0); } while (0)
#define PG8_LDA(dst, b, h) do { if constexpr (F8) { _Pragma("unroll") for (int m = 0; m < 4; ++m) dst##8[m] = cat16(*(const PG8_LAS bf16x8*)(lds + PG8_SA(b, h) + aoff + m * 2048), *(const PG8_LAS bf16x8*)(lds + PG8_SA(b, h) + aoff + m * 2048 + 1024)); } \
        else { _Pragma("unroll") for (int m = 0; m < 4; ++m) _Pragma("unroll") for (int k = 0; k < 2; ++k) dst[m][k] = *(const PG8_LAS bf16x8*)(lds + PG8_SA(b, h) + aoff + m * 2048 + k * 1024); } } while (0)
#define PG8_LDB(dst, b, h) do { if constexpr (F8) { _Pragma("unroll") for (int n = 0; n < 2; ++n) dst##8[n] = cat16(*(const PG8_LAS bf16x8*)(lds + PG8_SB(b, h) + boff + n * 2048), *(const PG8_LAS bf16x8*)(lds + PG8_SB(b, h) + boff + n * 2048 + 1024)); } \
        else { _Pragma("unroll") for (int n = 0; n < 2; ++n) _Pragma("unroll") for (int k = 0; k < 2; ++k) dst[n][k] = *(const PG8_LAS bf16x8*)(lds + PG8_SB(b, h) + boff + n * 2048 + k * 1024); } } while (0)
#define PG8_MMA(ai, bj, At, Bt) do { __builtin_amdgcn_s_setprio(1); \
        if constexpr (F8) { _Pragma("unroll") for (int m = 0; m < 4; ++m) _Pragma("unroll") for (int n = 0; n < 2; ++n) \
            asm volatile("v_mfma_f32_16x16x128_f8f6f4 %0, %1, %2, %0" : "+v"(acc[ai][bj][m][n]) : "v"(Bt##8[n]), "v"(At##8[m])); } \
        else { _Pragma("unroll") for (int m = 0; m < 4; ++m) _Pragma("unroll") for (int n = 0; n < 2; ++n) _Pragma("unroll") for (int k = 0; k < 2; ++k) \
            acc[ai][bj][m][n] = __builtin_amdgcn_mfma_f32_16x16x32_bf16(Bt[n][k], At[m][k], acc[ai][bj][m][n], 0, 0, 0); } \
        __builtin_amdgcn_s_setprio(0); } while (0)
#define PG8_WAIT_V(n) asm volatile("s_waitcnt vmcnt(" #n ")" ::: "memory")
#define PG8_WAIT_L(n) asm volatile("s_waitcnt lgkmcnt(" #n ")" ::: "memory")
#define PG8_BAR __builtin_amdgcn_s_barrier()
#define PG8_SCHED __builtin_amdgcn_sched_barrier(0)
    Unit cur, nxt; int ui = 0;
    if (!S.next(0, cur)) return;
    f32x4 acc[2][2][4][2];
#pragma unroll
    for (int a = 0; a < 2; ++a)
#pragma unroll
        for (int b = 0; b < 2; ++b)
#pragma unroll
            for (int m = 0; m < 4; ++m)
#pragma unroll
                for (int n = 0; n < 2; ++n) acc[a][b][m][n] = (f32x4){0.f, 0.f, 0.f, 0.f};
    bf16x8 At[4][2], B0[2][2], B1[2][2]; v8i_t At8[4], B08[2], B18[2];
    const char* cA = (const char*)g.A + (size_t)cur.pm * tstep + (size_t)cur.koff * 2; const char* cB = (const char*)g.Bt + (size_t)cur.pn * tstep + (size_t)cur.koff * 2;
    S.a_ready(cur);
    if constexpr (SP2) {
        PG8_STAGE(PG8_SB(0, 0), cB, voffB); PG8_STAGE(PG8_SB(0, 1), cB + hstep, voffB); PG8_STAGE(PG8_SA(0, 0), cA, voffA); PG8_STAGE(PG8_SA(0, 1), cA + hstep, voffA);
        if (wr == 1) PG8_BAR;
        PG8_WAIT_V(2); PG8_BAR;
        PG8_STAGE(PG8_SB(1, 0), cB + kstep, voffB); PG8_STAGE(PG8_SA(1, 0), cA + kstep, voffA); PG8_STAGE(PG8_SB(1, 1), cB + hstep + kstep, voffB);
        PG8_WAIT_V(6); PG8_BAR;
    } else {
        PG8_STAGE(PG8_SB(0, 0), cB, voffB); PG8_STAGE(PG8_SA(0, 0), cA, voffA); PG8_STAGE(PG8_SB(0, 1), cB + hstep, voffB); PG8_STAGE(PG8_SA(0, 1), cA + hstep, voffA);
        if (wr == 1) PG8_BAR;
        PG8_WAIT_V(4); PG8_BAR;
        PG8_STAGE(PG8_SB(1, 0), cB + kstep, voffB); PG8_STAGE(PG8_SA(1, 0), cA + kstep, voffA); PG8_STAGE(PG8_SB(1, 1), cB + hstep + kstep, voffB);
        PG8_WAIT_V(6); PG8_BAR;
    }
    for (;;) {
        const bool has_next = S.next(ui + 1, nxt);
        const char* nA = has_next ? (const char*)g.A + (size_t)nxt.pm * tstep + (size_t)nxt.koff * 2 : cA; const char* nB = has_next ? (const char*)g.Bt + (size_t)nxt.pn * tstep + (size_t)nxt.koff * 2 : cB;
        const int ntu = cur.kn > 0 ? cur.kn : nt;
        for (int t = 0; t < ntu; t += 2) {
            const bool last = (t == ntu - 2);
            const char* a1 = cA + (size_t)(t + 1) * kstep;
            const char* a2 = last ? nA : cA + (size_t)(t + 2) * kstep; const char* b2 = last ? nB : cB + (size_t)(t + 2) * kstep;
            const char* a3 = a2 + kstep; const char* b3 = b2 + kstep;
            if (last && has_next) S.a_ready(nxt);
            if constexpr (SP2) {
            PG8_LDB(B0, 0, 0); PG8_LDB(B1, 0, 1); PG8_SCHED; PG8_LDA(At, 0, 0); PG8_STAGE(PG8_SA(1, 1), a1 + hstep, voffA);
            PG8_WAIT_V(8); PG8_WAIT_L(0); PG8_BAR; PG8_MMA(0, 0, At, B0); PG8_MMA(0, 1, At, B1); PG8_BAR; PG8_SCHED;
            PG8_LDA(At, 0, 1); PG8_STAGE(PG8_SB(0, 0), b2, voffB); PG8_STAGE(PG8_SB(0, 1), b2 + hstep, voffB); PG8_STAGE(PG8_SA(0, 0), a2, voffA);
            PG8_WAIT_V(8); PG8_WAIT_L(0); PG8_BAR; PG8_MMA(1, 0, At, B0); PG8_MMA(1, 1, At, B1); PG8_BAR; PG8_SCHED;
            PG8_LDB(B0, 1, 0); PG8_LDB(B1, 1, 1); PG8_SCHED; PG8_LDA(At, 1, 0); PG8_STAGE(PG8_SA(0, 1), a2 + hstep, voffA);
            PG8_WAIT_V(8); PG8_WAIT_L(0); PG8_BAR; PG8_MMA(0, 0, At, B0); PG8_MMA(0, 1, At, B1); PG8_BAR; PG8_SCHED;
            PG8_LDA(At, 1, 1); PG8_STAGE(PG8_SB(1, 0), b3, voffB); PG8_STAGE(PG8_SB(1, 1), b3 + hstep, voffB); PG8_STAGE(PG8_SA(1, 0), a3, voffA);
            PG8_WAIT_V(8); PG8_WAIT_L(0); PG8_BAR; PG8_MMA(1, 0, At, B0); PG8_MMA(1, 1, At, B1); PG8_BAR; PG8_SCHED;
            } else {
            PG8_LDB(B0, 0, 0); PG8_SCHED; PG8_LDA(At, 0, 0); PG8_STAGE(PG8_SA(1, 1), a1 + hstep, voffA);
            PG8_WAIT_L(8); PG8_BAR; PG8_WAIT_L(0); PG8_MMA(0, 0, At, B0); PG8_BAR; PG8_SCHED;
            PG8_LDB(B1, 0, 1); PG8_STAGE(PG8_SB(0, 0), b2, voffB);
            PG8_BAR; PG8_WAIT_L(0); PG8_MMA(0, 1, At, B1); PG8_BAR;
            PG8_LDA(At, 0, 1); PG8_STAGE(PG8_SA(0, 0), a2, voffA);
            PG8_BAR; PG8_WAIT_L(0); PG8_MMA(1, 0, At, B0); PG8_BAR; PG8_SCHED;
            PG8_STAGE(PG8_SB(0, 1), b2 + hstep, voffB);
            PG8_WAIT_V(6); PG8_BAR; PG8_MMA(1, 1, At, B1); PG8_BAR;
            PG8_LDB(B0, 1, 0); PG8_SCHED; PG8_LDA(At, 1, 0); PG8_STAGE(PG8_SA(0, 1), a2 + hstep, voffA);
            PG8_WAIT_L(8); PG8_BAR; PG8_WAIT_L(0); PG8_MMA(0, 0, At, B0); PG8_BAR; PG8_SCHED;
            PG8_LDB(B1, 1, 1); PG8_STAGE(PG8_SB(1, 0), b3, voffB);
            PG8_BAR; PG8_WAIT_L(0); PG8_MMA(0, 1, At, B1); PG8_BAR;
            PG8_LDA(At, 1, 1); PG8_STAGE(PG8_SA(1, 0), a3, voffA);
            PG8_BAR; PG8_WAIT_L(0); PG8_MMA(1, 0, At, B0); PG8_BAR; PG8_SCHED;
            PG8_STAGE(PG8_SB(1, 1), b3 + hstep, voffB);
            PG8_WAIT_V(6); PG8_BAR; PG8_MMA(1, 1, At, B1); PG8_BAR;
            }
        }
        if constexpr (F8) asm volatile("s_nop 15\n\ts_nop 15" ::: "memory");
        if constexpr (ALIGN_EPI) { if (wr == 0) PG8_BAR; }
        if constexpr (!Epi::AFTER_DRAIN) { E(acc, cur, wr, wc, fr, fq); S.done(cur); }
        if (!has_next) break;
#pragma unroll
        for (int a = 0; a < 2; ++a)
#pragma unroll
            for (int b = 0; b < 2; ++b)
#pragma unroll
                for (int m = 0; m < 4; ++m)
#pragma unroll
                    for (int n = 0; n < 2; ++n) acc[a][b][m][n] = (f32x4){0.f, 0.f, 0.f, 0.f};
        cur = nxt; cA = nA; cB = nB; ++ui;
        if constexpr (ALIGN_EPI) { if (wr == 1) PG8_BAR; }
    }
    PG8_WAIT_V(0);
    if constexpr (!ALIGN_EPI) { if (wr == 0) PG8_BAR; }
    PG8_BAR;
    if constexpr (Epi::AFTER_DRAIN) { E.fused(acc, cur, wr, wc, fr, fq, lds, wid, lane); S.done(cur); }
#undef PG8_SA
#undef PG8_SB
#undef PG8_STAGE
#undef PG8_LDA
#undef PG8_LDB
#undef PG8_MMA
#undef PG8_WAIT_V
#undef PG8_WAIT_L
#undef PG8_BAR
#undef PG8_SCHED
}
}

#define GAS __attribute__((address_space(1)))
#define LAS __attribute__((address_space(3)))
typedef unsigned short bf16;
typedef unsigned v4u __attribute__((ext_vector_type(4)));
typedef unsigned v2u __attribute__((ext_vector_type(2)));
typedef float f32x4 __attribute__((ext_vector_type(4)));
typedef float f32x2 __attribute__((ext_vector_type(2)));
typedef short bf16x8 __attribute__((ext_vector_type(8)));
typedef GAS unsigned gu32;

constexpr int NWAVES = 8;
constexpr int DM = 4096;
constexpr int NPROW = 16384, NSROW = 2048, MTOK = NPROW + NSROW;
constexpr int PSEQ = 2048, SSEQ = 64, PAST = 1024, NPB = 8, NSB = 32;
#ifndef LDX_PAD
#define LDX_PAD 0
#endif
constexpr int LDX = 4096 + LDX_PAD;
constexpr int LDH = 12544;
constexpr int HQ = 0, HK = 2048, HV = 2560, HIQ = 3072, HQKV = 4096, HZ = 10240, HSM = 12288;
constexpr int NIN = 12400, CQKV = 6144, DFF = 11008, DFF2 = 22016;
constexpr int TOPK = 256;
constexpr float LN_EPS = 1e-5f;
constexpr float ALPHA = 1.189207115002721f;
constexpr float IDX_SCALE = 0.03125f;
constexpr float QSCALE = 0.08838834764831845f;

constexpr size_t O_Y = 0;
constexpr size_t O_PK = (size_t)MTOK * DM;
constexpr size_t O_PV = O_PK + (size_t)NPROW * 512;
constexpr size_t O_PIK = O_PV + (size_t)NPROW * 512;
constexpr size_t O_PDELTA = O_PIK + (size_t)NPROW * 64;
constexpr size_t O_PCONV = O_PDELTA + (size_t)NPB * 16 * 128 * 128;
constexpr size_t O_PFFN = O_PCONV + (size_t)NPB * 3 * CQKV;
constexpr size_t O_SK = O_PFFN + (size_t)NPB * 2 * DFF2;
constexpr size_t O_SV = O_SK + (size_t)NSROW * 512;
constexpr size_t O_SIK = O_SV + (size_t)NSROW * 512;
constexpr size_t O_SDELTA = O_SIK + (size_t)NSROW * 64;
constexpr size_t O_SCONV = O_SDELTA + (size_t)NSB * 16 * 128 * 128;
constexpr size_t O_SFFN = O_SCONV + (size_t)NSB * 3 * CQKV;
constexpr size_t O_END = O_SFFN + (size_t)NSB * 2 * DFF2;
static_assert(O_END == 108535808ull, "d_out map");
constexpr size_t OS_SC = 0;
constexpr size_t OS_SM = (size_t)MTOK * 2048;
constexpr size_t OS_VTP = OS_SM + (size_t)MTOK * 128;
constexpr size_t OS_VTS = OS_VTP + (size_t)NPB * 4 * 128 * PSEQ / 2;
constexpr int SLEN = PAST + SSEQ;
constexpr int NDU = 9216;
constexpr size_t OS_TBF = ((OS_VTS + (size_t)NSB * 4 * 128 * SLEN / 2) + 3) & ~(size_t)3;
constexpr size_t OS_TGF = OS_TBF + (size_t)NDU * 512;
constexpr size_t OS_MFF = OS_TGF + (size_t)NDU * 512;
constexpr size_t OS_GB = OS_MFF + (size_t)NDU * 512;
constexpr size_t OS_MSK = OS_GB + (size_t)MTOK * 16;
static_assert(OS_MSK % 4 == 0 && OS_MSK + (size_t)MTOK * 64 <= O_PK, "scratch in y region");


constexpr size_t MiB = 1u << 20;
constexpr size_t WS_CTL = 0, CTL_ZERO_BYTES = 64 * 1024;
constexpr size_t WS_WO = 1 * MiB;
constexpr size_t WS_XN = WS_WO + 32 * MiB;
constexpr size_t WS_CAT = WS_XN + 150 * MiB;
constexpr size_t WS_WIN = WS_CAT + 144 * MiB;
constexpr size_t WS_H = WS_WIN + 102 * MiB;
constexpr size_t WS_QKVC = WS_H + 441 * MiB;
constexpr size_t WS_END = WS_QKVC + 216 * MiB;
#ifndef WUP_EARLY
#define WUP_EARLY 1
#endif
#if WUP_EARLY
constexpr size_t WS_WUP = WS_CAT + 72 * MiB;
constexpr size_t WS_WDN = WS_CAT;
static_assert((size_t)MTOK * DM <= 72 * MiB && (size_t)DM * DFF <= 72 * MiB && WS_WUP + (size_t)DFF2 * LDX * 2 <= WS_H, "early w_up layout");
#else
constexpr size_t WS_WUP = WS_CAT;
constexpr size_t WS_WDN = WS_WUP + 178 * MiB;
#endif
constexpr size_t WS_ACT = WS_CAT + 264 * MiB;
constexpr size_t WS_P2 = WS_CAT + 706 * MiB;
constexpr size_t WS_PRE1 = WS_ACT;
constexpr size_t WS_PRE2 = WS_WUP;
constexpr size_t WS_P3 = WS_ACT + 194 * MiB;
constexpr size_t WS_UPS = WS_ACT + 388 * MiB;
static_assert((size_t)MTOK * LDH * 2 <= 441 * MiB && (size_t)LDH * LDX * 2 <= 102 * MiB && (size_t)MTOK * LDX * 2 <= 150 * MiB && (size_t)MTOK * CQKV * 2 <= 216 * MiB, "ws sizes");
static_assert((size_t)DFF2 * LDX * 2 <= 178 * MiB && (size_t)DM * DFF * 2 <= 86 * MiB && (size_t)MTOK * DFF * 2 <= 388 * MiB && WS_UPS + (size_t)288 * 4 * DFF2 * 2 <= WS_P2 && WS_P2 + (size_t)128 * 65536 * 4 <= WS_END, "ffn ws sizes");

constexpr int CW_QT1 = 1024, CW_QT6 = 1088, CW_QT5 = 1152, CW_T3 = 13312;
constexpr int CW_Q2 = 64, CW_Q3 = 128;
constexpr int CW_BAR = 4096;
constexpr int CW_XR = 12288;
constexpr int CW_TIX2 = 8192, CW_TIX4 = 8192 + 1152;

constexpr int RING_BYTES = 131072;
constexpr int LDSCTL_OFF = RING_BYTES, MISC_OFF = LDSCTL_OFF + 320;
constexpr int LDS_BYTES = 147456;
constexpr int EPIW_OFF = LDSCTL_OFF + 4096;
static_assert(EPIW_OFF + 8192 <= LDS_BYTES, "lds map");

#define RLX_AGENT __ATOMIC_RELAXED, __HIP_MEMORY_SCOPE_AGENT
#define LDS_WAIT() asm volatile("s_waitcnt lgkmcnt(0)" ::: "memory")
__device__ __forceinline__ unsigned f2bf(float f) { unsigned u = __builtin_bit_cast(unsigned, f); return (u + 0x7fffu + ((u >> 16) & 1u)) >> 16; }
typedef float f32x2_t __attribute__((ext_vector_type(2))); typedef __bf16 bf16x2_t __attribute__((ext_vector_type(2)));
__device__ __forceinline__ unsigned pk2(float lo, float hi) { f32x2_t v = {lo, hi}; bf16x2_t b = __builtin_convertvector(v, bf16x2_t); return __builtin_bit_cast(unsigned, b); }
__device__ __forceinline__ float bflo(unsigned w) { return __uint_as_float(w << 16); }
__device__ __forceinline__ float bfhi(unsigned w) { return __uint_as_float(w & 0xffff0000u); }
#define DPPF(x, ctrl) __int_as_float(__builtin_amdgcn_mov_dpp(__float_as_int(x), (ctrl), 0xf, 0xf, true))
__device__ __forceinline__ float wave_sum(float v) {
    v += DPPF(v, 0xB1); v += DPPF(v, 0x4E); v += DPPF(v, 0x141); v += DPPF(v, 0x140);
    const float s0 = __int_as_float(__builtin_amdgcn_readlane(__float_as_int(v), 0)), s1 = __int_as_float(__builtin_amdgcn_readlane(__float_as_int(v), 16));
    const float s2 = __int_as_float(__builtin_amdgcn_readlane(__float_as_int(v), 32)), s3 = __int_as_float(__builtin_amdgcn_readlane(__float_as_int(v), 48));
    return (s0 + s1) + (s2 + s3);
}
__device__ __forceinline__ float wave_max(float v) {
#pragma unroll
    for (int o = 1; o < 64; o <<= 1) v = fmaxf(v, __shfl_xor(v, o));
    return v;
}
__device__ __forceinline__ int wave_sum_i(int v) {
#pragma unroll
    for (int o = 1; o < 64; o <<= 1) v += __shfl_xor(v, o);
    return v;
}
#define DS_RD128(dst, addr, off) asm volatile("ds_read_b128 %0, %1 offset:%c2" : "=v"(dst) : "v"(addr), "i"(off))
#define DS_RDTR(dst, addr, off) asm volatile("ds_read_b64_tr_b16 %0, %1 offset:%c2" : "=v"(dst) : "v"(addr), "i"(off))
#define DS_RD64(dst, addr, off) asm volatile("ds_read_b64 %0, %1 offset:%c2" : "=v"(dst) : "v"(addr), "i"(off))
__device__ __forceinline__ float silu_f(float x) { return x * __builtin_amdgcn_rcpf(1.f + __expf(-x)); }

#define GLD32(dst, ptr, off) asm volatile("global_load_dword %0, %1, off offset:%c2 sc1" : "=&v"(dst) : "v"(ptr), "i"(off) : "memory")
#define GLD128(dst, ptr) asm volatile("global_load_dwordx4 %0, %1, off" : "=&v"(dst) : "v"(ptr) : "memory")
#define GLD128S(dst, voff, sptr, imm) asm volatile("global_load_dwordx4 %0, %1, %2 offset:%c3" : "=&v"(dst) : "v"(voff), "s"(sptr), "i"(imm) : "memory")
#ifndef FFN_DOWN_FP8
#define FFN_DOWN_FP8 1
#endif
#ifndef MIX_FP8
#define MIX_FP8 1
#endif
constexpr float CAT_Q = 16.f, WO_Q = 512.f;
constexpr float ACT_Q = 2.f, WDN_Q = 1024.f;
__device__ __forceinline__ unsigned pk4_fp8(float a, float b, float c_, float d) {
    a = __builtin_amdgcn_fmed3f(a, -448.f, 448.f); b = __builtin_amdgcn_fmed3f(b, -448.f, 448.f); c_ = __builtin_amdgcn_fmed3f(c_, -448.f, 448.f); d = __builtin_amdgcn_fmed3f(d, -448.f, 448.f);
    int w = 0; w = __builtin_amdgcn_cvt_pk_fp8_f32(a, b, w, false); w = __builtin_amdgcn_cvt_pk_fp8_f32(c_, d, w, true); return (unsigned)w;
}
#ifndef EPI_NT
#define EPI_NT 0
#endif
#if EPI_NT
#define EPI_ST(ptr, val) __builtin_nontemporal_store((val), (ptr))
#else
#define EPI_ST(ptr, val) (*(ptr) = (val))
#endif
__device__ __forceinline__ void st8f(float* p, pg8::f32x4 a, pg8::f32x4 b) { EPI_ST((pg8::f32x4*)p, a); EPI_ST((pg8::f32x4*)(p + 4), b); }
__device__ __forceinline__ void st8b(bf16* p, pg8::f32x4 a, pg8::f32x4 b) { pg8::u32x4 w; w.x = pg8::cvt_pk_bf16(a[0], a[1]); w.y = pg8::cvt_pk_bf16(a[2], a[3]); w.z = pg8::cvt_pk_bf16(b[0], b[1]); w.w = pg8::cvt_pk_bf16(b[2], b[3]); EPI_ST((pg8::u32x4*)p, w); }

struct Epi1 {
    static constexpr bool PERM = true, AFTER_DRAIN = false;
    bf16* H; float* SM; float* out;
    __device__ __forceinline__ void operator()(const pg8::f32x4 (&acc)[2][2][4][2], const pg8::Unit& u, int wr, int wc, int fr, int fq) const {
        const int pn = u.pn;
#pragma unroll
        for (int ai = 0; ai < 2; ++ai)
#pragma unroll
            for (int m = 0; m < 4; ++m) {
                const int row = u.pm * 256 + ai * 128 + wr * 64 + m * 16 + fr;
                const bool prompt = row < NPROW; const int r2 = row - NPROW;
                const int b = prompt ? (row >> 11) : (r2 >> 6), t = prompt ? (row & 2047) : (r2 & 63);
#pragma unroll
                for (int bj = 0; bj < 2; ++bj) {
                    const int col = pn * 256 + bj * 128 + wc * 32 + 8 * fq;
                    const pg8::f32x4 v0 = acc[ai][bj][m][0], v1 = acc[ai][bj][m][1];
                    st8b(H + (size_t)row * LDH + col, v0, v1);
                    if (pn >= 8 && pn < 12) {
                        int c = col - HK; const bool isv = c >= 512; if (isv) c -= 512;
                        float* dst = out + (prompt ? (isv ? O_PV : O_PK) + (size_t)row * 512 : (isv ? O_SV : O_SK) + (size_t)r2 * 512) + c;
                        st8f(dst, v0, v1);
                    } else if (pn >= 16 && pn < 40) {
                        const int tl = prompt ? t - (PSEQ - 3) : t - (SSEQ - 3);
                        if (tl >= 0) st8f(out + (prompt ? O_PCONV : O_SCONV) + (size_t)(b * 3 + tl) * CQKV + (col - HQKV), v0, v1);
                    } else if (pn == 48) {
                        const int c = col - HSM;
                        if (c < 128) st8f(SM + (size_t)row * 128 + c, v0, v1);
                        if (c < 64) st8f(out + (prompt ? O_PIK + (size_t)row * 64 : O_SIK + (size_t)r2 * 64) + c, v0, v1);
                    }
                }
            }
    }
};
struct EpiRes {
    static constexpr bool PERM = true, AFTER_DRAIN = false;
    const bf16* res; bf16* out; int row0; float sc;
    float* p2; unsigned* tix;
    __device__ __forceinline__ void operator()(const pg8::f32x4 (&acc)[2][2][4][2], const pg8::Unit& u, int wr, int wc, int fr, int fq) const {
        const int rowb = row0 + u.pm * 256 + wr * 64 + fr, colb = u.pn * 256 + wc * 32 + 8 * fq;
        if (u.part != 0) {
            float* pt = p2 + (size_t)u.tidx * 65536 + (size_t)(wr * 64 + fr) * 256 + wc * 32 + 8 * fq;
#pragma unroll
            for (int ai = 0; ai < 2; ++ai)
#pragma unroll
                for (int m = 0; m < 4; ++m)
#pragma unroll
                    for (int bj = 0; bj < 2; ++bj) st8f(pt + (size_t)(ai * 128 + m * 16) * 256 + bj * 128, acc[ai][bj][m][0] * sc, acc[ai][bj][m][1] * sc);
            if (wr == 0 && wc == 0 && fr == 0 && fq == 0) tix[u.pm * 16 + u.pn] = (unsigned)u.tidx + 1u;
            return;
        }
        pg8::u32x4 r[2][4][2];
#pragma unroll
        for (int ai = 0; ai < 2; ++ai)
#pragma unroll
            for (int m = 0; m < 4; ++m)
#pragma unroll
                for (int bj = 0; bj < 2; ++bj) GLD128(r[ai][m][bj], res + (size_t)(rowb + ai * 128 + m * 16) * LDX + colb + bj * 128);
        asm volatile("s_waitcnt vmcnt(0)" : "+v"(r[0][0][0]), "+v"(r[0][0][1]), "+v"(r[0][1][0]), "+v"(r[0][1][1]), "+v"(r[0][2][0]), "+v"(r[0][2][1]), "+v"(r[0][3][0]), "+v"(r[0][3][1]),
                                            "+v"(r[1][0][0]), "+v"(r[1][0][1]), "+v"(r[1][1][0]), "+v"(r[1][1][1]), "+v"(r[1][2][0]), "+v"(r[1][2][1]), "+v"(r[1][3][0]), "+v"(r[1][3][1]));
#pragma unroll
        for (int ai = 0; ai < 2; ++ai) {
#pragma unroll
            for (int m = 0; m < 4; ++m) {
                const int row = rowb + ai * 128 + m * 16;
#pragma unroll
                for (int bj = 0; bj < 2; ++bj) {
                    const int col = colb + bj * 128;
                    const pg8::u32x4 rr = r[ai][m][bj];
                    pg8::f32x4 v0 = acc[ai][bj][m][0] * sc, v1 = acc[ai][bj][m][1] * sc;
                    v0[0] += ALPHA * bflo(rr.x); v0[1] += ALPHA * bfhi(rr.x); v0[2] += ALPHA * bflo(rr.y); v0[3] += ALPHA * bfhi(rr.y);
                    v1[0] += ALPHA * bflo(rr.z); v1[1] += ALPHA * bfhi(rr.z); v1[2] += ALPHA * bflo(rr.w); v1[3] += ALPHA * bfhi(rr.w);
                    st8b(out + (size_t)row * DM + col, v0, v1);
                }
            }
        }
    }
};
__device__ __forceinline__ float dpp_ror1(float x) { return __int_as_float(__builtin_amdgcn_mov_dpp(__float_as_int(x), 0x121, 0xf, 0xf, true)); }
__device__ __forceinline__ float dpp_ror2(float x) { return __int_as_float(__builtin_amdgcn_mov_dpp(__float_as_int(x), 0x122, 0xf, 0xf, true)); }
#ifndef UPT_NS
#define UPT_NS 4
#endif
struct EpiUpAct {
    static constexpr bool PERM = true, AFTER_DRAIN = false;
    bf16* ACT; bf16* UPS; float* out; const float* fw; const float* fb; LAS float* wl;
    float* part; unsigned* cnt;
    __device__ __forceinline__ void operator()(const pg8::f32x4 (&acc)[2][2][4][2], const pg8::Unit& u, int wr, int wc, int fr, int fq) const {
        const int colb = u.pn * 128 + wc * 32 + 8 * fq;
        if (u.kn > 0) {
            pg8::f32x4 (&A)[2][2][4][2] = const_cast<pg8::f32x4 (&)[2][2][4][2]>(acc);
            const int lane_ = fq * 16 + fr, ws_ = wr * 4 + wc;
            float* pb = part + (size_t)u.tidx * (UPT_NS * 65536) + ws_ * 8192 + lane_ * 4;
            float* mine = pb + (size_t)u.part * 65536;
#pragma unroll
            for (int ai = 0; ai < 2; ++ai)
#pragma unroll
                for (int bj = 0; bj < 2; ++bj)
#pragma unroll
                    for (int m = 0; m < 4; ++m)
#pragma unroll
                        for (int n = 0; n < 2; ++n) asm volatile("global_store_dwordx4 %0, %1, off sc1" :: "v"(mine + (((ai * 2 + bj) * 4 + m) * 2 + n) * 256), "v"(A[ai][bj][m][n]) : "memory");
            asm volatile("s_waitcnt vmcnt(0)" ::: "memory");
            unsigned old_ = 0u;
            if (lane_ == 0) old_ = __hip_atomic_fetch_add(cnt + u.tidx * 8 + ws_, 1u, __ATOMIC_RELAXED, __HIP_MEMORY_SCOPE_AGENT);
            old_ = __builtin_amdgcn_readfirstlane(old_);
            if (old_ != (unsigned)(UPT_NS - 1)) return;
            __builtin_amdgcn_fence(__ATOMIC_ACQUIRE, "agent");
#pragma unroll 1
            for (int j = 1; j < UPT_NS; ++j) {
                const float* op = pb + (size_t)((u.part + j) % UPT_NS) * 65536;
#pragma unroll
                for (int ai = 0; ai < 2; ++ai)
#pragma unroll
                    for (int bj = 0; bj < 2; ++bj)
#pragma unroll
                        for (int m = 0; m < 4; ++m)
#pragma unroll
                            for (int n = 0; n < 2; ++n) A[ai][bj][m][n] += *(const pg8::f32x4*)(op + (((ai * 2 + bj) * 4 + m) * 2 + n) * 256);
            }
        }
        LAS float* wl_ = wl + (wr * 4 + wc) * 256;
        {
            const int lane_ = fq * 16 + fr, k = lane_ >> 3, c4 = lane_ & 7;
            const float* src = ((k & 3) == 3 ? fb : fw + (k & 3) * DFF2) + (k >> 2) * DFF + u.pn * 128 + wc * 32 + 4 * c4;
            const pg8::f32x4 wv_ = *(const pg8::f32x4*)src * ((FFN_DOWN_FP8 && k >= 4) ? ACT_Q : 1.f);
            *(LAS pg8::f32x4*)(wl_ + lane_ * 4) = wv_;
            LDS_WAIT(); asm volatile("" ::: "memory");
        }
#pragma unroll
        for (int n = 0; n < 2; ++n) {
            const int cg = colb + 4 * n;
            pg8::f32x4 W[1][8];
#pragma unroll
            for (int k = 0; k < 8; ++k) W[0][k] = *(const LAS pg8::f32x4*)(wl_ + (k * 8 + 2 * fq + n) * 4);
            const pg8::f32x4 wg0 = W[0][0], wg1 = W[0][1], wg2 = W[0][2], bg = W[0][3], wv0 = W[0][4], wv1 = W[0][5], wv2 = W[0][6], bv = W[0][7];
#pragma unroll
            for (int ai = 0; ai < 2; ++ai) {
                pg8::f32x4 g1p = {0.f, 0.f, 0.f, 0.f}, g2p = g1p, v1p = g1p, v2p = g1p;
#pragma unroll
                for (int m = 0; m < 4; ++m) {
                    const int row = u.pm * 256 + ai * 128 + wr * 64 + m * 16 + fr;
                    const pg8::f32x4 G = acc[ai][0][m][n], V = acc[ai][1][m][n];
                    pg8::f32x4 g1, g2, v1, v2, a;
#pragma unroll
                    for (int e2 = 0; e2 < 4; e2 += 2) {
                        typedef float f2_t __attribute__((ext_vector_type(2)));
                        f2_t pg1, pg2, pv1, pv2;
#pragma unroll
                        for (int q = 0; q < 2; ++q) { const int e = e2 + q;
                            g1[e] = dpp_ror1(G[e]); g2[e] = dpp_ror2(G[e]); v1[e] = dpp_ror1(V[e]); v2[e] = dpp_ror2(V[e]);
                            pg1[q] = fr == 0 ? g1p[e] : g1[e]; pg2[q] = fr < 2 ? g2p[e] : g2[e]; pv1[q] = fr == 0 ? v1p[e] : v1[e]; pv2[q] = fr < 2 ? v2p[e] : v2[e]; }
                        const f2_t G2 = {G[e2], G[e2 + 1]}, V2 = {V[e2], V[e2 + 1]};
                        const f2_t cg2 = (f2_t){bg[e2], bg[e2 + 1]} + (f2_t){wg0[e2], wg0[e2 + 1]} * pg2 + (f2_t){wg1[e2], wg1[e2 + 1]} * pg1 + (f2_t){wg2[e2], wg2[e2 + 1]} * G2;
                        const f2_t cv2 = (f2_t){bv[e2], bv[e2 + 1]} + (f2_t){wv0[e2], wv0[e2 + 1]} * pv2 + (f2_t){wv1[e2], wv1[e2 + 1]} * pv1 + (f2_t){wv2[e2], wv2[e2 + 1]} * V2;
#pragma unroll
                        for (int q = 0; q < 2; ++q) a[e2 + q] = cg2[q] * __builtin_amdgcn_rcpf(1.f + __expf(-cg2[q])) * cv2[q];
                    }
                    g1p = g1; g2p = g2; v1p = v1; v2p = v2;
                    const bool first2 = (m == 0) && fr < 2;
#if FFN_DOWN_FP8
                    if (!first2) *(unsigned*)((unsigned char*)ACT + (size_t)row * DFF + cg) = pk4_fp8(a[0], a[1], a[2], a[3]);
#else
                    if (!first2) { pg8::u32x4 t; t.x = pg8::cvt_pk_bf16(a[0], a[1]); t.y = pg8::cvt_pk_bf16(a[2], a[3]); *(unsigned long long*)(ACT + (size_t)row * DFF + cg) = (unsigned long long)t.x | ((unsigned long long)t.y << 32); }
#endif
                    if (first2 || ((m == 3) && fr >= 14)) {
                        bf16* us = UPS + (size_t)((row >> 6) * 4 + (((row & 63) + 2) & 63)) * DFF2;
                        *(unsigned long long*)(us + cg) = (unsigned long long)pg8::cvt_pk_bf16(G[0], G[1]) | ((unsigned long long)pg8::cvt_pk_bf16(G[2], G[3]) << 32);
                        *(unsigned long long*)(us + DFF + cg) = (unsigned long long)pg8::cvt_pk_bf16(V[0], V[1]) | ((unsigned long long)pg8::cvt_pk_bf16(V[2], V[3]) << 32);
                    }
                    {
                        const bool prompt = row < NPROW; const int r2 = row - NPROW;
                        const int b = prompt ? (row >> 11) : (r2 >> 6), t = prompt ? (row & 2047) : (r2 & 63);
                        const int tl = prompt ? t - (PSEQ - 2) : t - (SSEQ - 2);
                        if (tl >= 0) { float* so = out + (prompt ? O_PFFN : O_SFFN) + (size_t)(b * 2 + tl) * DFF2; *(pg8::f32x4*)(so + cg) = G; *(pg8::f32x4*)(so + DFF + cg) = V; }
                    }
                }
            }
        }
    }
};

#define XB_TMO      128
#define XB_XCNT(j)  (256  + 64 * (j))
#define XB_XSUB(j)  (1280 + 64 * (j))
#define XB_XGEN(j)  (2304 + 64 * (j))
#define XB_TOP      3328
#define XB_TOPGEN   3392
#define XCD_BAR_WORDS 3456
#define XB_SPIN_CAP (1u << 18)

__device__ __forceinline__ unsigned xb_ld(unsigned* p)              { return __hip_atomic_load(p, __ATOMIC_RELAXED, __HIP_MEMORY_SCOPE_AGENT); }
__device__ __forceinline__ unsigned xb_add(unsigned* p, unsigned v) { return __hip_atomic_fetch_add(p, v, __ATOMIC_RELAXED, __HIP_MEMORY_SCOPE_AGENT); }
__device__ __forceinline__ unsigned xb_xcc_id() { return (unsigned)__builtin_amdgcn_s_getreg((3 << 11) | 20) & 0xFu; }
#define XB_SPIN(cond, bar) do { unsigned _sp = 0; while (cond) { __builtin_amdgcn_s_sleep(1); \
    if ((++_sp & 255u) == 0u) { if (xb_ld(&(bar)[XB_TMO])) break; if (_sp > XB_SPIN_CAP) { atomicAdd(&(bar)[XB_TMO], 1u); break; } } } } while (0)

struct XcdBarrier {
    unsigned* bar; unsigned x;
    volatile LAS unsigned* st;
};

__device__ __forceinline__ XcdBarrier xcd_barrier_post(unsigned* bar, volatile LAS unsigned* st) {
    XcdBarrier b; b.bar = bar; b.x = xb_xcc_id(); b.st = st;
    if (threadIdx.x == 0) (void)xb_add(&bar[XB_XCNT(b.x)], 1u);
    return b;
}
__device__ __forceinline__ void xcd_barrier_complete(unsigned* bar, unsigned x, unsigned& nloc, unsigned& nx) {
    const unsigned G = gridDim.x * gridDim.y * gridDim.z;
    unsigned sum, cnt, mine, sp = 0u;
    for (;;) {
        sum = 0u; cnt = 0u; mine = 0u;
#pragma unroll
        for (unsigned j = 0; j < 16; ++j) { const unsigned c = xb_ld(&bar[XB_XCNT(j)]); sum += c; cnt += (c > 0u) ? 1u : 0u; mine = (j == x) ? c : mine; }
        if (sum == G) break;
        __builtin_amdgcn_s_sleep(1);
        if ((++sp & 255u) == 0u) { if (xb_ld(&bar[XB_TMO])) break; if (sp > XB_SPIN_CAP) { atomicAdd(&bar[XB_TMO], 1u); break; } }
    }
    nloc = mine > 0u ? mine : 1u; nx = cnt > 0u ? cnt : 1u;
}

__device__ __forceinline__ void xcd_barrier(const XcdBarrier& b) {
    asm volatile("s_waitcnt vmcnt(0)" ::: "memory");
    __syncthreads();
    if (threadIdx.x == 0) {
        unsigned* bar = b.bar;
        __builtin_amdgcn_s_waitcnt(0);
        unsigned nloc = b.st[0], nx = b.st[1];
        if (nloc == 0u) { xcd_barrier_complete(bar, b.x, nloc, nx); b.st[0] = nloc; b.st[1] = nx; }
        const unsigned old = xb_add(&bar[XB_XSUB(b.x)], 1u);
        const unsigned gen = old / nloc;
        if (old + 1u == (gen + 1u) * nloc) {
            __builtin_amdgcn_fence(__ATOMIC_RELEASE, "agent");
            asm volatile("s_waitcnt vmcnt(0)" ::: "memory");
            const unsigned og = xb_add(&bar[XB_TOP], 1u);
            const unsigned tg = og / nx;
            if (og + 1u == (tg + 1u) * nx) xb_add(&bar[XB_TOPGEN], 1u);
            else XB_SPIN(xb_ld(&bar[XB_TOPGEN]) == tg, bar);
            __builtin_amdgcn_fence(__ATOMIC_ACQUIRE, "agent");
            xb_add(&bar[XB_XGEN(b.x)], 1u);
            asm volatile("s_waitcnt vmcnt(0)" ::: "memory");
        } else {
            XB_SPIN(xb_ld(&bar[XB_XGEN(b.x)]) == gen, bar);
            __builtin_amdgcn_fence(__ATOMIC_ACQUIRE, "agent");
            asm volatile("s_waitcnt vmcnt(0)" ::: "memory");
        }
    }
    __syncthreads();
}

struct Ctx {
    float* out; unsigned char* ws;
    LAS unsigned char* lds; gu32* ctl;
    int tid, lane, wave, G, bid;
};
enum { I_XP = 0, I_XS, I_CK, I_CV, I_CIK, I_SDELTA, I_SCONV, I_SFFN, I_LNG, I_LNB, I_WIN, I_CQW, I_CQB, I_ALOG, I_DTB, I_DNG, I_RELB, I_WO, I_LN1G, I_LN1B, I_WUP, I_FCW, I_FCB, I_WDN, I_LN2G, I_LN2B };

constexpr int PTAB_OFF = LDSCTL_OFF + 1024;
__device__ __forceinline__ const float* inp(const Ctx& C, int i) {
    const unsigned long long v = ((const LAS unsigned long long*)(C.lds + PTAB_OFF))[i];
    const unsigned lo = __builtin_amdgcn_readfirstlane((unsigned)v), hi = __builtin_amdgcn_readfirstlane((unsigned)(v >> 32));
    return (const float*)(const GAS float*)(size_t)(((unsigned long long)hi << 32) | lo);
}
__device__ __forceinline__ int q_next(const Ctx& C, int cw) {
    volatile LAS unsigned* slot = (volatile LAS unsigned*)(C.lds + MISC_OFF) + 16;
    __syncthreads();
    if (C.tid == 0) *slot = __hip_atomic_fetch_add((unsigned*)(C.ctl + cw), 1u, __ATOMIC_RELAXED, __HIP_MEMORY_SCOPE_AGENT);
    __syncthreads();
    return (int)*slot;
}

template <int MODE> __device__ __forceinline__ int dst_row_map(int n) {
    if (MODE == 0 || MODE == 3 || MODE == 4) return n;
    if (MODE == 2) { const int v = n >= DFF, j = v ? n - DFF : n; return (j >> 7) * 256 + v * 128 + (j & 127); }
    if (n < 4096) return n;
    if (n < 4160) return HSM + (n - 4096);
    if (n < 4176) return HSM + 64 + (n - 4160);
    if (n < 12368) return n - 80;
    return n;
}
__device__ __forceinline__ void tr_load(const float* W, int K, int N, int item, int lane, float (&v)[32]) {
    const int nblk = (N + 31) / 32, kb = item / nblk, nb = item % nblk, k0 = 64 * kb, n0 = 32 * nb;
    const int nn = min(n0 + (lane & 31), N - 1);
    const float* src = W + (size_t)(k0 + (lane >> 5)) * N + nn;
#pragma unroll
    for (int i = 0; i < 32; ++i) v[i] = src[(size_t)(2 * i) * N];
}
template <int MODE> __device__ __forceinline__ void tr_store(int K, int N, bf16* WT, LAS float* scr, int item, int lane, const float (&v)[32]) {
    const int ldw = (MODE == 1 || MODE == 2) ? LDX : K;
    const int nblk = (N + 31) / 32, kb = item / nblk, nb = item % nblk, k0 = 64 * kb, n0 = 32 * nb;
#pragma unroll
    for (int i = 0; i < 32; ++i) scr[(2 * i + (lane >> 5)) * 33 + (lane & 31)] = v[i];
    LDS_WAIT(); asm volatile("" ::: "memory");
    const int c = lane & 7;
#pragma unroll
    for (int j = 0; j < 4; ++j) { const int n = (lane >> 3) + 8 * j; const LAS float* s = scr + (8 * c) * 33 + n;
        v4u o; o.x = pk2(s[0 * 33], s[1 * 33]); o.y = pk2(s[2 * 33], s[3 * 33]); o.z = pk2(s[4 * 33], s[5 * 33]); o.w = pk2(s[6 * 33], s[7 * 33]);
        if (MODE == 3 || MODE == 4) { const float WQ_ = MODE == 3 ? WDN_Q : WO_Q; if (n0 + n < N) { v2u q; q.x = pk4_fp8(s[0 * 33] * WQ_, s[1 * 33] * WQ_, s[2 * 33] * WQ_, s[3 * 33] * WQ_); q.y = pk4_fp8(s[4 * 33] * WQ_, s[5 * 33] * WQ_, s[6 * 33] * WQ_, s[7 * 33] * WQ_);
                                          *(v2u*)((unsigned char*)WT + (size_t)(n0 + n) * K + k0 + 8 * c) = q; } }
        else if (n0 + n < N) *(v4u*)(WT + (size_t)dst_row_map<MODE>(n0 + n) * ldw + k0 + 8 * c) = o; }
    LDS_WAIT(); asm volatile("" ::: "memory");
}
template <int MODE> __device__ __forceinline__ void transpose_static(const float* W, int K, int N, bf16* WT, int total, LAS float* scr, int gw, int NGW, int lane) {
    float a[32], b[32];
    int it = gw;
    if (it >= total) return;
    tr_load(W, K, N, it, lane, a);
#pragma unroll 1
    for (;;) {
        const int it1 = it + NGW, it2 = it1 + NGW;
        tr_load(W, K, N, min(it1, total - 1), lane, b);
        tr_store<MODE>(K, N, WT, scr, it, lane, a);
        if (it1 >= total) break;
        tr_load(W, K, N, min(it2, total - 1), lane, a);
        tr_store<MODE>(K, N, WT, scr, it1, lane, b);
        if (it2 >= total) break;
        it = it2;
    }
}
__device__ __forceinline__ int wup_item(int v) {
    if (v < 18432) { const int kb = v / 288, e = v - kb * 288; return kb * 688 + (e < 144 ? e : e + 200); }
    const int w = v - 18432, kb = w / 400, e = w - kb * 400; return kb * 688 + (e < 200 ? e + 144 : e + 288);
}
template <int MODE, bool UPMAP = false> __device__ __forceinline__ void transpose_queue(const Ctx& C, const float* W, int K, int N, bf16* WT, int nitems, int cw, int g_lo = 0, int g_hi = 1 << 30, int scr_base = 0, int scr_stride = 16384) {
    LAS float* scr = (LAS float*)(C.lds + scr_base + C.wave * scr_stride);
    volatile LAS unsigned* slot = (volatile LAS unsigned*)(C.lds + MISC_OFF) + 16;
    const int ngrab = min((nitems + 15) / 16, g_hi);
    int g = g_lo + q_next(C, cw);
    if (g >= ngrab) return;
    float a[32], b[32];
    tr_load(W, K, N, UPMAP ? wup_item(min(g * 16 + C.wave, nitems - 1)) : min(g * 16 + C.wave, nitems - 1), C.lane, a);
#pragma unroll 1
    for (;;) {
        const int i0 = g * 16 + C.wave, i1 = i0 + 8;
        unsigned tk = 0u;
        if (C.tid == 0) tk = __hip_atomic_fetch_add((unsigned*)(C.ctl + cw), 1u, __ATOMIC_RELAXED, __HIP_MEMORY_SCOPE_AGENT);
        tr_load(W, K, N, UPMAP ? wup_item(min(i1, nitems - 1)) : min(i1, nitems - 1), C.lane, b);
        if (i0 < nitems) tr_store<MODE>(K, N, WT, scr, UPMAP ? wup_item(i0) : i0, C.lane, a);
        __syncthreads();
        if (C.tid == 0) *slot = tk;
        __syncthreads();
        const int gn = g_lo + (int)*slot;
        tr_load(W, K, N, UPMAP ? wup_item(min(gn * 16 + C.wave, nitems - 1)) : min(gn * 16 + C.wave, nitems - 1), C.lane, a);
        if (i1 < nitems) tr_store<MODE>(K, N, WT, scr, UPMAP ? wup_item(i1) : i1, C.lane, b);
        if (gn >= ngrab) break;
        g = gn;
    }
}
template <int MODE> __device__ __forceinline__ bool transpose_grabs(const Ctx& C, const float* W, int K, int N, bf16* WT, int nitems, int cw, int g_lo, int g_hi, int scr_base, int scr_stride, int ngr) {
    LAS float* scr = (LAS float*)(C.lds + scr_base + C.wave * scr_stride);
    const int ngrab = min((nitems + 15) / 16, g_hi);
#pragma unroll 1
    for (int j = 0; j < ngr; ++j) {
        const int g = g_lo + q_next(C, cw); if (g >= ngrab) return false;
        const int i0 = g * 16 + C.wave, i1 = i0 + 8;
        float a[32], b[32];
        tr_load(W, K, N, min(i0, nitems - 1), C.lane, a);
        tr_load(W, K, N, min(i1, nitems - 1), C.lane, b);
        if (i0 < nitems) tr_store<MODE>(K, N, WT, scr, i0, C.lane, a);
        if (i1 < nitems) tr_store<MODE>(K, N, WT, scr, i1, C.lane, b);
    }
    return true;
}
struct LnP { f32x4 g[16], b[16]; };
__device__ __forceinline__ void ln_params(LnP& P, const float* g, const float* bta, int lane) {
#pragma unroll
    for (int j = 0; j < 16; ++j) { P.g[j] = ((const f32x4*)g)[lane + 64 * j]; P.b[j] = ((const f32x4*)bta)[lane + 64 * j]; }
}
template <bool F32OUT, bool TAIL = false, bool INBF = false> __device__ __forceinline__ void ln_row(const void* xrow, const LnP& P, void* orow, int lane, const unsigned* tix16 = nullptr, const float* p2 = nullptr, int rin = 0) {
    f32x4 v[16]; float s = 0.f;
    if (INBF) {
        const v2u* xr = (const v2u*)xrow + lane;
#pragma unroll
        for (int j = 0; j < 16; ++j) { const v2u w = xr[64 * j]; v[j] = (f32x4){bflo(w.x), bfhi(w.x), bflo(w.y), bfhi(w.y)}; }
    } else {
        const f32x4* xr = (const f32x4*)xrow + lane;
#pragma unroll
        for (int j = 0; j < 16; ++j) v[j] = xr[64 * j];
    }
    if (TAIL) {
        unsigned tt[16], any = 0u;
#pragma unroll
        for (int j = 0; j < 16; ++j) { tt[j] = __builtin_amdgcn_readfirstlane(tix16[j]); any |= tt[j]; }
        if (any) {
#pragma unroll
            for (int h = 0; h < 4; ++h) {
                f32x4 pv[4];
#pragma unroll
                for (int j = 0; j < 4; ++j) { const unsigned t = tt[4 * h + j]; pv[j] = *(const f32x4*)(p2 + (size_t)(t ? t - 1u : 0u) * 65536 + (size_t)rin * 256 + lane * 4); }
#pragma unroll
                for (int j = 0; j < 4; ++j) { const float on = tt[4 * h + j] ? 1.f : 0.f; v[4 * h + j] += pv[j] * on; }
            }
        }
    }
#pragma unroll
    for (int j = 0; j < 16; ++j) s += (v[j].x + v[j].y) + (v[j].z + v[j].w);
    const float mean = wave_sum(s) * (1.f / DM); float s2 = 0.f;
#pragma unroll
    for (int j = 0; j < 16; ++j) { v[j] = v[j] - mean; s2 += (v[j].x * v[j].x + v[j].y * v[j].y) + (v[j].z * v[j].z + v[j].w * v[j].w); }
    const float rstd = 1.f / sqrtf(wave_sum(s2) * (1.f / DM) + LN_EPS);
#pragma unroll
    for (int j = 0; j < 16; ++j) {
        const f32x4 y = v[j] * rstd * P.g[j] + P.b[j];
        if (F32OUT) ((f32x4*)orow)[lane + 64 * j] = y;
        else { v2u w; w.x = pk2(y.x, y.y); w.y = pk2(y.z, y.w); ((v2u*)orow)[lane + 64 * j] = w; }
    }
}

#ifndef LN_PIPE
#define LN_PIPE 0
#endif
__device__ __forceinline__ void ln_ld(f32x4 (&v)[16], const float* xrow, int lane) {
    const unsigned vo = 16u * (unsigned)lane;
#pragma unroll
    for (int j = 0; j < 16; ++j) GLD128S(v[j], vo + 4096u * (j >> 2), xrow, 1024 * (j & 3));
}
#define LN_WAIT(N, v) asm volatile("s_waitcnt vmcnt(" #N ")" : "+v"(v[0]), "+v"(v[1]), "+v"(v[2]), "+v"(v[3]), "+v"(v[4]), "+v"(v[5]), "+v"(v[6]), "+v"(v[7]), "+v"(v[8]), "+v"(v[9]), "+v"(v[10]), "+v"(v[11]), "+v"(v[12]), "+v"(v[13]), "+v"(v[14]), "+v"(v[15]))
__device__ __forceinline__ void ln_fin(f32x4 (&v)[16], const LAS f32x4* gl, const LAS f32x4* bl, bf16* orow, int lane) {
    float s = 0.f;
#pragma unroll
    for (int j = 0; j < 16; ++j) s += (v[j].x + v[j].y) + (v[j].z + v[j].w);
    const float mean = wave_sum(s) * (1.f / DM); float s2 = 0.f;
#pragma unroll
    for (int j = 0; j < 16; ++j) { v[j] = v[j] - mean; s2 += (v[j].x * v[j].x + v[j].y * v[j].y) + (v[j].z * v[j].z + v[j].w * v[j].w); }
    const float rstd = 1.f / sqrtf(wave_sum(s2) * (1.f / DM) + LN_EPS);
    const unsigned ga = (unsigned)(size_t)gl + 16u * lane;
#pragma unroll
    for (int q = 0; q < 4; ++q) {
        f32x4 g4[4], b4[4];
#pragma unroll
        for (int j = 0; j < 4; ++j) { DS_RD128(g4[j], ga, 1024 * (4 * q + j)); DS_RD128(b4[j], ga, 16384 + 1024 * (4 * q + j)); }
        asm volatile("s_waitcnt lgkmcnt(0)" : "+v"(g4[0]), "+v"(g4[1]), "+v"(g4[2]), "+v"(g4[3]), "+v"(b4[0]), "+v"(b4[1]), "+v"(b4[2]), "+v"(b4[3]));
#pragma unroll
        for (int j = 0; j < 4; ++j) {
            const f32x4 y = v[4 * q + j] * rstd * g4[j] + b4[j];
            v2u w; w.x = pk2(y.x, y.y); w.y = pk2(y.z, y.w); ((v2u*)orow)[lane + 64 * (4 * q + j)] = w;
        }
    }
    (void)bl;
}
__device__ __forceinline__ void phase0(const Ctx& C) {
    LAS float* scr = (LAS float*)(C.lds + C.wave * 16384);
    const int gw = C.bid * NWAVES + C.wave, NGW = C.G * NWAVES;
    bf16* WinT = (bf16*)(C.ws + WS_WIN); bf16* WoT = (bf16*)(C.ws + WS_WO); bf16* XN = (bf16*)(C.ws + WS_XN);
    constexpr int I_IN = (DM / 64) * ((NIN + 31) / 32), I_O = (DM / 64) * (DM / 32);
    transpose_static<1>(inp(C, I_WIN), DM, NIN, WinT, I_IN, scr, gw, NGW, C.lane);
    (void)WoT; (void)I_O;
    for (int i = gw * 64 + C.lane; i < 144 * (LDX / 8); i += NGW * 64) ((v4u*)(WinT + (size_t)NIN * LDX))[i] = (v4u){0u, 0u, 0u, 0u};
#if defined(PROBE_DUP) && PROBE_DUP == 13
    transpose_static<1>(inp(C, I_WIN), DM, NIN, WinT, I_IN, scr, gw, NGW, C.lane);
#endif
#if LN_PIPE
    {
        __syncthreads();
        LAS f32x4* gl = (LAS f32x4*)C.lds; LAS f32x4* bl = gl + DM / 4;
        for (int i = C.tid; i < DM / 4; i += NWAVES * 64) { gl[i] = ((const f32x4*)inp(C, I_LNG))[i]; bl[i] = ((const f32x4*)inp(C, I_LNB))[i]; }
        __syncthreads();
        const float* xp = inp(C, I_XP); const float* xs = inp(C, I_XS);
        f32x4 va[16], vb[16];
        int m = gw;
        if (m < MTOK) {
            ln_ld(va, m < NPROW ? xp + (size_t)m * DM : xs + (size_t)(m - NPROW) * DM, C.lane);
            LN_WAIT(0, va);
#pragma unroll 1
            for (;;) {
                const int m1 = m + NGW, m1c = min(m1, MTOK - 1), m2 = m1 + NGW, m2c = min(m2, MTOK - 1);
                ln_ld(vb, m1c < NPROW ? xp + (size_t)m1c * DM : xs + (size_t)(m1c - NPROW) * DM, C.lane);
                LN_WAIT(32, va);
                ln_fin(va, gl, bl, XN + (size_t)m * LDX, C.lane);
                if (m1 >= MTOK) break;
                ln_ld(va, m2c < NPROW ? xp + (size_t)m2c * DM : xs + (size_t)(m2c - NPROW) * DM, C.lane);
                LN_WAIT(32, vb);
                ln_fin(vb, gl, bl, XN + (size_t)m1 * LDX, C.lane);
                if (m2 >= MTOK) break;
                m = m2;
            }
            asm volatile("s_waitcnt vmcnt(0)" ::: "memory");
        }
    }
#else
    LnP P; ln_params(P, inp(C, I_LNG), inp(C, I_LNB), C.lane);
#pragma unroll 1
    for (int m = gw; m < MTOK; m += NGW) {
        const float* xr = m < NPROW ? inp(C, I_XP) + (size_t)m * DM : inp(C, I_XS) + (size_t)(m - NPROW) * DM;
        ln_row<false>(xr, P, XN + (size_t)m * LDX, C.lane);
    }
#endif
#if defined(PROBE_DUP) && PROBE_DUP == 14
#pragma unroll 1
    for (int m = gw; m < MTOK; m += NGW) {
        const float* xr = m < NPROW ? inp(C, I_XP) + (size_t)m * DM : inp(C, I_XS) + (size_t)(m - NPROW) * DM;
        ln_row<false>(xr, P, XN + (size_t)m * LDX, C.lane);
    }
#endif
}

__device__ __forceinline__ void select_row(const Ctx& C, int row, int L, unsigned long long* msk, int lane) {
    const float* SC = C.out + OS_SC;
    if (L <= TOPK) { if (lane < 32) msk[lane] = (64 * lane < L) ? ~0ull : 0ull; return; }
    unsigned v[32];
    {
        const float* p0 = SC + (size_t)row * 2048 + lane; const float* p1 = p0 + 1024;
#pragma unroll
        for (int i = 0; i < 16; ++i) { GLD32(v[i], p0, i * 256); GLD32(v[16 + i], p1, i * 256); }
        asm volatile("s_waitcnt vmcnt(0)" : "+v"(v[0]), "+v"(v[1]), "+v"(v[2]), "+v"(v[3]), "+v"(v[4]), "+v"(v[5]), "+v"(v[6]), "+v"(v[7]), "+v"(v[8]), "+v"(v[9]), "+v"(v[10]), "+v"(v[11]), "+v"(v[12]), "+v"(v[13]), "+v"(v[14]), "+v"(v[15]));
        asm volatile("" : "+v"(v[16]), "+v"(v[17]), "+v"(v[18]), "+v"(v[19]), "+v"(v[20]), "+v"(v[21]), "+v"(v[22]), "+v"(v[23]), "+v"(v[24]), "+v"(v[25]), "+v"(v[26]), "+v"(v[27]), "+v"(v[28]), "+v"(v[29]), "+v"(v[30]), "+v"(v[31]));
        int Lr = L; asm volatile("" : "+s"(Lr));
#pragma unroll
        for (int i = 0; i < 32; ++i) { unsigned u = v[i]; u = (u & 0x80000000u) ? ~u : (u | 0x80000000u); v[i] = (lane + 64 * i < Lr) ? u : 0u; }
    }
    unsigned T = 0u;
    for (int bit = 31; bit >= 0; --bit) {
        const unsigned cand = T | (1u << bit); int cnt = 0;
#pragma unroll
        for (int i = 0; i < 32; ++i) cnt += __popcll(__ballot(v[i] >= cand));
        if (cnt >= TOPK) { T = cand; if (cnt == TOPK) break; }
    }
    int cgt = 0;
#pragma unroll
    for (int i = 0; i < 32; ++i) cgt += __popcll(__ballot(v[i] > T));
    const int need = TOPK - cgt;
    const unsigned long long ltm = (1ull << lane) - 1ull;
    int eqb = 0;
#pragma unroll
    for (int i = 0; i < 32; ++i) {
        const bool gt = v[i] > T, eq = v[i] == T;
        const unsigned long long eqm = __ballot(eq);
        const int myeq = eqb + __popcll(eqm & ltm);
        const unsigned long long sm = __ballot(gt || (eq && myeq < need));
        if (lane == 0) msk[i] = sm;
        eqb += __popcll(eqm);
    }
}
__device__ __forceinline__ float relu_i(float x) { const int b = __builtin_bit_cast(int, x); return __builtin_bit_cast(float, b > 0 ? b : 0); }
__device__ __forceinline__ float relu_f(float x) { return __builtin_amdgcn_fmed3f(x, 0.f, __builtin_inff()); }
template <bool DOSEL = true> __device__ __forceinline__ void idx_unit(const Ctx& C, int item) {
    bool prompt; int b, c;
    if (item < 120) { prompt = true; c = 31 - item / 8; b = item % 8; }
    else if (item < 152) { prompt = false; c = 0; b = item - 120; }
    else { prompt = true; const int j = item - 152; c = 16 - j / 8; b = j % 8; }
    const bf16* H = (const bf16*)(C.ws + WS_H);
    const float* SM = C.out + OS_SM; float* SC = C.out + OS_SC;
    const int row0 = prompt ? b * PSEQ + c * 64 : NPROW + b * SSEQ;
    const int nkt = prompt ? c + 1 : (PAST + SSEQ) / 64;
    int lane_ = C.lane; asm volatile("" : "+v"(lane_));
    const int lane = lane_, l15 = lane & 15, l4 = lane >> 4;
    LAS float* wl = (LAS float*)(C.lds + EPIW_OFF);
    LAS unsigned char* QL = C.lds;
    __syncthreads();
    for (int i = C.tid; i < 1024; i += NWAVES * 64) wl[i] = SM[(size_t)(row0 + (i >> 4)) * 128 + 64 + (i & 15)] * IDX_SCALE;
    {
        const bf16* qsrc = H + (size_t)(row0 + (C.tid >> 7)) * LDH + HIQ + (C.tid & 127) * 8;
        v4u qv[16];
#pragma unroll
        for (int k = 0; k < 16; ++k) qv[k] = *(const v4u*)(qsrc + (size_t)(4 * k) * LDH);
#pragma unroll
        for (int k = 0; k < 16; ++k) { const int row = (C.tid >> 7) + 4 * k, p = C.tid & 127; *(LAS v4u*)(QL + row * 2048 + ((p ^ (row & 15)) << 4)) = qv[k]; }
    }
    __syncthreads();
    const unsigned qrb = (unsigned)(size_t)QL + (unsigned)l15 * 2048u;
    const unsigned qlo00 = qrb + (unsigned)(((0 + l4) ^ l15) << 4), qlo01 = qrb + (unsigned)(((4 + l4) ^ l15) << 4), qlo10 = qrb + (unsigned)(((8 + l4) ^ l15) << 4), qlo11 = qrb + (unsigned)(((12 + l4) ^ l15) << 4);
#define IDX_QRD(dst, a0, a1) do { const unsigned b0_ = (a0) + 65536u, b1_ = (a1) + 65536u; \
        DS_RD128(dst[0][0], a0, 0); DS_RD128(dst[0][1], a1, 0); DS_RD128(dst[1][0], a0, 32768); DS_RD128(dst[1][1], a1, 32768); \
        DS_RD128(dst[2][0], b0_, 0); DS_RD128(dst[2][1], b1_, 0); DS_RD128(dst[3][0], b0_, 32768); DS_RD128(dst[3][1], b1_, 32768); } while (0)
#define IDX_QWAIT(f) asm volatile("s_waitcnt lgkmcnt(0)" : "+v"(f[0][0]), "+v"(f[0][1]), "+v"(f[1][0]), "+v"(f[1][1]), "+v"(f[2][0]), "+v"(f[2][1]), "+v"(f[3][0]), "+v"(f[3][1]))
#define IDX_HEAD(f, HH) do { float w[4]; \
        _Pragma("unroll") for (int qb = 0; qb < 4; ++qb) w[qb] = wl[(qb * 16 + l15) * 16 + (HH)]; \
        _Pragma("unroll") for (int kb = 0; kb < 4; ++kb) {     \
            f32x4 a[4]; \
            _Pragma("unroll") for (int qb = 0; qb < 4; ++qb) a[qb] = __builtin_amdgcn_mfma_f32_16x16x32_bf16(afr[kb][0], f[qb][0], (f32x4){0.f, 0.f, 0.f, 0.f}, 0, 0, 0); \
            _Pragma("unroll") for (int qb = 0; qb < 4; ++qb) a[qb] = __builtin_amdgcn_mfma_f32_16x16x32_bf16(afr[kb][1], f[qb][1], a[qb], 0, 0, 0); \
            __builtin_amdgcn_sched_barrier(0); \
            _Pragma("unroll") for (int qb = 0; qb < 4; ++qb) { const f32x4 av = a[qb]; \
                  \
                const f32x4 rv = (f32x4){relu_i(av[0]), relu_i(av[1]), relu_i(av[2]), relu_i(av[3])}; \
                idx[kb][qb] += rv * w[qb]; } \
            __builtin_amdgcn_sched_barrier(0); } } while (0)
    for (int kt = C.wave; kt < nkt; kt += NWAVES) {
        bf16x8 afr[4][2];
        if (prompt || kt == nkt - 1) {
            const int krow0 = prompt ? b * PSEQ + kt * 64 : NPROW + b * SSEQ;
#pragma unroll
            for (int kb = 0; kb < 4; ++kb)
#pragma unroll
                for (int ks = 0; ks < 2; ++ks) afr[kb][ks] = *(const bf16x8*)(H + (size_t)(krow0 + kb * 16 + l15) * LDH + HSM + ks * 32 + l4 * 8);
        } else {
            const float* ck = inp(C, I_CIK) + ((size_t)b * PAST + kt * 64) * 64;
#pragma unroll
            for (int kb = 0; kb < 4; ++kb)
#pragma unroll
                for (int ks = 0; ks < 2; ++ks) {
                    const f32x4* p = (const f32x4*)(ck + (size_t)(kb * 16 + l15) * 64 + ks * 32 + l4 * 8);
                    const f32x4 x0 = p[0], x1 = p[1]; v4u w; w.x = pk2(x0.x, x0.y); w.y = pk2(x0.z, x0.w); w.z = pk2(x1.x, x1.y); w.w = pk2(x1.z, x1.w);
                    afr[kb][ks] = __builtin_bit_cast(bf16x8, w);
                }
        }
        f32x4 idx[4][4];
#pragma unroll
        for (int kb = 0; kb < 4; ++kb)
#pragma unroll
            for (int qb = 0; qb < 4; ++qb) idx[kb][qb] = (f32x4){0.f, 0.f, 0.f, 0.f};
        bf16x8 bfr[4][2], bnx[4][2];
        IDX_QRD(bfr, qlo00, qlo01); IDX_QWAIT(bfr);
#pragma unroll 1
        for (int hp = 0; hp < 8; ++hp) {
            const unsigned ho = (unsigned)hp * 256u, hn = (unsigned)(hp < 7 ? hp + 1 : 7) * 256u;
            IDX_QRD(bnx, qlo10 + ho, qlo11 + ho);
            __builtin_amdgcn_sched_barrier(0);
            IDX_HEAD(bfr, 2 * hp);
            __builtin_amdgcn_sched_barrier(0);
            IDX_QWAIT(bnx);
            IDX_QRD(bfr, qlo00 + hn, qlo01 + hn);
            __builtin_amdgcn_sched_barrier(0);
            IDX_HEAD(bnx, 2 * hp + 1);
            __builtin_amdgcn_sched_barrier(0);
            IDX_QWAIT(bfr);
        }
#pragma unroll
        for (int kb = 0; kb < 4; ++kb)
#pragma unroll
            for (int qb = 0; qb < 4; ++qb)
                *(f32x4*)(SC + (size_t)(row0 + qb * 16 + l15) * 2048 + kt * 64 + kb * 16 + l4 * 4) = idx[kb][qb];
    }
#undef IDX_QRD
#undef IDX_QWAIT
#undef IDX_HEAD
    __syncthreads();
    if (DOSEL) {
        unsigned long long* MG = (unsigned long long*)(C.out + OS_MSK);
        const int Lq = prompt ? (c + 1) * 64 : SLEN;
#pragma unroll 1
        for (int j = 0; j < 8; ++j) { const int row = row0 + C.wave * 8 + j; select_row(C, row, Lq, MG + (size_t)row * 32, lane); }
    }
}
__device__ __forceinline__ void prep_unit(const Ctx& C, int tb) {
    const bf16* H = (const bf16*)(C.ws + WS_H); bf16* QKVC = (bf16*)(C.ws + WS_QKVC);
    const int R0 = tb * 16; const bool prompt = R0 < NPROW; const int r2 = R0 - NPROW;
    const int b = prompt ? (R0 >> 11) : (r2 >> 6), t0 = prompt ? (R0 & 2047) : (r2 & 63);
    const float* cw = inp(C, I_CQW); const float* cb = inp(C, I_CQB); const float* st = inp(C, I_SCONV);
    for (int seg = C.wave; seg < 48; seg += NWAVES) {
        const int c = seg * 128 + 2 * C.lane;
        const f32x2 w0 = *(const f32x2*)(cw + c), w1 = *(const f32x2*)(cw + CQKV + c), w2 = *(const f32x2*)(cw + 2 * CQKV + c), w3 = *(const f32x2*)(cw + 3 * CQKV + c), bi = *(const f32x2*)(cb + c);
        f32x2 xm3, xm2, xm1;
        if (t0 > 0) {
            const unsigned a = *(const unsigned*)(H + (size_t)(R0 - 3) * LDH + HQKV + c), bq = *(const unsigned*)(H + (size_t)(R0 - 2) * LDH + HQKV + c), cq = *(const unsigned*)(H + (size_t)(R0 - 1) * LDH + HQKV + c);
            xm3 = (f32x2){bflo(a), bfhi(a)}; xm2 = (f32x2){bflo(bq), bfhi(bq)}; xm1 = (f32x2){bflo(cq), bfhi(cq)};
        } else if (prompt) { xm3 = xm2 = xm1 = (f32x2){0.f, 0.f}; }
        else { xm3 = *(const f32x2*)(st + (size_t)(b * 3 + 0) * CQKV + c); xm2 = *(const f32x2*)(st + (size_t)(b * 3 + 1) * CQKV + c); xm1 = *(const f32x2*)(st + (size_t)(b * 3 + 2) * CQKV + c); }
        const float post = seg < 16 ? QSCALE : 1.f;
#pragma unroll 4
        for (int i = 0; i < 16; ++i) {
            const unsigned xw = *(const unsigned*)(H + (size_t)(R0 + i) * LDH + HQKV + c);
            const f32x2 x0 = (f32x2){bflo(xw), bfhi(xw)};
            f32x2 y = bi + w0 * xm3 + w1 * xm2 + w2 * xm1 + w3 * x0;
            y.x = silu_f(y.x); y.y = silu_f(y.y);
            if (seg < 32) { const float ss = wave_sum(y.x * y.x + y.y * y.y); const float sc = post / sqrtf(ss + 1e-6f); y.x *= sc; y.y *= sc; }
            *(unsigned*)(QKVC + (size_t)(R0 + i) * CQKV + c) = pk2(y.x, y.y);
            xm3 = xm2; xm2 = xm1; xm1 = x0;
        }
    }
}

constexpr int DCH = 32;
__device__ __forceinline__ void delta_unit(const Ctx& C, int item) {
    const bool prompt = item < 128; const int j2 = item - 128;
    const int b = prompt ? item >> 4 : j2 >> 4, h = item & 15;
    const int T = prompt ? PSEQ : SSEQ, rowbase = prompt ? b * PSEQ : NPROW + b * SSEQ;
    const bf16* H = (const bf16*)(C.ws + WS_H); const bf16* QKVC = (const bf16*)(C.ws + WS_QKVC); bf16* CAT = (bf16*)(C.ws + WS_CAT);
    const float* SM = C.out + OS_SM;
    LAS float* qs = (LAS float*)(C.lds + 16384);
    LAS float* ks = qs + DCH * 128;
    LAS float* vs = ks + DCH * 128;
    LAS float* os = vs + DCH * 128;
    LAS float* xch = os + DCH * 128;
    LAS float* sc = xch + 2 * 4 * 128 * 2;
    int tid_ = C.tid; asm volatile("" : "+v"(tid_));
    const int tid = tid_, e = tid & 127, part = __builtin_amdgcn_readfirstlane(tid >> 7), lane = tid & 63, wave = __builtin_amdgcn_readfirstlane(tid >> 6);
    float S[32];
    if (prompt) {
#pragma unroll
        for (int i = 0; i < 32; ++i) S[i] = 0.f;
    } else {
        const float* s0 = inp(C, I_SDELTA) + ((size_t)(b * 16 + h) * 128 + part * 32) * 128 + e;
#pragma unroll
        for (int i = 0; i < 32; ++i) S[i] = s0[(size_t)i * 128];
    }
    const float Aexp = expf(inp(C, I_ALOG)[h]), dtb = inp(C, I_DTB)[h];
    const f32x2 gn = *(const f32x2*)(inp(C, I_DNG) + 2 * lane);
    for (int c0 = 0; c0 < T; c0 += DCH) {
        __syncthreads();
        for (int idx = tid; idx < DCH * 192; idx += NWAVES * 64) {
            const int r = idx / 192, p = idx % 192, which = p >> 6, pp = p & 63;
            const unsigned w = *(const unsigned*)(QKVC + (size_t)(rowbase + c0 + r) * CQKV + which * 2048 + h * 128 + 2 * pp);
            LAS float* dst = (which == 0 ? qs : which == 1 ? ks : vs) + r * 128 + 2 * pp;
            dst[0] = bflo(w); dst[1] = bfhi(w);
        }
        if (tid < DCH) {
            const size_t row = (size_t)(rowbase + c0 + tid);
            const float a_in = SM[row * 128 + 96 + h], b_in = SM[row * 128 + 80 + h];
            const float x = a_in + dtb; const float sp = x > 20.f ? x : log1pf(expf(x));
            sc[tid * 4 + 0] = expf(-Aexp * sp); sc[tid * 4 + 1] = 1.f / (1.f + expf(-b_in));
        }
        __syncthreads();
        for (int r = wave; r < DCH; r += NWAVES) {
            const float d = qs[r * 128 + 2 * lane] * ks[r * 128 + 2 * lane] + qs[r * 128 + 2 * lane + 1] * ks[r * 128 + 2 * lane + 1];
            const float s = wave_sum(d); if (lane == 0) sc[r * 4 + 2] = s;
        }
        __syncthreads();
        for (int t = 0; t < DCH; ++t) {
            const LAS float* kt = ks + t * 128 + part * 32; const LAS float* qt = qs + t * 128 + part * 32;
            float kreg[32]; float pk = 0.f, pq = 0.f;
#pragma unroll
            for (int i = 0; i < 32; ++i) { kreg[i] = kt[i]; pk += kreg[i] * S[i]; pq += qt[i] * S[i]; }
            LAS f32x2* xb = (LAS f32x2*)xch + (t & 1) * 512;
            xb[part * 128 + e] = (f32x2){pk, pq};
            __syncthreads();
            const f32x2 x0 = xb[e], x1 = xb[128 + e], x2 = xb[256 + e], x3 = xb[384 + e];
            const float kS = (x0.x + x1.x) + (x2.x + x3.x), qS = (x0.y + x1.y) + (x2.y + x3.y);
            const float eg = sc[t * 4 + 0], beta = sc[t * 4 + 1], qk = sc[t * 4 + 2];
            const float vn = beta * (vs[t * 128 + e] - eg * kS);
            const float o = eg * qS + qk * vn;
#pragma unroll
            for (int i = 0; i < 32; ++i) S[i] = eg * S[i] + kreg[i] * vn;
            if (part == 0) os[t * 128 + e] = o;
        }
        __syncthreads();
        for (int r = wave; r < DCH; r += NWAVES) {
            const size_t row = (size_t)(rowbase + c0 + r);
            const float o0 = os[r * 128 + 2 * lane], o1 = os[r * 128 + 2 * lane + 1];
            const float ss = wave_sum(o0 * o0 + o1 * o1);
            const float rs = 1.f / sqrtf(ss * (1.f / 128.f) + LN_EPS);
            const unsigned zw = *(const unsigned*)(H + row * LDH + HZ + h * 128 + 2 * lane);
            const float y0 = o0 * rs * gn.x * silu_f(bflo(zw)), y1 = o1 * rs * gn.y * silu_f(bfhi(zw));
            *(unsigned*)(CAT + row * DM + 2048 + h * 128 + 2 * lane) = pk2(y0, y1);
        }
    }
    float* so = C.out + (prompt ? O_PDELTA : O_SDELTA) + ((size_t)(b * 16 + h) * 128 + part * 32) * 128 + e;
#pragma unroll
    for (int i = 0; i < 32; ++i) so[(size_t)i * 128] = S[i];
    __syncthreads();
}

__device__ __forceinline__ void vt_item(const Ctx& C, int item) {
    const bf16* H = (const bf16*)(C.ws + WS_H);
    LAS unsigned char* scr = C.lds + C.wave * 16384;
    int lane_ = C.lane; asm volatile("" : "+v"(lane_)); const int lane = lane_;
    bool prompt; int b, n, kt;
    if (item < NPB * 4 * 32) { prompt = true; b = item >> 7; n = (item >> 5) & 3; kt = item & 31; }
    else { prompt = false; const int j = item - NPB * 4 * 32; b = j / 68; n = (j % 68) / 17; kt = j % 17; }
    if (prompt || kt == 16) {
        const bf16* src = H + (size_t)(prompt ? b * PSEQ + kt * 64 + lane : NPROW + b * SSEQ + lane) * LDH + HV + n * 128;
#pragma unroll
        for (int c = 0; c < 16; ++c) *(LAS v4u*)(scr + lane * 256 + c * 16) = *(const v4u*)(src + c * 8);
    } else {
        const float* src = inp(C, I_CV) + ((size_t)(b * PAST + kt * 64 + lane) * 4 + n) * 128;
#pragma unroll
        for (int c = 0; c < 16; ++c) { const f32x4 x0 = *(const f32x4*)(src + c * 8), x1 = *(const f32x4*)(src + c * 8 + 4);
            v4u w; w.x = pk2(x0.x, x0.y); w.y = pk2(x0.z, x0.w); w.z = pk2(x1.x, x1.y); w.w = pk2(x1.z, x1.w); *(LAS v4u*)(scr + lane * 256 + c * 16) = w; }
    }
    LDS_WAIT(); asm volatile("" ::: "memory");
    bf16* VT = (bf16*)(C.out + (prompt ? OS_VTP : OS_VTS));
    const int ntile = prompt ? PSEQ / 64 : SLEN / 64;
#pragma unroll 4
    for (int c = 0; c < 16; ++c) {
        const int cid = lane + 64 * c, d = cid >> 3, kc = cid & 7;
        const LAS unsigned short* s = (const LAS unsigned short*)(scr + (kc * 8) * 256 + d * 2);
        v4u w;
        w.x = (unsigned)s[0 * 128] | ((unsigned)s[1 * 128] << 16); w.y = (unsigned)s[2 * 128] | ((unsigned)s[3 * 128] << 16);
        w.z = (unsigned)s[4 * 128] | ((unsigned)s[5 * 128] << 16); w.w = (unsigned)s[6 * 128] | ((unsigned)s[7 * 128] << 16);
        *(v4u*)(VT + ((size_t)(((b * 4 + n) * ntile + kt) * 128 + d)) * 64 + kc * 8) = w;
    }
    LDS_WAIT(); asm volatile("" ::: "memory");
}

typedef float f32x16 __attribute__((ext_vector_type(16)));
constexpr int A_LUT = 0, A_MSK = 16384, A_KS = 32768, A_VS = A_KS + 64 * 272, A_BUF = 2 * 64 * 272, A_END = A_KS + 2 * A_BUF;
static_assert(A_END <= RING_BYTES, "attention LDS map");
constexpr float LOG2E = 1.4426950408889634f;
__device__ __forceinline__ int t5_bucket(int rel) {
    const int n = rel < 0 ? -rel : rel; int bk;
    if (n < 8) bk = n; else bk = n < 12 ? 8 : n < 16 ? 9 : n < 23 ? 10 : n < 32 ? 11 : n < 46 ? 12 : n < 64 ? 13 : n < 91 ? 14 : 15;
    return (rel > 0 ? 16 : 0) + bk;
}
__device__ __forceinline__ void attn_lut(const Ctx& C) {
    LAS float* lut = (LAS float*)(C.lds + A_LUT);
    for (int i = C.tid; i < 16 * 256; i += NWAVES * 64) { const int head = i >> 8, rel = (i & 255) - 191; lut[i] = inp(C, I_RELB)[t5_bucket(rel) * 16 + head] * LOG2E; }
}
__device__ __forceinline__ float max3f(float a, float b, float c) { float r; asm("v_max3_f32 %0, %1, %2, %3" : "=v"(r) : "v"(a), "v"(b), "v"(c)); return r; }
#ifndef ATT_PP
#define ATT_PP 1
#endif
#ifndef ATT_DEFER
#define ATT_DEFER 8.f
#endif
#if !ATT_PP
__device__ __forceinline__ void attn_unit_seq(const Ctx& C, int item) {
    bool prompt; int b, c, n;
    if (item < 480) { prompt = true; c = 31 - (item >> 5); b = (item & 31) >> 2; n = item & 3; }
    else if (item < 608) { prompt = false; c = 0; const int j = item - 480; b = j >> 2; n = j & 3; }
    else { prompt = true; const int j = item - 608; c = 16 - (j >> 5); b = (j & 31) >> 2; n = j & 3; }
    const bf16* H = (const bf16*)(C.ws + WS_H); bf16* CAT = (bf16*)(C.ws + WS_CAT);
    int tid_ = C.tid; asm volatile("" : "+v"(tid_));
    const int tid = tid_, lane = tid & 63, wave = __builtin_amdgcn_readfirstlane(tid >> 6);
    const int row0 = prompt ? b * PSEQ + c * 64 : NPROW + b * SSEQ;
    const int past = prompt ? 0 : PAST, t0 = prompt ? c * 64 : 0;
    const int L = prompt ? (c + 1) * 64 : SLEN, nkt = L / 64;
    const int ntile = prompt ? PSEQ / 64 : SLEN / 64;
    LAS unsigned long long* MSK = (LAS unsigned long long*)(C.lds + A_MSK);
    LAS unsigned char* KS = C.lds + A_KS; LAS unsigned char* VS = C.lds + A_VS;
    const LAS float* LUT = (const LAS float*)(C.lds + A_LUT);
    __syncthreads();
    {
        const v4u* mg = (const v4u*)(C.out + OS_MSK + (size_t)row0 * 64);
        ((LAS v4u*)MSK)[tid] = mg[tid]; ((LAS v4u*)MSK)[tid + 512] = mg[tid + 512];
    }
    const int g = wave & 3, qh = wave >> 2, h = lane >> 5, l31 = lane & 31;
    const int ql = qh * 32 + l31, qpos = past + t0 + ql, qpos_min = past + t0 + qh * 32;
    const float SC2 = QSCALE * LOG2E;
    const int head = n * 4 + g;
    bf16x8 qf[8];
#pragma unroll
    for (int s = 0; s < 8; ++s) qf[s] = *(const bf16x8*)(H + (size_t)(row0 + ql) * LDH + HQ + head * 128 + 16 * s + 8 * h);
    f32x16 oacc[4];
#pragma unroll
    for (int db = 0; db < 4; ++db)
#pragma unroll
        for (int r = 0; r < 16; ++r) oacc[db][r] = 0.f;
    float m_run = -INFINITY, l_run = 0.f;
    const float bfar = inp(C, I_RELB)[15 * 16 + head] * LOG2E;
    const LAS float* lut = LUT + head * 256;
    v4u kreg[2], vreg[2];
    const unsigned koffH0 = (unsigned)(tid >> 4) * LDH + (unsigned)(tid & 15) * 8u, koffH1 = koffH0 + 32u * LDH;
    const unsigned koffC0 = (unsigned)(tid >> 4) * 512u + (unsigned)(tid & 15) * 8u, koffC1 = koffC0 + 32u * 512u;
#define ATT_LOAD(KT) do { const int kt_ = (KT); \
        if (prompt || kt_ == 16) { const bf16* kb_ = H + (size_t)(prompt ? b * PSEQ + kt_ * 64 : NPROW + b * SSEQ) * LDH + HK + n * 128; kreg[0] = *(const v4u*)(kb_ + koffH0); kreg[1] = *(const v4u*)(kb_ + koffH1); } \
        else { const float* cb_ = inp(C, I_CK) + ((size_t)(b * PAST + kt_ * 64) * 4 + n) * 128; \
               const f32x4 x0 = *(const f32x4*)(cb_ + koffC0), x1 = *(const f32x4*)(cb_ + koffC0 + 4), y0 = *(const f32x4*)(cb_ + koffC1), y1 = *(const f32x4*)(cb_ + koffC1 + 4); \
               kreg[0].x = pk2(x0.x, x0.y); kreg[0].y = pk2(x0.z, x0.w); kreg[0].z = pk2(x1.x, x1.y); kreg[0].w = pk2(x1.z, x1.w); \
               kreg[1].x = pk2(y0.x, y0.y); kreg[1].y = pk2(y0.z, y0.w); kreg[1].z = pk2(y1.x, y1.y); kreg[1].w = pk2(y1.z, y1.w); } \
        if (prompt || kt_ == 16) { const bf16* vb_ = H + (size_t)(prompt ? b * PSEQ + kt_ * 64 : NPROW + b * SSEQ) * LDH + HV + n * 128; vreg[0] = *(const v4u*)(vb_ + koffH0); vreg[1] = *(const v4u*)(vb_ + koffH1); } \
        else { const float* cb_ = inp(C, I_CV) + ((size_t)(b * PAST + kt_ * 64) * 4 + n) * 128; \
               const f32x4 x0 = *(const f32x4*)(cb_ + koffC0), x1 = *(const f32x4*)(cb_ + koffC0 + 4), y0 = *(const f32x4*)(cb_ + koffC1), y1 = *(const f32x4*)(cb_ + koffC1 + 4); \
               vreg[0].x = pk2(x0.x, x0.y); vreg[0].y = pk2(x0.z, x0.w); vreg[0].z = pk2(x1.x, x1.y); vreg[0].w = pk2(x1.z, x1.w); \
               vreg[1].x = pk2(y0.x, y0.y); vreg[1].y = pk2(y0.z, y0.w); vreg[1].z = pk2(y1.x, y1.y); vreg[1].w = pk2(y1.z, y1.w); } } while (0)
    ATT_LOAD(0);
#pragma unroll 1
    for (int kt = 0; kt < nkt; ++kt) {
        __syncthreads();
#pragma unroll
        for (int i = 0; i < 2; ++i) { const int cid = tid + 512 * i;
            *(LAS v4u*)(KS + (cid >> 4) * 272 + (cid & 15) * 16) = kreg[i];
            *(LAS v4u*)(VS + (cid >> 4) * 272 + (cid & 15) * 16) = vreg[i]; }
        __syncthreads();
        if (kt + 1 < nkt) ATT_LOAD(kt + 1);
        f32x16 s0, s1;
#pragma unroll
        for (int r = 0; r < 16; ++r) { s0[r] = 0.f; s1[r] = 0.f; }
        {
            const unsigned kaddr = (unsigned)(size_t)(KS + l31 * 272 + 16 * h);
            asm volatile("" ::: "memory");
#pragma unroll
            for (int s4 = 0; s4 < 2; ++s4) {
                bf16x8 kA[4], kB[4];
#pragma unroll
                for (int s = 0; s < 4; ++s) { DS_RD128(kA[s], kaddr, 32 * (4 * s4 + s)); DS_RD128(kB[s], kaddr, 32 * 272 + 32 * (4 * s4 + s)); }
                asm volatile("s_waitcnt lgkmcnt(0)" : "+v"(kA[0]), "+v"(kA[1]), "+v"(kA[2]), "+v"(kA[3]), "+v"(kB[0]), "+v"(kB[1]), "+v"(kB[2]), "+v"(kB[3]));
#pragma unroll
                for (int s = 0; s < 4; ++s) {
                    s0 = __builtin_amdgcn_mfma_f32_32x32x16_bf16(kA[s], qf[4 * s4 + s], s0, 0, 0, 0);
                    s1 = __builtin_amdgcn_mfma_f32_32x32x16_bf16(kB[s], qf[4 * s4 + s], s1, 0, 0, 0);
                }
            }
        }
        asm volatile("s_nop 7\n\ts_nop 7\n\ts_nop 3" : "+v"(s0), "+v"(s1));
        const unsigned long long mw = MSK[ql * 32 + kt];
        const unsigned wlo = (unsigned)mw >> (4 * h), whi = (unsigned)(mw >> 32) >> (4 * h);
        const bool far = (kt * 64 + 63 - qpos_min) <= -91;
        float mx;
        if (far) {
            float a = max3f(s0[0], s0[1], s0[2]), bq = max3f(s1[0], s1[1], s1[2]);
#pragma unroll
            for (int r = 3; r < 15; r += 2) { a = max3f(a, s0[r], s0[r + 1]); bq = max3f(bq, s1[r], s1[r + 1]); }
            mx = fmaf(max3f(a, bq, fmaxf(s0[15], s1[15])), SC2, bfar);
        } else {
            const int relb0 = kt * 64 + 4 * h - qpos + 191;
#pragma unroll
            for (int r = 0; r < 16; ++r) { const int cr = (r & 3) + 8 * (r >> 2);
                s0[r] = fmaf(s0[r], SC2, lut[relb0 + cr]); s1[r] = fmaf(s1[r], SC2, lut[relb0 + 32 + cr]); }
            float a = max3f(s0[0], s0[1], s0[2]), bq = max3f(s1[0], s1[1], s1[2]);
#pragma unroll
            for (int r = 3; r < 15; r += 2) { a = max3f(a, s0[r], s0[r + 1]); bq = max3f(bq, s1[r], s1[r + 1]); }
            mx = max3f(a, bq, fmaxf(s0[15], s1[15]));
        }
        mx = fmaxf(mx, __shfl_xor(mx, 32));
        float m_new = m_run;
        if (__any(mx > m_run + ATT_DEFER)) {
            m_new = fmaxf(m_run, mx);
            const float alpha = __builtin_amdgcn_exp2f(m_run - m_new);
            l_run *= alpha;
#pragma unroll
            for (int db = 0; db < 4; ++db)
#pragma unroll
                for (int r = 0; r < 16; ++r) oacc[db][r] *= alpha;
        }
        m_run = m_new;
        const float sc = far ? SC2 : 1.f, sb = far ? bfar - m_new : -m_new;
        float psum = 0.f;
#pragma unroll
        for (int r = 0; r < 16; ++r) { const int cr = (r & 3) + 8 * (r >> 2);
            const float p0 = __builtin_amdgcn_exp2f(fmaf(s0[r], sc, sb)), p1 = __builtin_amdgcn_exp2f(fmaf(s1[r], sc, sb));
            unsigned m0, m1;
            asm("v_bfe_i32 %0, %1, %c2, 1" : "=v"(m0) : "v"(wlo), "i"(cr)); asm("v_bfe_i32 %0, %1, %c2, 1" : "=v"(m1) : "v"(whi), "i"(cr));
            s0[r] = __uint_as_float(__float_as_uint(p0) & m0); s1[r] = __uint_as_float(__float_as_uint(p1) & m1);
            psum += s0[r] + s1[r]; }
        l_run += psum;
        bf16x8 pb[2][2];
#pragma unroll
        for (int s = 0; s < 2; ++s) {
            v4u w0, w1;
            w0.x = pk2(s0[8 * s + 0], s0[8 * s + 1]); w0.y = pk2(s0[8 * s + 2], s0[8 * s + 3]); w0.z = pk2(s0[8 * s + 4], s0[8 * s + 5]); w0.w = pk2(s0[8 * s + 6], s0[8 * s + 7]);
            w1.x = pk2(s1[8 * s + 0], s1[8 * s + 1]); w1.y = pk2(s1[8 * s + 2], s1[8 * s + 3]); w1.z = pk2(s1[8 * s + 4], s1[8 * s + 5]); w1.w = pk2(s1[8 * s + 6], s1[8 * s + 7]);
            pb[0][s] = __builtin_bit_cast(bf16x8, w0); pb[1][s] = __builtin_bit_cast(bf16x8, w1);
        }
        {
            const unsigned vaddr = (unsigned)(size_t)(VS + (4 * h + ((lane & 15) >> 2)) * 272 + (16 * ((lane >> 4) & 1) + 4 * (lane & 3)) * 2);
#pragma unroll
            for (int d2 = 0; d2 < 2; ++d2) {
                v2u vlo[8], vhi[8];
#pragma unroll
                for (int dd = 0; dd < 2; ++dd)
#pragma unroll
                    for (int ks = 0; ks < 4; ++ks) { DS_RDTR(vlo[dd * 4 + ks], vaddr, ks * 4352 + (2 * d2 + dd) * 64); DS_RDTR(vhi[dd * 4 + ks], vaddr, ks * 4352 + 2176 + (2 * d2 + dd) * 64); }
                asm volatile("s_waitcnt lgkmcnt(0)" : "+v"(vlo[0]), "+v"(vlo[1]), "+v"(vlo[2]), "+v"(vlo[3]), "+v"(vlo[4]), "+v"(vlo[5]), "+v"(vlo[6]), "+v"(vlo[7]),
                                                      "+v"(vhi[0]), "+v"(vhi[1]), "+v"(vhi[2]), "+v"(vhi[3]), "+v"(vhi[4]), "+v"(vhi[5]), "+v"(vhi[6]), "+v"(vhi[7]));
#pragma unroll
                for (int dd = 0; dd < 2; ++dd)
#pragma unroll
                    for (int ks = 0; ks < 4; ++ks) {
                        const bf16x8 a = __builtin_bit_cast(bf16x8, (v4u){vlo[dd * 4 + ks].x, vlo[dd * 4 + ks].y, vhi[dd * 4 + ks].x, vhi[dd * 4 + ks].y});
                        oacc[2 * d2 + dd] = __builtin_amdgcn_mfma_f32_32x32x16_bf16(a, pb[ks >> 1][ks & 1], oacc[2 * d2 + dd], 0, 0, 0);
                    }
            }
        }
    }
#undef ATT_LOAD
    const float inv = 1.f / (l_run + __shfl_xor(l_run, 32));
    bf16* op = CAT + (size_t)(row0 + ql) * DM + head * 128 + 4 * h;
#pragma unroll
    for (int db = 0; db < 4; ++db)
#pragma unroll
        for (int q4 = 0; q4 < 4; ++q4) {
#if MIX_FP8
            *(unsigned*)((unsigned char*)CAT + (size_t)(row0 + ql) * DM + head * 128 + 4 * h + 32 * db + 8 * q4) = pk4_fp8(oacc[db][4 * q4 + 0] * (inv * CAT_Q), oacc[db][4 * q4 + 1] * (inv * CAT_Q), oacc[db][4 * q4 + 2] * (inv * CAT_Q), oacc[db][4 * q4 + 3] * (inv * CAT_Q));
#else
            v2u w; w.x = pk2(oacc[db][4 * q4 + 0] * inv, oacc[db][4 * q4 + 1] * inv); w.y = pk2(oacc[db][4 * q4 + 2] * inv, oacc[db][4 * q4 + 3] * inv);
            *(v2u*)(op + 32 * db + 8 * q4) = w;
#endif
        }
}
#define attn_unit attn_unit_seq
#else
__device__ __forceinline__ void attn_unit(const Ctx& C, int item) {
    bool prompt; int b, c, n;
    if (item < 480) { prompt = true; c = 31 - (item >> 5); b = (item & 31) >> 2; n = item & 3; }
    else if (item < 608) { prompt = false; c = 0; const int j = item - 480; b = j >> 2; n = j & 3; }
    else { prompt = true; const int j = item - 608; c = 16 - (j >> 5); b = (j & 31) >> 2; n = j & 3; }
    const bf16* H = (const bf16*)(C.ws + WS_H); bf16* CAT = (bf16*)(C.ws + WS_CAT);
    int tid_ = C.tid; asm volatile("" : "+v"(tid_));
    const int tid = tid_, lane = tid & 63, wave = __builtin_amdgcn_readfirstlane(tid >> 6);
    const int row0 = prompt ? b * PSEQ + c * 64 : NPROW + b * SSEQ;
    const int past = prompt ? 0 : PAST, t0 = prompt ? c * 64 : 0;
    const int L = prompt ? (c + 1) * 64 : SLEN, nkt = L / 64;
    const int ntile = prompt ? PSEQ / 64 : SLEN / 64;
    LAS unsigned long long* MSK = (LAS unsigned long long*)(C.lds + A_MSK);
    LAS unsigned char* KS = C.lds + A_KS; LAS unsigned char* VS = C.lds + A_VS;
    const LAS float* LUT = (const LAS float*)(C.lds + A_LUT);
    __syncthreads();
    {
        const v4u* mg = (const v4u*)(C.out + OS_MSK + (size_t)row0 * 64);
        ((LAS v4u*)MSK)[tid] = mg[tid]; ((LAS v4u*)MSK)[tid + 512] = mg[tid + 512];
    }
    const int g = wave & 3, qh = wave >> 2, h = lane >> 5, l31 = lane & 31;
    const int ql = qh * 32 + l31, qpos = past + t0 + ql, qpos_min = past + t0 + qh * 32;
    const float SC2 = QSCALE * LOG2E;
    const int head = n * 4 + g;
    bf16x8 qf[8];
#pragma unroll
    for (int s = 0; s < 8; ++s) qf[s] = *(const bf16x8*)(H + (size_t)(row0 + ql) * LDH + HQ + head * 128 + 16 * s + 8 * h);
    f32x16 oacc[4];
#pragma unroll
    for (int db = 0; db < 4; ++db)
#pragma unroll
        for (int r = 0; r < 16; ++r) oacc[db][r] = 0.f;
    float m_run = -INFINITY, l_run = 0.f;
    const float bfar = inp(C, I_RELB)[15 * 16 + head] * LOG2E;
    const LAS float* lut = LUT + head * 256;
    v4u kreg[2], vreg[2];
    const unsigned koffH0 = (unsigned)(tid >> 4) * LDH + (unsigned)(tid & 15) * 8u, koffH1 = koffH0 + 32u * LDH;
    const unsigned koffC0 = (unsigned)(tid >> 4) * 512u + (unsigned)(tid & 15) * 8u, koffC1 = koffC0 + 32u * 512u;
#define ATT_LOADK(KT) do { const int kt_ = (KT); \
        if (prompt || kt_ == 16) { const bf16* kb_ = H + (size_t)(prompt ? b * PSEQ + kt_ * 64 : NPROW + b * SSEQ) * LDH + HK + n * 128; kreg[0] = *(const v4u*)(kb_ + koffH0); kreg[1] = *(const v4u*)(kb_ + koffH1); } \
        else { const float* cb_ = inp(C, I_CK) + ((size_t)(b * PAST + kt_ * 64) * 4 + n) * 128; \
               const f32x4 x0 = *(const f32x4*)(cb_ + koffC0), x1 = *(const f32x4*)(cb_ + koffC0 + 4), y0 = *(const f32x4*)(cb_ + koffC1), y1 = *(const f32x4*)(cb_ + koffC1 + 4); \
               kreg[0].x = pk2(x0.x, x0.y); kreg[0].y = pk2(x0.z, x0.w); kreg[0].z = pk2(x1.x, x1.y); kreg[0].w = pk2(x1.z, x1.w); \
               kreg[1].x = pk2(y0.x, y0.y); kreg[1].y = pk2(y0.z, y0.w); kreg[1].z = pk2(y1.x, y1.y); kreg[1].w = pk2(y1.z, y1.w); } } while (0)
#define ATT_LOADV(KT) do { const int kt_ = (KT); \
        if (prompt || kt_ == 16) { const bf16* vb_ = H + (size_t)(prompt ? b * PSEQ + kt_ * 64 : NPROW + b * SSEQ) * LDH + HV + n * 128; vreg[0] = *(const v4u*)(vb_ + koffH0); vreg[1] = *(const v4u*)(vb_ + koffH1); } \
        else { const float* cb_ = inp(C, I_CV) + ((size_t)(b * PAST + kt_ * 64) * 4 + n) * 128; \
               const f32x4 x0 = *(const f32x4*)(cb_ + koffC0), x1 = *(const f32x4*)(cb_ + koffC0 + 4), y0 = *(const f32x4*)(cb_ + koffC1), y1 = *(const f32x4*)(cb_ + koffC1 + 4); \
               vreg[0].x = pk2(x0.x, x0.y); vreg[0].y = pk2(x0.z, x0.w); vreg[0].z = pk2(x1.x, x1.y); vreg[0].w = pk2(x1.z, x1.w); \
               vreg[1].x = pk2(y0.x, y0.y); vreg[1].y = pk2(y0.z, y0.w); vreg[1].z = pk2(y1.x, y1.y); vreg[1].w = pk2(y1.z, y1.w); } } while (0)
    f32x16 s0, s1; bf16x8 pb[2][2];
    auto STK = [&](const int slot) __attribute__((always_inline)) {
#pragma unroll
        for (int i = 0; i < 2; ++i) { const int cid = tid + 512 * i; *(LAS v4u*)(KS + slot * A_BUF + (cid >> 4) * 272 + (cid & 15) * 16) = kreg[i]; } };
    auto STV = [&](const int slot) __attribute__((always_inline)) {
#pragma unroll
        for (int i = 0; i < 2; ++i) { const int cid = tid + 512 * i; *(LAS v4u*)(VS + slot * A_BUF + (cid >> 4) * 272 + (cid & 15) * 16) = vreg[i]; } };
    auto QK = [&](const int kt) __attribute__((always_inline)) {
        LAS unsigned char* KSk = KS + (kt & 1) * A_BUF;
#pragma unroll
        for (int r = 0; r < 16; ++r) { s0[r] = 0.f; s1[r] = 0.f; }
        {
            const unsigned kaddr = (unsigned)(size_t)(KSk + l31 * 272 + 16 * h);
            asm volatile("" ::: "memory");
#pragma unroll
            for (int s4 = 0; s4 < 2; ++s4) {
                bf16x8 kA[4], kB[4];
#pragma unroll
                for (int s = 0; s < 4; ++s) { DS_RD128(kA[s], kaddr, 32 * (4 * s4 + s)); DS_RD128(kB[s], kaddr, 32 * 272 + 32 * (4 * s4 + s)); }
                asm volatile("s_waitcnt lgkmcnt(0)" : "+v"(kA[0]), "+v"(kA[1]), "+v"(kA[2]), "+v"(kA[3]), "+v"(kB[0]), "+v"(kB[1]), "+v"(kB[2]), "+v"(kB[3]));
#pragma unroll
                for (int s = 0; s < 4; ++s) {
                    s0 = __builtin_amdgcn_mfma_f32_32x32x16_bf16(kA[s], qf[4 * s4 + s], s0, 0, 0, 0);
                    s1 = __builtin_amdgcn_mfma_f32_32x32x16_bf16(kB[s], qf[4 * s4 + s], s1, 0, 0, 0);
                }
            }
        }
        asm volatile("s_nop 7\n\ts_nop 7\n\ts_nop 3" : "+v"(s0), "+v"(s1));
    };
    auto SM = [&](const int kt) __attribute__((always_inline)) {
        const unsigned long long mw = MSK[ql * 32 + kt];
        const unsigned wlo = (unsigned)mw >> (4 * h), whi = (unsigned)(mw >> 32) >> (4 * h);
        const bool far = (kt * 64 + 63 - qpos_min) <= -91;
        float mx;
        if (far) {
            float a = max3f(s0[0], s0[1], s0[2]), bq = max3f(s1[0], s1[1], s1[2]);
#pragma unroll
            for (int r = 3; r < 15; r += 2) { a = max3f(a, s0[r], s0[r + 1]); bq = max3f(bq, s1[r], s1[r + 1]); }
            mx = fmaf(max3f(a, bq, fmaxf(s0[15], s1[15])), SC2, bfar);
        } else {
            const int relb0 = kt * 64 + 4 * h - qpos + 191;
#pragma unroll
            for (int r = 0; r < 16; ++r) { const int cr = (r & 3) + 8 * (r >> 2);
                s0[r] = fmaf(s0[r], SC2, lut[relb0 + cr]); s1[r] = fmaf(s1[r], SC2, lut[relb0 + 32 + cr]); }
            float a = max3f(s0[0], s0[1], s0[2]), bq = max3f(s1[0], s1[1], s1[2]);
#pragma unroll
            for (int r = 3; r < 15; r += 2) { a = max3f(a, s0[r], s0[r + 1]); bq = max3f(bq, s1[r], s1[r + 1]); }
            mx = max3f(a, bq, fmaxf(s0[15], s1[15]));
        }
        mx = fmaxf(mx, __shfl_xor(mx, 32));
        float m_new = m_run;
        if (__any(mx > m_run + ATT_DEFER)) {
            m_new = fmaxf(m_run, mx);
            const float alpha = __builtin_amdgcn_exp2f(m_run - m_new);
            l_run *= alpha;
#pragma unroll
            for (int db = 0; db < 4; ++db)
#pragma unroll
                for (int r = 0; r < 16; ++r) oacc[db][r] *= alpha;
        }
        m_run = m_new;
        const float sc = far ? SC2 : 1.f, sb = far ? bfar - m_new : -m_new;
        float psum = 0.f;
#pragma unroll
        for (int r = 0; r < 16; ++r) { const int cr = (r & 3) + 8 * (r >> 2);
            const float p0 = __builtin_amdgcn_exp2f(fmaf(s0[r], sc, sb)), p1 = __builtin_amdgcn_exp2f(fmaf(s1[r], sc, sb));
            unsigned m0, m1;
            asm("v_bfe_i32 %0, %1, %c2, 1" : "=v"(m0) : "v"(wlo), "i"(cr)); asm("v_bfe_i32 %0, %1, %c2, 1" : "=v"(m1) : "v"(whi), "i"(cr));
            s0[r] = __uint_as_float(__float_as_uint(p0) & m0); s1[r] = __uint_as_float(__float_as_uint(p1) & m1);
            psum += s0[r] + s1[r]; }
        l_run += psum;
#pragma unroll
        for (int s = 0; s < 2; ++s) {
            v4u w0, w1;
            w0.x = pk2(s0[8 * s + 0], s0[8 * s + 1]); w0.y = pk2(s0[8 * s + 2], s0[8 * s + 3]); w0.z = pk2(s0[8 * s + 4], s0[8 * s + 5]); w0.w = pk2(s0[8 * s + 6], s0[8 * s + 7]);
            w1.x = pk2(s1[8 * s + 0], s1[8 * s + 1]); w1.y = pk2(s1[8 * s + 2], s1[8 * s + 3]); w1.z = pk2(s1[8 * s + 4], s1[8 * s + 5]); w1.w = pk2(s1[8 * s + 6], s1[8 * s + 7]);
            pb[0][s] = __builtin_bit_cast(bf16x8, w0); pb[1][s] = __builtin_bit_cast(bf16x8, w1);
        }
    };
    auto PV = [&](const int kt) __attribute__((always_inline)) {
        LAS unsigned char* VSk = VS + (kt & 1) * A_BUF;
        {
            const unsigned vaddr = (unsigned)(size_t)(VSk + (4 * h + ((lane & 15) >> 2)) * 272 + (16 * ((lane >> 4) & 1) + 4 * (lane & 3)) * 2);
#pragma unroll
            for (int d2 = 0; d2 < 2; ++d2) {
                v2u vlo[8], vhi[8];
#pragma unroll
                for (int dd = 0; dd < 2; ++dd)
#pragma unroll
                    for (int ks = 0; ks < 4; ++ks) { DS_RDTR(vlo[dd * 4 + ks], vaddr, ks * 4352 + (2 * d2 + dd) * 64); DS_RDTR(vhi[dd * 4 + ks], vaddr, ks * 4352 + 2176 + (2 * d2 + dd) * 64); }
                asm volatile("s_waitcnt lgkmcnt(0)" : "+v"(vlo[0]), "+v"(vlo[1]), "+v"(vlo[2]), "+v"(vlo[3]), "+v"(vlo[4]), "+v"(vlo[5]), "+v"(vlo[6]), "+v"(vlo[7]),
                                                      "+v"(vhi[0]), "+v"(vhi[1]), "+v"(vhi[2]), "+v"(vhi[3]), "+v"(vhi[4]), "+v"(vhi[5]), "+v"(vhi[6]), "+v"(vhi[7]));
#pragma unroll
                for (int dd = 0; dd < 2; ++dd)
#pragma unroll
                    for (int ks = 0; ks < 4; ++ks) {
                        const bf16x8 a = __builtin_bit_cast(bf16x8, (v4u){vlo[dd * 4 + ks].x, vlo[dd * 4 + ks].y, vhi[dd * 4 + ks].x, vhi[dd * 4 + ks].y});
                        oacc[2 * d2 + dd] = __builtin_amdgcn_mfma_f32_32x32x16_bf16(a, pb[ks >> 1][ks & 1], oacc[2 * d2 + dd], 0, 0, 0);
                    }
            }
        }
    };
    ATT_LOADK(0); STK(0);
    ATT_LOADK(nkt > 1 ? 1 : 0); ATT_LOADV(0);
#define ATT_STAGE(t) do { if ((t) + 1 < nkt) STK(((t) + 1) & 1); STV((t) & 1); if ((t) + 2 < nkt) ATT_LOADK((t) + 2); if ((t) + 1 < nkt) ATT_LOADV((t) + 1); } while (0)
    if (qh == 0) {
#pragma unroll 1
        for (int t = 0; t < nkt; ++t) {
            __syncthreads(); ATT_STAGE(t);
            __builtin_amdgcn_s_setprio(2);
            if (t > 0) PV(t - 1);
            QK(t);
            __builtin_amdgcn_s_setprio(0);
            __syncthreads();
            SM(t);
        }
        __syncthreads();
        PV(nkt - 1);
        __syncthreads();
    } else {
#pragma unroll 1
        for (int t = 0; t < nkt; ++t) {
            __syncthreads(); ATT_STAGE(t);
            if (t > 0) SM(t - 1);
            __syncthreads();
            __builtin_amdgcn_s_setprio(2);
            if (t > 0) PV(t - 1);
            QK(t);
            __builtin_amdgcn_s_setprio(0);
        }
        __syncthreads();
        SM(nkt - 1);
        __syncthreads();
        PV(nkt - 1);
    }
#undef ATT_STAGE
#undef ATT_LOADK
#undef ATT_LOADV
    const float inv = 1.f / (l_run + __shfl_xor(l_run, 32));
    bf16* op = CAT + (size_t)(row0 + ql) * DM + head * 128 + 4 * h;
#pragma unroll
    for (int db = 0; db < 4; ++db)
#pragma unroll
        for (int q4 = 0; q4 < 4; ++q4) {
#if MIX_FP8
            *(unsigned*)((unsigned char*)CAT + (size_t)(row0 + ql) * DM + head * 128 + 4 * h + 32 * db + 8 * q4) = pk4_fp8(oacc[db][4 * q4 + 0] * (inv * CAT_Q), oacc[db][4 * q4 + 1] * (inv * CAT_Q), oacc[db][4 * q4 + 2] * (inv * CAT_Q), oacc[db][4 * q4 + 3] * (inv * CAT_Q));
#else
            v2u w; w.x = pk2(oacc[db][4 * q4 + 0] * inv, oacc[db][4 * q4 + 1] * inv); w.y = pk2(oacc[db][4 * q4 + 2] * inv, oacc[db][4 * q4 + 3] * inv);
            *(v2u*)(op + 32 * db + 8 * q4) = w;
#endif
        }
}
#endif

__device__ __forceinline__ void phase5(const Ctx& C) {
    LAS float* scr = (LAS float*)(C.lds + C.wave * 16384);
    const int gw = C.bid * NWAVES + C.wave, NGW = C.G * NWAVES;
    bf16* WupT = (bf16*)(C.ws + WS_WUP); bf16* WdnT = (bf16*)(C.ws + WS_WDN); bf16* X1 = (bf16*)(C.ws + WS_XN);
    { LnP P; ln_params(P, inp(C, I_LN1G), inp(C, I_LN1B), C.lane);
#pragma unroll 1
      for (int m = gw; m < MTOK; m += NGW) ln_row<false, true, true>((const bf16*)(C.ws + WS_PRE1) + (size_t)m * DM, P, X1 + (size_t)m * LDX, C.lane, (const unsigned*)(C.ctl + CW_TIX2) + (m >> 8) * 16, (const float*)(C.ws + WS_P2), m & 255); }
#if defined(PROBE_DUP) && PROBE_DUP == 9
    { LnP P; ln_params(P, inp(C, I_LN1G), inp(C, I_LN1B), C.lane);
#pragma unroll 1
      for (int m = gw; m < MTOK; m += NGW) ln_row<false, true, true>((const bf16*)(C.ws + WS_PRE1) + (size_t)m * DM, P, X1 + (size_t)m * LDX, C.lane, (const unsigned*)(C.ctl + CW_TIX2) + (m >> 8) * 16, (const float*)(C.ws + WS_P2), m & 255); }
#endif
    constexpr int I_UP = (DM / 64) * (DFF2 / 32), I_DN = (DFF / 64) * (DM / 32);
#if !WUP_EARLY
    transpose_static<2>(inp(C, I_WUP), DM, DFF2, WupT, I_UP, scr, gw, NGW, C.lane); (void)WdnT; (void)I_DN;
#else
    (void)scr; (void)WupT; (void)WdnT; (void)I_UP; (void)I_DN;
#endif
}
__device__ __forceinline__ void ffn_fixup(const Ctx& C) {
    const bf16* UPS = (const bf16*)(C.ws + WS_UPS); bf16* ACT = (bf16*)(C.ws + WS_ACT);
    const float* fw = inp(C, I_FCW); const float* fb = inp(C, I_FCB); const float* st = inp(C, I_SFFN);
    const int gt = C.bid * (NWAVES * 64) + C.tid, NGT = C.G * NWAVES * 64;
    for (int it = gt; it < 576 * (DFF / 4); it += NGT) {
        const int ri = it / (DFF / 4), j = (it % (DFF / 4)) * 4, blk = ri >> 1, w = ri & 1, row = blk * 64 + w;
        const bool prompt = row < NPROW; const int r2 = row - NPROW;
        const int b = prompt ? (row >> 11) : (r2 >> 6), t = prompt ? (row & 2047) : (r2 & 63);
        f32x4 g[3], v[3];
        v2u ua[3], uc[3]; f32x4 sg[3], sv[3];
#pragma unroll
        for (int k = 0; k < 3; ++k) {
            const int dt = k - 2, tt = t + dt;
            const int rr = max(row + dt, 0), bb = rr >> 6, idx = ((rr & 63) + 2) & 63;
            ua[k] = *(const v2u*)(UPS + (size_t)(bb * 4 + idx) * DFF2 + j); uc[k] = *(const v2u*)(UPS + (size_t)(bb * 4 + idx) * DFF2 + DFF + j);
            const int si = min(max(2 + tt, 0), 1), bs = prompt ? 0 : b;
            sg[k] = *(const f32x4*)(st + (size_t)(bs * 2 + si) * DFF2 + j); sv[k] = *(const f32x4*)(st + (size_t)(bs * 2 + si) * DFF2 + DFF + j);
        }
        asm volatile("" : "+v"(ua[0]), "+v"(ua[1]), "+v"(ua[2]), "+v"(uc[0]), "+v"(uc[1]), "+v"(uc[2]), "+v"(sg[0]), "+v"(sg[1]), "+v"(sg[2]), "+v"(sv[0]), "+v"(sv[1]), "+v"(sv[2]));
#pragma unroll
        for (int k = 0; k < 3; ++k) {
            const int tt = t + k - 2;
            const float ks = (tt < 0 && !prompt) ? 1.f : 0.f;
            const f32x4 gu = (f32x4){bflo(ua[k].x), bfhi(ua[k].x), bflo(ua[k].y), bfhi(ua[k].y)}, vu = (f32x4){bflo(uc[k].x), bfhi(uc[k].x), bflo(uc[k].y), bfhi(uc[k].y)};
            g[k] = tt >= 0 ? gu : sg[k] * ks; v[k] = tt >= 0 ? vu : sv[k] * ks;
        }
        f32x4 G = *(const f32x4*)(fb + j), V = *(const f32x4*)(fb + DFF + j);
#pragma unroll
        for (int k = 0; k < 3; ++k) { G += *(const f32x4*)(fw + (size_t)k * DFF2 + j) * g[k]; V += *(const f32x4*)(fw + (size_t)k * DFF2 + DFF + j) * v[k]; }
#if FFN_DOWN_FP8
        *(unsigned*)((unsigned char*)ACT + (size_t)row * DFF + j) = pk4_fp8(silu_f(G.x) * V.x * ACT_Q, silu_f(G.y) * V.y * ACT_Q, silu_f(G.z) * V.z * ACT_Q, silu_f(G.w) * V.w * ACT_Q);
#else
        v2u o; o.x = pk2(silu_f(G.x) * V.x, silu_f(G.y) * V.y); o.y = pk2(silu_f(G.z) * V.z, silu_f(G.w) * V.w);
        *(v2u*)(ACT + (size_t)row * DFF + j) = o;
#endif
    }
}

__device__ __forceinline__ int crow16(int r, int h) { return (r & 3) + 8 * (r >> 2) + 4 * h; }
__device__ __forceinline__ bf16x8 pack8(float a0, float a1, float a2, float a3, float a4, float a5, float a6, float a7) {
    v4u w; w.x = pk2(a0, a1); w.y = pk2(a2, a3); w.z = pk2(a4, a5); w.w = pk2(a6, a7); return __builtin_bit_cast(bf16x8, w);
}
typedef short v4i16_t __attribute__((ext_vector_type(4)));
__device__ __forceinline__ v2u tr4(LAS unsigned char* tile, int row0, int col0, int lane) {
    const int q = (lane & 15) >> 2, p = lane & 3, blk = (lane >> 4) & 1;
    const v4i16_t r = __builtin_amdgcn_ds_read_tr16_b64_v4i16((LAS v4i16_t*)(tile + (row0 + q) * 272 + (col0 + 16 * blk + 4 * p) * 2));
    return __builtin_bit_cast(v2u, r);
}

template <int SIDX> __device__ __forceinline__ void dprep_pass(const Ctx& C, const bf16* H, bf16* QKVC, const float* cw, const float* cb, const float* st, LAS unsigned char* tile, int R0, int t0, bool prompt, int b, int h, int lane) {
    const int cch = SIDX * 2048 + h * 128 + 2 * lane;
    const f32x2 w0 = *(const f32x2*)(cw + cch), w1 = *(const f32x2*)(cw + CQKV + cch), w2 = *(const f32x2*)(cw + 2 * CQKV + cch), w3 = *(const f32x2*)(cw + 3 * CQKV + cch), bi = *(const f32x2*)(cb + cch);
    f32x2 xm3, xm2, xm1;
    const int Rh = R0 >= 3 ? R0 - 3 : 0, bs = prompt ? 0 : b;
    unsigned ha = *(const unsigned*)(H + (size_t)Rh * LDH + HQKV + cch), hb = *(const unsigned*)(H + (size_t)(Rh + 1) * LDH + HQKV + cch), hc = *(const unsigned*)(H + (size_t)(Rh + 2) * LDH + HQKV + cch);
    f32x2 s3 = *(const f32x2*)(st + (size_t)(bs * 3 + 0) * CQKV + cch), s2 = *(const f32x2*)(st + (size_t)(bs * 3 + 1) * CQKV + cch), s1 = *(const f32x2*)(st + (size_t)(bs * 3 + 2) * CQKV + cch);
    const float post = SIDX == 0 ? QSCALE : 1.f;
    unsigned xws[32];
#pragma unroll
    for (int i = 0; i < 32; ++i) xws[i] = *(const unsigned*)(H + (size_t)(R0 + i) * LDH + HQKV + cch);
    asm volatile("" : "+v"(ha), "+v"(hb), "+v"(hc), "+v"(s3), "+v"(s2), "+v"(s1));
    {
        const bool fromH = t0 > 0; const float ks = (!fromH && !prompt) ? 1.f : 0.f;
        xm3 = fromH ? (f32x2){bflo(ha), bfhi(ha)} : s3 * ks; xm2 = fromH ? (f32x2){bflo(hb), bfhi(hb)} : s2 * ks; xm1 = fromH ? (f32x2){bflo(hc), bfhi(hc)} : s1 * ks;
    }
#pragma unroll
    for (int i0 = 0; i0 < 32; i0 += 8) {
        f32x2 y[8];
#pragma unroll
        for (int j = 0; j < 8; ++j) {
            const unsigned xw = xws[i0 + j];
            const f32x2 x0 = (f32x2){bflo(xw), bfhi(xw)};
            y[j] = bi + w0 * xm3 + w1 * xm2 + w2 * xm1 + w3 * x0;
            xm3 = xm2; xm2 = xm1; xm1 = x0;
        }
#pragma unroll
        for (int j = 0; j < 8; ++j) { y[j].x = silu_f(y[j].x); y[j].y = silu_f(y[j].y); }
        if (SIDX < 2) {
            float ss[8];
#pragma unroll
            for (int j = 0; j < 8; ++j) ss[j] = wave_sum(y[j].x * y[j].x + y[j].y * y[j].y);
#pragma unroll
            for (int j = 0; j < 8; ++j) { const float sc = post * __builtin_amdgcn_rsqf(ss[j] + 1e-6f); y[j].x *= sc; y[j].y *= sc; }
        }
#pragma unroll
        for (int j = 0; j < 8; ++j) {
            const unsigned pw = pk2(y[j].x, y[j].y);
            *(unsigned*)(QKVC + (size_t)(R0 + i0 + j) * CQKV + cch) = pw;
            if (SIDX < 2) *(LAS unsigned*)(tile + (i0 + j) * 272 + 4 * lane) = pw;
        }
    }
}

__device__ __forceinline__ void dprep_unit(const Ctx& C, int u, int lane_in, LAS unsigned char* scr, const int pmode = 0) {
    int lane = lane_in; asm volatile("" : "+v"(lane));
    const bool prompt = u < 8192; const int u2 = u - 8192;
    const int bh = prompt ? (u >> 6) : (u2 >> 1), c = prompt ? (u & 63) : (u2 & 1), b = bh >> 4, h = bh & 15;
    const int R0 = (prompt ? b * PSEQ : NPROW + b * SSEQ) + c * 32, t0 = c * 32;
    const bf16* H = (const bf16*)(C.ws + WS_H); bf16* QKVC = (bf16*)(C.ws + WS_QKVC);
    const float* SM = C.out + OS_SM;
    const float* cw = inp(C, I_CQW); const float* cb = inp(C, I_CQB); const float* st = inp(C, I_SCONV);
    LAS unsigned char* tile = scr;
    LAS float* LT = (LAS float*)(scr + 8704);
    LAS float* Gs = LT + 32 * 36;
    LAS float* Bs = Gs + 32;
    const int l31 = lane & 31, hh = lane >> 5;
    bf16x8 kf[8], qf[8];
    if (pmode != 2)
    dprep_pass<1>(C, H, QKVC, cw, cb, st, tile, R0, t0, prompt, b, h, lane);
#pragma unroll
    for (int s = 0; s < 8; ++s) kf[s] = *(const LAS bf16x8*)(tile + l31 * 272 + 32 * s + 16 * hh);
    LDS_WAIT(); asm volatile("" ::: "memory");
    if (pmode != 2)
    dprep_pass<0>(C, H, QKVC, cw, cb, st, tile, R0, t0, prompt, b, h, lane);
#pragma unroll
    for (int s = 0; s < 8; ++s) qf[s] = *(const LAS bf16x8*)(tile + l31 * 272 + 32 * s + 16 * hh);
    LDS_WAIT(); asm volatile("" ::: "memory");
    if (pmode != 2)
    dprep_pass<2>(C, H, QKVC, cw, cb, st, tile, R0, t0, prompt, b, h, lane);
    LDS_WAIT(); asm volatile("" ::: "memory");
    if (pmode == 1) return;
    const size_t grow = (size_t)(R0 + l31);
    const float Aexp = expf(inp(C, I_ALOG)[h]), dtb = inp(C, I_DTB)[h];
    const float xg = SM[grow * 128 + 96 + h] + dtb; const float sp = xg > 20.f ? xg : log1pf(expf(xg));
    float G = -Aexp * sp;
#pragma unroll
    for (int off = 1; off < 32; off <<= 1) { const float t = __shfl_up(G, off, 32); if (l31 >= off) G += t; }
    const float beta = 1.f / (1.f + expf(-SM[grow * 128 + 80 + h]));
    if (lane < 32) { Gs[lane] = G; Bs[lane] = beta; (C.out + OS_GB)[grow * 16 + h] = G; }
    f32x16 KK, KQ;
#pragma unroll
    for (int r = 0; r < 16; ++r) { KK[r] = 0.f; KQ[r] = 0.f; }
#pragma unroll
    for (int s = 0; s < 8; ++s) { KK = __builtin_amdgcn_mfma_f32_32x32x16_bf16(kf[s], kf[s], KK, 0, 0, 0); KQ = __builtin_amdgcn_mfma_f32_32x32x16_bf16(kf[s], qf[s], KQ, 0, 0, 0); }
    LDS_WAIT(); asm volatile("" ::: "memory");
    float mfv[16];
#pragma unroll
    for (int q4 = 0; q4 < 4; ++q4) {
        const f32x4 Gm = *(const LAS f32x4*)(Gs + 8 * q4 + 4 * hh), Bm = *(const LAS f32x4*)(Bs + 8 * q4 + 4 * hh);
        f32x4 lv;
#pragma unroll
        for (int e = 0; e < 4; ++e) {
            const int r = 4 * q4 + e, m = 8 * q4 + 4 * hh + e;
            lv[e] = (m > l31) ? Bm[e] * KK[r] * __expf(Gm[e] - G) : 0.f;
            mfv[r] = (l31 >= m) ? KQ[r] * __expf(G - Gm[e]) : 0.f;
        }
        *(LAS f32x4*)(LT + l31 * 36 + 8 * q4 + 4 * hh) = lv;
    }
    {
        float* mff = C.out + OS_MFF + (size_t)u * 512;
        *(bf16x8*)(mff + (0 * 64 + lane) * 4) = pack8(mfv[0], mfv[1], mfv[2], mfv[3], mfv[4], mfv[5], mfv[6], mfv[7]);
        *(bf16x8*)(mff + (1 * 64 + lane) * 4) = pack8(mfv[8], mfv[9], mfv[10], mfv[11], mfv[12], mfv[13], mfv[14], mfv[15]);
    }
    LDS_WAIT(); asm volatile("" ::: "memory");
    LAS float* Tm = (LAS float*)scr + l31 * 33;
    for (int j = 31; j >= 0; --j) {
        float p = 0.f;
        const LAS float* lrow = LT + j * 36;
#pragma unroll 4
        for (int i2 = j + 1 + hh; i2 < 32; i2 += 2) p += Tm[i2] * lrow[i2];
        const auto rr = __builtin_amdgcn_permlane32_swap(__float_as_uint(p), __float_as_uint(p), false, false);
        Tm[j] = ((l31 == j) ? 1.f : 0.f) - (__uint_as_float(rr[0]) + __uint_as_float(rr[1]));
    }
    const float eG = __expf(G);
    if (lane < 32) Gs[lane] = beta * eG;
    LDS_WAIT(); asm volatile("" ::: "memory");
    float* tbf = C.out + OS_TBF + (size_t)u * 512; float* tgf = C.out + OS_TGF + (size_t)u * 512;
#pragma unroll
    for (int s = 0; s < 2; ++s) {
        float a[8], g8[8];
#pragma unroll
        for (int jj = 0; jj < 8; ++jj) {
            const int jn = 16 * s + 8 * hh + jj;
            const int jk = 16 * s + 8 * (jj >> 2) + 4 * hh + (jj & 3);
            a[jj] = Tm[jn] * Bs[jn]; g8[jj] = Tm[jk] * Gs[jk];
        }
        *(bf16x8*)(tbf + (s * 64 + lane) * 4) = pack8(a[0], a[1], a[2], a[3], a[4], a[5], a[6], a[7]);
        *(bf16x8*)(tgf + (s * 64 + lane) * 4) = pack8(g8[0], g8[1], g8[2], g8[3], g8[4], g8[5], g8[6], g8[7]);
    }
    LDS_WAIT(); asm volatile("" ::: "memory");
}

constexpr int DS_BASE = 16384, DS_TILE = 32 * 272, DS_FR = 3 * DS_TILE, DS_SCL = DS_FR + 6144, DS_OB = DS_SCL + 320, DS_HALF = DS_OB + 32 * 132 * 4;
static_assert(DS_BASE + 2 * DS_HALF <= RING_BYTES && DS_HALF % 16 == 0, "dscan LDS map");
__device__ __forceinline__ void dscan_unit(const Ctx& C, int item, const int HOT = 0) {
    int tid_ = C.tid; asm volatile("" : "+v"(tid_));
    const int tid = tid_, lane = tid & 63, wave = __builtin_amdgcn_readfirstlane(tid >> 6);
    const bool prompt = item < 64;
    const int half = wave >> 2, eb = wave & 3, ht = tid & 255;
    const int bh = prompt ? item * 2 + half : (item - 64) * 2 + half, b = bh >> 4, h = bh & 15;
    const int nch = prompt ? 64 : 2, rowbase = prompt ? b * PSEQ : NPROW + b * SSEQ, ubase = prompt ? bh * 64 : 8192 + bh * 2;
    const bf16* H = (const bf16*)(C.ws + WS_H); const bf16* QKVC = (const bf16*)(C.ws + WS_QKVC); bf16* CAT = (bf16*)(C.ws + WS_CAT);
    LAS unsigned char* hb = C.lds + DS_BASE + half * DS_HALF;
    LAS unsigned char* QT = hb; LAS unsigned char* KT = hb + DS_TILE; LAS unsigned char* VT_ = hb + 2 * DS_TILE;
    LAS unsigned char* FR = hb + DS_FR; LAS float* SCL = (LAS float*)(hb + DS_SCL); LAS float* OB = (LAS float*)(hb + DS_OB);
    const int l31 = lane & 31, hh = lane >> 5;
    f32x16 S[4];
    if (prompt) {
#pragma unroll
        for (int db = 0; db < 4; ++db)
#pragma unroll
            for (int r = 0; r < 16; ++r) S[db][r] = 0.f;
    } else {
        const float* s0 = inp(C, I_SDELTA) + (size_t)bh * 128 * 128 + 32 * eb + l31;
#pragma unroll
        for (int db = 0; db < 4; ++db)
#pragma unroll
            for (int r = 0; r < 16; ++r) S[db][r] = s0[(size_t)(32 * db + crow16(r, hh)) * 128];
    }
    const f32x2 gn = *(const f32x2*)(inp(C, I_DNG) + 2 * lane);
    v4u sreg[8]; float gi = 0.f, gl_ = 0.f;
#define DS_REQ(CH) do { const int R0_ = rowbase + (HOT ? 0 : (CH)) * 32, u_ = ubase + (HOT ? 0 : (CH)); \
        const bf16* qb_ = QKVC + (size_t)R0_ * CQKV + h * 128; const float* fb_ = C.out + (size_t)u_ * 512;     \
        _Pragma("unroll") for (int k_ = 0; k_ < 6; ++k_) { const unsigned idx = (unsigned)ht + 256u * k_, which = idx >> 9, r = (idx & 511u) >> 4, pc = idx & 15u; \
            sreg[k_] = *(const v4u*)(qb_ + (r * (unsigned)CQKV + which * 2048u + pc * 8u)); } \
        _Pragma("unroll") for (int k_ = 0; k_ < 2; ++k_) { const unsigned idx = (unsigned)ht + 256u * k_; if (idx < 384u) { const unsigned f = idx >> 7, rest = idx & 127u; \
            sreg[6 + k_] = *(const v4u*)(fb_ + ((f == 0 ? OS_TBF : f == 1 ? OS_TGF : OS_MFF) + rest * 4u)); } } \
        if (ht < 32) { const float* gb = C.out + OS_GB + (size_t)R0_ * 16 + h; gi = gb[ht * 16]; gl_ = gb[31 * 16]; } } while (0)
    DS_REQ(0);
#pragma unroll 1
    for (int ch = 0; ch < nch; ++ch) {
        const int R0 = rowbase + ch * 32;
#pragma unroll
        for (int k_ = 0; k_ < 6; ++k_) { const int idx = ht + 256 * k_, which = idx >> 9, r = (idx & 511) >> 4, pc = idx & 15; *(LAS v4u*)(hb + which * DS_TILE + r * 272 + pc * 16) = sreg[k_]; }
#pragma unroll
        for (int k_ = 0; k_ < 2; ++k_) { const int idx = ht + 256 * k_; if (idx < 384) *(LAS v4u*)(FR + idx * 16) = sreg[6 + k_]; }
        if (ht < 32) { SCL[ht] = __expf(gi); SCL[32 + ht] = __expf(gl_ - gi); if (ht == 0) SCL[64] = __expf(gl_); }
        __syncthreads();
        if (ch + 1 < nch) DS_REQ(ch + 1);
        f32x16 un;
#pragma unroll
        for (int r = 0; r < 16; ++r) un[r] = 0.f;
        {
            const bf16x8 tb0 = *(const LAS bf16x8*)(FR + lane * 16), tb1 = *(const LAS bf16x8*)(FR + (64 + lane) * 16);
            const v2u a0 = tr4(VT_, 8 * hh, 32 * eb, lane), a1 = tr4(VT_, 8 * hh + 4, 32 * eb, lane), b0 = tr4(VT_, 16 + 8 * hh, 32 * eb, lane), b1 = tr4(VT_, 16 + 8 * hh + 4, 32 * eb, lane);
            un = __builtin_amdgcn_mfma_f32_32x32x16_bf16(tb0, __builtin_bit_cast(bf16x8, (v4u){a0.x, a0.y, a1.x, a1.y}), un, 0, 0, 0);
            un = __builtin_amdgcn_mfma_f32_32x32x16_bf16(tb1, __builtin_bit_cast(bf16x8, (v4u){b0.x, b0.y, b1.x, b1.y}), un, 0, 0, 0);
        }
        {
            const bf16x8 tg0 = *(const LAS bf16x8*)(FR + 2048 + lane * 16), tg1 = *(const LAS bf16x8*)(FR + 2048 + (64 + lane) * 16);
#pragma unroll
            for (int db = 0; db < 4; ++db) {
                const v2u l0 = tr4(KT, 4 * hh, 32 * db, lane), h0 = tr4(KT, 8 + 4 * hh, 32 * db, lane), l1 = tr4(KT, 16 + 4 * hh, 32 * db, lane), h1 = tr4(KT, 24 + 4 * hh, 32 * db, lane);
                f32x16 w;
#pragma unroll
                for (int r = 0; r < 16; ++r) w[r] = 0.f;
                w = __builtin_amdgcn_mfma_f32_32x32x16_bf16(__builtin_bit_cast(bf16x8, (v4u){l0.x, l0.y, h0.x, h0.y}), tg0, w, 0, 0, 0);
                w = __builtin_amdgcn_mfma_f32_32x32x16_bf16(__builtin_bit_cast(bf16x8, (v4u){l1.x, l1.y, h1.x, h1.y}), tg1, w, 0, 0, 0);
                const bf16x8 wA0 = pack8(-w[0], -w[1], -w[2], -w[3], -w[4], -w[5], -w[6], -w[7]), wA1 = pack8(-w[8], -w[9], -w[10], -w[11], -w[12], -w[13], -w[14], -w[15]);
                const bf16x8 SB0 = pack8(S[db][0], S[db][1], S[db][2], S[db][3], S[db][4], S[db][5], S[db][6], S[db][7]);
                const bf16x8 SB1 = pack8(S[db][8], S[db][9], S[db][10], S[db][11], S[db][12], S[db][13], S[db][14], S[db][15]);
                un = __builtin_amdgcn_mfma_f32_32x32x16_bf16(wA0, SB0, un, 0, 0, 0);
                un = __builtin_amdgcn_mfma_f32_32x32x16_bf16(wA1, SB1, un, 0, 0, 0);
            }
        }
        bf16x8 vnB0, vnB1, vnS0, vnS1;
        {
            float vn[16], dc[16];
#pragma unroll
            for (int q4 = 0; q4 < 4; ++q4) {
                const f32x4 d4 = *(const LAS f32x4*)(SCL + 32 + 8 * q4 + 4 * hh);
#pragma unroll
                for (int e = 0; e < 4; ++e) { dc[4 * q4 + e] = d4[e]; vn[4 * q4 + e] = un[4 * q4 + e]; }
            }
            vnB0 = pack8(vn[0], vn[1], vn[2], vn[3], vn[4], vn[5], vn[6], vn[7]); vnB1 = pack8(vn[8], vn[9], vn[10], vn[11], vn[12], vn[13], vn[14], vn[15]);
            vnS0 = pack8(vn[0] * dc[0], vn[1] * dc[1], vn[2] * dc[2], vn[3] * dc[3], vn[4] * dc[4], vn[5] * dc[5], vn[6] * dc[6], vn[7] * dc[7]);
            vnS1 = pack8(vn[8] * dc[8], vn[9] * dc[9], vn[10] * dc[10], vn[11] * dc[11], vn[12] * dc[12], vn[13] * dc[13], vn[14] * dc[14], vn[15] * dc[15]);
        }
        unsigned zreg[8];
#pragma unroll
        for (int jr = 0; jr < 8; ++jr) zreg[jr] = *(const unsigned*)(H + (size_t)((HOT ? rowbase : R0) + eb * 8 + jr) * LDH + HZ + h * 128 + 2 * lane);
        f32x16 qs, o2;
#pragma unroll
        for (int r = 0; r < 16; ++r) { qs[r] = 0.f; o2[r] = 0.f; }
        const float gl = SCL[64];
#pragma unroll
        for (int db = 0; db < 4; ++db) {
            const bf16x8 SB0 = pack8(S[db][0], S[db][1], S[db][2], S[db][3], S[db][4], S[db][5], S[db][6], S[db][7]);
            const bf16x8 SB1 = pack8(S[db][8], S[db][9], S[db][10], S[db][11], S[db][12], S[db][13], S[db][14], S[db][15]);
            const LAS unsigned char* qp = QT + l31 * 272 + (32 * db + 4 * hh) * 2;
            const v2u ql0 = *(const LAS v2u*)qp, qh0 = *(const LAS v2u*)(qp + 16), ql1 = *(const LAS v2u*)(qp + 32), qh1 = *(const LAS v2u*)(qp + 48);
            qs = __builtin_amdgcn_mfma_f32_32x32x16_bf16(__builtin_bit_cast(bf16x8, (v4u){ql0.x, ql0.y, qh0.x, qh0.y}), SB0, qs, 0, 0, 0);
            qs = __builtin_amdgcn_mfma_f32_32x32x16_bf16(__builtin_bit_cast(bf16x8, (v4u){ql1.x, ql1.y, qh1.x, qh1.y}), SB1, qs, 0, 0, 0);
            const v2u l0 = tr4(KT, 4 * hh, 32 * db, lane), h0 = tr4(KT, 8 + 4 * hh, 32 * db, lane), l1 = tr4(KT, 16 + 4 * hh, 32 * db, lane), h1 = tr4(KT, 24 + 4 * hh, 32 * db, lane);
#pragma unroll
            for (int r = 0; r < 16; ++r) S[db][r] *= gl;
            S[db] = __builtin_amdgcn_mfma_f32_32x32x16_bf16(__builtin_bit_cast(bf16x8, (v4u){l0.x, l0.y, h0.x, h0.y}), vnS0, S[db], 0, 0, 0);
            S[db] = __builtin_amdgcn_mfma_f32_32x32x16_bf16(__builtin_bit_cast(bf16x8, (v4u){l1.x, l1.y, h1.x, h1.y}), vnS1, S[db], 0, 0, 0);
        }
        {
            const bf16x8 mf0 = *(const LAS bf16x8*)(FR + 4096 + lane * 16), mf1 = *(const LAS bf16x8*)(FR + 4096 + (64 + lane) * 16);
            o2 = __builtin_amdgcn_mfma_f32_32x32x16_bf16(mf0, vnB0, o2, 0, 0, 0);
            o2 = __builtin_amdgcn_mfma_f32_32x32x16_bf16(mf1, vnB1, o2, 0, 0, 0);
        }
        float eg[16];
#pragma unroll
        for (int q4 = 0; q4 < 4; ++q4) { const f32x4 e4 = *(const LAS f32x4*)(SCL + 8 * q4 + 4 * hh); eg[4 * q4] = e4[0]; eg[4 * q4 + 1] = e4[1]; eg[4 * q4 + 2] = e4[2]; eg[4 * q4 + 3] = e4[3]; }
#pragma unroll
        for (int r = 0; r < 16; ++r) OB[crow16(r, hh) * 132 + 32 * eb + l31] = qs[r] * eg[r] + o2[r];
        __syncthreads();
        f32x2 ovv[8]; float ssq[8];
#pragma unroll
        for (int jr = 0; jr < 8; ++jr) ovv[jr] = *(const LAS f32x2*)(OB + (eb * 8 + jr) * 132 + 2 * lane);
#pragma unroll
        for (int jr = 0; jr < 8; ++jr) ssq[jr] = wave_sum(ovv[jr].x * ovv[jr].x + ovv[jr].y * ovv[jr].y);
#pragma unroll
        for (int jr = 0; jr < 8; ++jr) {
            const int i = eb * 8 + jr; const size_t row = (size_t)(R0 + i);
            const f32x2 ov = ovv[jr];
            const float rs = __builtin_amdgcn_rsqf(ssq[jr] * (1.f / 128.f) + LN_EPS);
            const unsigned zw = zreg[jr];
#if MIX_FP8
            *(unsigned short*)((unsigned char*)(HOT ? (bf16*)(C.ws + 427 * MiB) : CAT) + (HOT ? (size_t)i : row) * DM + 2048 + h * 128 + 2 * lane) = (unsigned short)pk4_fp8(ov.x * rs * gn.x * silu_f(bflo(zw)) * CAT_Q, ov.y * rs * gn.y * silu_f(bfhi(zw)) * CAT_Q, 0.f, 0.f);
#else
            *(unsigned*)(CAT + row * DM + 2048 + h * 128 + 2 * lane) = pk2(ov.x * rs * gn.x * silu_f(bflo(zw)), ov.y * rs * gn.y * silu_f(bfhi(zw)));
#endif
        }
    }
#undef DS_REQ
    float* so = HOT ? (float*)(C.ws + 427 * MiB + 262144) + (size_t)(bh & 15) * 128 * 128 + 32 * eb + l31 : C.out + (prompt ? O_PDELTA : O_SDELTA) + (size_t)bh * 128 * 128 + 32 * eb + l31;
#pragma unroll
    for (int db = 0; db < 4; ++db)
#pragma unroll
        for (int r = 0; r < 16; ++r) so[(size_t)(32 * db + crow16(r, hh)) * 128] = S[db][r];
}

#ifndef MK_PER_PHASE
#define MK_PER_PHASE 0
#endif
constexpr int N_PHASES = 10;
#ifndef GEMM_XS
#define GEMM_XS 0
#endif
#ifndef UP_TAIL_SPLIT
#define UP_TAIL_SPLIT 0
#endif
#ifndef WUP_P1
#define WUP_P1 0
#endif
static_assert(WUP_P1 <= 1152, "only the first 1152 grabs avoid the w_in^T region");
#ifndef WUP_MIX
#define WUP_MIX 0
#endif
#ifndef WUP_SPLIT
#define WUP_SPLIT 0
#endif
#ifndef GEMM_WGM_UP
#define GEMM_WGM_UP GEMM_WGM
#endif
#ifndef GEMM_WGM_RES
#define GEMM_WGM_RES 4
#endif
#ifndef GEMM_WGM
#define GEMM_WGM 4
#endif
struct Args { const float* in[26]; float* out; unsigned char* ws; int ph_lo, ph_hi; };
static_assert(sizeof(Args) == 26 * 8 + 8 + 8 + 8, "Args has no padding");

struct HotOrder { pg8::StaticOrder S; __device__ bool next(int i, pg8::Unit& u) const { pg8::Unit t; if (!S.next(i, t)) return false; u.pm = S.c & 3; u.pn = (S.c >> 2) & 7; u.koff = 0; u.part = 0; u.kn = 0; u.tidx = 0; return true; }
                  __device__ void a_ready(const pg8::Unit&) const {} __device__ void done(const pg8::Unit&) const {} };
struct EpiNull { static constexpr bool PERM = true, AFTER_DRAIN = false; float* sink;
                 __device__ __forceinline__ void operator()(const pg8::f32x4 (&acc)[2][2][4][2], const pg8::Unit& u, int wr, int wc, int fr, int fq) const {
                     float s = 0.f;
#pragma unroll
                     for (int a = 0; a < 2; ++a)
#pragma unroll
                         for (int b = 0; b < 2; ++b)
#pragma unroll
                             for (int m = 0; m < 4; ++m) s += acc[a][b][m][0][0] + acc[a][b][m][1][3];
                     if (s == 123456.789f) sink[0] = s; } };
__global__ void __launch_bounds__(NWAVES * 64, 2) fwd_kernel(Args args) {
    extern __shared__ __attribute__((aligned(16))) unsigned char lds_raw[];
    Ctx C;
    C.out = args.out; C.ws = args.ws;
    C.lds = (LAS unsigned char*)lds_raw; C.ctl = (gu32*)(args.ws + WS_CTL);
    C.tid = threadIdx.x; C.lane = C.tid & 63; C.wave = __builtin_amdgcn_readfirstlane(C.tid >> 6); C.G = gridDim.x; C.bid = blockIdx.x;
    for (int u = C.tid; u < (LDS_BYTES - LDSCTL_OFF) / 4; u += NWAVES * 64) ((LAS unsigned*)(C.lds + LDSCTL_OFF))[u] = 0u;
    __syncthreads();
    if (C.tid < 26) ((LAS unsigned long long*)(C.lds + PTAB_OFF))[C.tid] = (unsigned long long)(size_t)args.in[C.tid];
    __syncthreads();
    XcdBarrier bar; bar.bar = (unsigned*)(C.ctl + CW_BAR); bar.x = 0; bar.st = nullptr;
    if (!MK_PER_PHASE) bar = xcd_barrier_post((unsigned*)(C.ctl + CW_BAR), (volatile LAS unsigned*)(C.lds + MISC_OFF) + 8);
    const int lo = args.ph_lo, hi = args.ph_hi;
#define IN(k) (lo <= (k) && (k) < hi)
#define SEAM(k) do { if (IN(k) && IN((k) + 1)) xcd_barrier(bar); REFRESH_IDS(); } while (0)
#define REFRESH_IDS() do { int t_ = threadIdx.x; asm volatile("" : "+v"(t_)); C.tid = t_; C.lane = t_ & 63; C.wave = __builtin_amdgcn_readfirstlane(t_ >> 6); } while (0)

#ifndef PROBE_DUP
#define PROBE_DUP 0
#endif
    if (IN(0)) { phase0(C); if (PROBE_DUP == 1) { xcd_barrier(bar); phase0(C); } } SEAM(0);

    if (IN(1)) {
        pg8::Gemm g{(const pg8::bf16_t*)(C.ws + WS_XN), (const pg8::bf16_t*)(C.ws + WS_WIN), MTOK, LDH, DM, LDX};
        pg8::StaticOrder S; S.init(MTOK, LDH, C.G, C.bid); S.wgm = GEMM_WGM; S.xs = GEMM_XS;
        Epi1 E{(bf16*)(C.ws + WS_H), C.out + OS_SM, C.out};
#if defined(GEMM_STAGGER) && GEMM_STAGGER
        for (int d = 0; d < ((C.bid >> 5) & 7) * GEMM_STAGGER; ++d) __builtin_amdgcn_s_sleep(127);
#endif
        pg8::gemm_phase<Epi1, pg8::StaticOrder, true, true>(C.lds, g, S, E);
        REFRESH_IDS();
        transpose_queue<MIX_FP8 ? 4 : 0>(C, inp(C, I_WO), DM, DM, (bf16*)(C.ws + WS_WO), (DM / 64) * (DM / 32), CW_QT1);
#if WUP_EARLY && WUP_P1 > 0
        transpose_queue<2, true>(C, inp(C, I_WUP), DM, DFF2, (bf16*)(C.ws + WS_WUP), (DM / 64) * (DFF2 / 32), CW_QT5 + 128, 0, WUP_P1, 0, 16384);
#endif
        if (PROBE_DUP == 4) { xcd_barrier(bar); pg8::gemm_phase<Epi1, pg8::StaticOrder, true, true>(C.lds, g, S, E); }
        if (PROBE_DUP == 21) { xcd_barrier(bar); EpiNull EN{(float*)(C.ws + WS_P2)}; pg8::gemm_phase<EpiNull, pg8::StaticOrder, true, true>(C.lds, g, S, EN); }
        if (PROBE_DUP == 20) {
            xcd_barrier(bar);
            HotOrder HO{S}; EpiNull EN{(float*)(C.ws + WS_P2)};
            pg8::gemm_phase<EpiNull, HotOrder, true, true>(C.lds, g, HO, EN);
        }
    } SEAM(1);

    if (IN(2)) {
#if PROBE_DUP == 32 || PROBE_DUP == 33
        { const int pm = __builtin_amdgcn_readfirstlane(PROBE_DUP - 31); for (;;) { const int it = q_next(C, CW_Q2 + 256); if (it >= NDU / 8) break; dprep_unit(C, it * 8 + C.wave, C.lane, C.lds + C.wave * 13824, pm); } xcd_barrier(bar); REFRESH_IDS(); }
#endif
        for (;;) { const int it = q_next(C, CW_Q2); if (it >= 288 + NDU / 8) break; if (it < 288) idx_unit(C, it); else dprep_unit(C, (it - 288) * 8 + C.wave, C.lane, C.lds + C.wave * 13824); }
#if WUP_EARLY
        REFRESH_IDS();
        transpose_queue<2, true>(C, inp(C, I_WUP), DM, DFF2, (bf16*)(C.ws + WS_WUP), (DM / 64) * (DFF2 / 32), CW_QT5, WUP_P1, WUP_P1 + WUP_SPLIT, 16384, 8704);
#endif
        if (PROBE_DUP == 2) { xcd_barrier(bar); for (;;) { const int it = q_next(C, CW_Q2 + 256); if (it >= 288 + NDU / 8) break; if (it < 288) idx_unit(C, it); else dprep_unit(C, (it - 288) * 8 + C.wave, C.lane, C.lds + C.wave * 13824); } }
        if (PROBE_DUP == 12) { xcd_barrier(bar); for (;;) { const int it = q_next(C, CW_Q2 + 256); if (it >= 288) break; idx_unit<false>(C, it); } }
        if (PROBE_DUP == 10) { xcd_barrier(bar); for (;;) { const int it = q_next(C, CW_Q2 + 256); if (it >= 288) break; idx_unit(C, it); } }
        if (PROBE_DUP == 11) { xcd_barrier(bar); for (;;) { const int it = q_next(C, CW_Q2 + 256); if (it >= NDU / 8) break; dprep_unit(C, it * 8 + C.wave, C.lane, C.lds + C.wave * 13824); } }
    } SEAM(2);

    if (IN(3)) {
        attn_lut(C);
#if PROBE_DUP == 31
#pragma unroll 1
        for (int hot = 1; hot >= 0; --hot) { const int hv = __builtin_amdgcn_readfirstlane(hot); for (;;) { const int it = q_next(C, CW_Q3 + 256 * hv); if (it >= 320) break; dscan_unit(C, it, hv); } xcd_barrier(bar); }
#else
        for (;;) { const int it = q_next(C, CW_Q3); if (it >= 320) break; dscan_unit(C, it); }
#endif
        REFRESH_IDS();
#if WUP_EARLY && WUP_MIX > 0 && WUP_P1 == 0
        {
            bool more = true;
            for (;;) { const int it = q_next(C, CW_Q3 + 64); if (it >= 1152) break; attn_unit(C, it);
                if (more) { REFRESH_IDS(); more = transpose_grabs<2>(C, inp(C, I_WUP), DM, DFF2, (bf16*)(C.ws + WS_WUP), (DM / 64) * (DFF2 / 32), CW_QT5 + 64, WUP_SPLIT, 1 << 30, 16384, 8704, WUP_MIX); REFRESH_IDS(); } }
        }
#else
        for (;;) { const int it = q_next(C, CW_Q3 + 64); if (it >= 1152) break; attn_unit(C, it); }
#endif
#if WUP_EARLY
        REFRESH_IDS();
        transpose_queue<2, true>(C, inp(C, I_WUP), DM, DFF2, (bf16*)(C.ws + WS_WUP), (DM / 64) * (DFF2 / 32), CW_QT5 + 64, WUP_P1 + WUP_SPLIT, 1 << 30, 16384, 8704);
#endif
        if (PROBE_DUP == 3) { xcd_barrier(bar); for (;;) { const int it = q_next(C, CW_Q3 + 256); if (it >= 320) break; dscan_unit(C, it); } }
        if (PROBE_DUP == 6) { xcd_barrier(bar); for (;;) { const int it = q_next(C, CW_Q3 + 320); if (it >= 1152) break; attn_unit(C, it); } }
    } SEAM(3);

    if (IN(4)) {
        pg8::StaticOrder S; S.init(MTOK, DM, C.G, C.bid); S.wgm = GEMM_WGM_RES; S.xs = GEMM_XS;
#if MIX_FP8
        pg8::Gemm g{(const pg8::bf16_t*)(C.ws + WS_CAT), (const pg8::bf16_t*)(C.ws + WS_WO), MTOK, DM, DM / 2, DM / 2};
        EpiRes E{(const bf16*)(C.ws + WS_XN), (bf16*)(C.ws + WS_PRE1), 0, 1.f / (CAT_Q * WO_Q), (float*)(C.ws + WS_P2), (unsigned*)(C.ctl + CW_TIX2)};
        S.lim = 1024;
        pg8::gemm_phase<EpiRes, pg8::StaticOrder, true, true, true>(C.lds, g, S, E);
        { pg8::TailOrder T{S, 1024, 2, 16, 16}; pg8::gemm_phase<EpiRes, pg8::TailOrder, true, true, true>(C.lds, g, T, E); }
#else
        pg8::Gemm g{(const pg8::bf16_t*)(C.ws + WS_CAT), (const pg8::bf16_t*)(C.ws + WS_WO), MTOK, DM, DM, DM};
        EpiRes E{(const bf16*)(C.ws + WS_XN), (bf16*)(C.ws + WS_PRE1), 0, 1.f, nullptr, nullptr};
        pg8::gemm_phase<EpiRes, pg8::StaticOrder, true, true>(C.lds, g, S, E);
#endif
    } SEAM(4);

    if (IN(5)) { phase5(C); if (PROBE_DUP == 1) { xcd_barrier(bar); phase5(C); } } SEAM(5);

    if (IN(6)) {
        pg8::Gemm g{(const pg8::bf16_t*)(C.ws + WS_XN), (const pg8::bf16_t*)(C.ws + WS_WUP), MTOK, DFF2, DM, LDX};
        pg8::StaticOrder S; S.init(MTOK, DFF2, C.G, C.bid); S.wgm = GEMM_WGM_UP; S.xs = GEMM_XS;
        EpiUpAct E{(bf16*)(C.ws + WS_ACT), (bf16*)(C.ws + WS_UPS), C.out, inp(C, I_FCW), inp(C, I_FCB), (LAS float*)(C.lds + EPIW_OFF), (float*)(C.ws + WS_P3), (unsigned*)(C.ctl + CW_T3)};
#if UP_TAIL_SPLIT
        S.lim = 6144;
        pg8::gemm_phase<EpiUpAct, pg8::StaticOrder, true, true>(C.lds, g, S, E);
        { pg8::TailOrder T{S, 6144, UPT_NS, 64 / UPT_NS, 64 / UPT_NS}; pg8::gemm_phase<EpiUpAct, pg8::TailOrder, true, true>(C.lds, g, T, E); }
#else
        pg8::gemm_phase<EpiUpAct, pg8::StaticOrder, true, true>(C.lds, g, S, E);
#endif
        REFRESH_IDS();
        if (PROBE_DUP == 40) { xcd_barrier(bar); pg8::gemm_phase<EpiUpAct, pg8::StaticOrder, true, true>(C.lds, g, S, E); REFRESH_IDS(); }
        if (PROBE_DUP == 41) { xcd_barrier(bar); EpiNull EN{(float*)(C.ws + WS_P2)}; pg8::gemm_phase<EpiNull, pg8::StaticOrder, true, true>(C.lds, g, S, EN); REFRESH_IDS(); }
        transpose_queue<FFN_DOWN_FP8 ? 3 : 0>(C, inp(C, I_WDN), DFF, DM, (bf16*)(C.ws + WS_WDN), (DFF / 64) * (DM / 32), CW_QT6);
    } SEAM(6);
    if (IN(7)) { ffn_fixup(C); } SEAM(7);
    if (IN(8)) {
#if FFN_DOWN_FP8
        pg8::Gemm g{(const pg8::bf16_t*)(C.ws + WS_ACT), (const pg8::bf16_t*)(C.ws + WS_WDN), MTOK, DM, DFF / 2, DFF / 2};
        pg8::StaticOrder S; S.init(MTOK, DM, C.G, C.bid); S.wgm = GEMM_WGM_RES; S.xs = GEMM_XS;
        EpiRes E{(const bf16*)(C.ws + WS_XN), (bf16*)(C.ws + WS_PRE2), 0, 1.f / (ACT_Q * WDN_Q), (float*)(C.ws + WS_P2), (unsigned*)(C.ctl + CW_TIX4)};
        S.lim = 1024;
        pg8::gemm_phase<EpiRes, pg8::StaticOrder, true, true, true>(C.lds, g, S, E);
        { pg8::TailOrder T{S, 1024, 2, 44, 42}; pg8::gemm_phase<EpiRes, pg8::TailOrder, true, true, true>(C.lds, g, T, E); }
#else
        pg8::Gemm g{(const pg8::bf16_t*)(C.ws + WS_ACT), (const pg8::bf16_t*)(C.ws + WS_WDN), MTOK, DM, DFF, DFF};
        pg8::StaticOrder S; S.init(MTOK, DM, C.G, C.bid); S.wgm = GEMM_WGM_RES; S.xs = GEMM_XS;
        EpiRes E{(const bf16*)(C.ws + WS_XN), (bf16*)(C.ws + WS_PRE2), 0, 1.f, nullptr, nullptr};
        pg8::gemm_phase<EpiRes, pg8::StaticOrder, true, true>(C.lds, g, S, E);
#endif
    } SEAM(8);

    if (IN(9)) {
        const int gw = C.bid * NWAVES + C.wave, NGW = C.G * NWAVES;
        LnP P; ln_params(P, inp(C, I_LN2G), inp(C, I_LN2B), C.lane);
#pragma unroll 1
        for (int m = gw; m < MTOK; m += NGW) ln_row<true, true, true>((const bf16*)(C.ws + WS_PRE2) + (size_t)m * DM, P, C.out + O_Y + (size_t)m * DM, C.lane, (const unsigned*)(C.ctl + CW_TIX4) + (m >> 8) * 16, (const float*)(C.ws + WS_P2), m & 255);
    }
#undef IN
#undef SEAM
}

extern "C" void kernel_launch(void* const* d_in, const int* in_sizes, int n_in, void* d_out, int out_size, void* d_ws, size_t ws_size, hipStream_t stream) {
    static int grid = 0;
    if (grid == 0) {
        if (n_in != 26 || (size_t)out_size != O_END || ws_size < WS_END) { fprintf(stderr, "kernel_launch: unexpected shapes: n_in %d out %d ws %zu (need %zu)\n", n_in, out_size, ws_size, (size_t)WS_END); grid = -1; return; }
        int dev = 0, cus = 0, per_cu = 0;
        if (hipGetDevice(&dev) != hipSuccess || hipDeviceGetAttribute(&cus, hipDeviceAttributeMultiprocessorCount, dev) != hipSuccess) { grid = -1; return; }
        if (hipFuncSetAttribute((const void*)fwd_kernel, hipFuncAttributeMaxDynamicSharedMemorySize, LDS_BYTES) != hipSuccess) { fprintf(stderr, "kernel_launch: hipFuncSetAttribute failed\n"); grid = -1; return; }
        if (hipOccupancyMaxActiveBlocksPerMultiprocessor(&per_cu, (const void*)fwd_kernel, NWAVES * 64, LDS_BYTES) != hipSuccess || per_cu < 1) { fprintf(stderr, "kernel_launch: occupancy query says %d\n", per_cu); }
        (void)hipGetLastError();
        grid = cus;
    }
    if (grid < 0) return;
    if (hipMemsetAsync((char*)d_ws + WS_CTL, 0, CTL_ZERO_BYTES, stream) != hipSuccess) return;
    Args a{};
    for (int i = 0; i < 26; ++i) a.in[i] = (const float*)d_in[i];
    a.out = (float*)d_out; a.ws = (unsigned char*)d_ws;
#if MK_PER_PHASE
    for (int p = 0; p < N_PHASES; ++p) { a.ph_lo = p; a.ph_hi = p + 1; hipLaunchKernelGGL(fwd_kernel, dim3(grid), dim3(NWAVES * 64), LDS_BYTES, stream, a); }
#else
    a.ph_lo = 0; a.ph_hi = N_PHASES;
    hipLaunchKernelGGL(fwd_kernel, dim3(grid), dim3(NWAVES * 64), LDS_BYTES, stream, a);
#endif
    const hipError_t le = hipPeekAtLastError();
    if (le != hipSuccess) fprintf(stderr, "kernel_launch: launch failed: %s\n", hipGetErrorName(le));
}
```

```cpp
#include <hip/hip_runtime.h>
#include <cstdio>
#include <cstdint>
#define WUP_P1 0
namespace pg8 {
#define PG8_LAS __attribute__((address_space(3)))
typedef unsigned short bf16_t;
typedef short bf16x8 __attribute__((ext_vector_type(8)));
typedef float f32x4 __attribute__((ext_vector_type(4)));
typedef unsigned u32x4 __attribute__((ext_vector_type(4)));
constexpr int BM = 256, BK = 64, HALF = 128, HTB = HALF * BK * 2  , STAGE_BYTES = 8 * HTB, NXCD = 8, WGM = 8;

__host__ __device__ __forceinline__ int lds_byte(int r, int c) { const int st = (r >> 4) * 2 + (c >> 5), rr = r & 15, cc = c & 31, ob = rr * 64 + cc * 2; return st * 1024 + (ob ^ (((ob >> 9) & 1) << 5)); }
__host__ __device__ __forceinline__ void stage_rc(int b, int& R, int& C) { const int st = b / 1024, sb = b % 1024, swz = sb ^ (((sb >> 9) & 1) << 5); R = (st >> 1) * 16 + swz / 64; C = (st & 1) * 32 + (swz % 64) / 2; }
__host__ __device__ __forceinline__ int perm32(int rho) { const int n = rho >> 4, i = rho & 15; return 8 * (i >> 2) + 4 * n + (i & 3); }

struct Unit { int pm, pn, koff, part, kn, tidx; };
struct Gemm { const bf16_t* A; const bf16_t* Bt; int M, N, K, lda; };

struct StaticOrder {
    int nM, nN, nwg, G, c, lim, wgm, xs;
    __host__ __device__ void init(int M, int N, int G_, int c_) { nM = M / BM; nN = N / BM; nwg = nM * nN; G = G_; c = c_; lim = nwg; wgm = WGM; xs = 0; }
    __host__ __device__ void map(long L, Unit& u) const {
        if (xs) {
            const int x = (int)(L % NXCD), e = (int)(L / NXCD), per = nM / NXCD, nig = wgm * nN, k = e / nig, w = e % nig;
            u.pm = x * per + k * wgm + w % wgm; u.pn = w / wgm; u.koff = 0; u.part = 0; u.kn = 0; u.tidx = 0; return;
        }
        int wgid = (int)L; { const int q = nwg / NXCD, r = nwg % NXCD, xcd = wgid % NXCD, off = wgid / NXCD; wgid = (xcd < r ? xcd * (q + 1) : r * (q + 1) + (xcd - r) * q) + off; }
        const int nig = wgm * nN, gid = wgid / nig, fm = gid * wgm, gsz = (nM - fm) < wgm ? (nM - fm) : wgm;
        u.pm = fm + ((wgid % nig) % gsz); u.pn = (wgid % nig) / gsz; u.koff = 0; u.part = 0; u.kn = 0; u.tidx = 0;
    }
    __host__ __device__ bool next(int i, Unit& u) const {
        const long L = (long)i * G + c; if (L >= lim) return false;
        map(L, u); return true;
    }
    __device__ __forceinline__ void a_ready(const Unit&) const {}
    __device__ __forceinline__ void done(const Unit&) const {}
};

struct TailOrder {
    StaticOrder S; int L0, nsplit, kt0, kt1;
    __host__ __device__ bool next(int i, Unit& u) const {
        if (i > 0) return false; const long L = L0 + S.c / nsplit; if (L >= S.nwg) return false;
        S.map(L, u); u.part = S.c % nsplit; u.koff = u.part == 0 ? 0 : (kt0 + (u.part - 1) * kt1) * BK; u.kn = u.part == 0 ? kt0 : kt1; u.tidx = (int)(L - L0); return true;
    }
    __device__ __forceinline__ void a_ready(const Unit&) const {}
    __device__ __forceinline__ void done(const Unit&) const {}
};
__device__ __forceinline__ unsigned cvt_pk_bf16(float lo, float hi) { unsigned r; asm volatile("v_cvt_pk_bf16_f32 %0, %1, %2" : "=v"(r) : "v"(lo), "v"(hi)); return r; }
typedef float f32x2 __attribute__((ext_vector_type(2)));

typedef int v8i_t __attribute__((ext_vector_type(8)));
__device__ __forceinline__ v8i_t cat16(bf16x8 lo, bf16x8 hi) { const u32x4 a = __builtin_bit_cast(u32x4, lo), b = __builtin_bit_cast(u32x4, hi); return (v8i_t){(int)a.x, (int)a.y, (int)a.z, (int)a.w, (int)b.x, (int)b.y, (int)b.z, (int)b.w}; }
template <class Epi, class Sched, bool ALIGN_EPI = false, bool SP2 = false, bool F8 = false>
__device__ __forceinline__ void gemm_phase(PG8_LAS unsigned char* lds, const Gemm g, const Sched& S, const Epi& E) {
    const int tid = threadIdx.x, wid = __builtin_amdgcn_readfirstlane(tid >> 6), lane = tid & 63, wr = wid >> 2, wc = wid & 3, fr = lane & 15, fq = lane >> 4;
    const int K = g.lda, nt = g.K / BK;
    unsigned voffA[2], voffB[2];
#pragma unroll
    for (int i = 0; i < 2; ++i) { int R, C; stage_rc(tid * 16 + i * 8192, R, C); const int Rb = Epi::PERM ? ((R & ~31) + perm32(R & 31)) : R;
        voffA[i] = (unsigned)(R * K + C) * 2u; voffB[i] = (unsigned)(Rb * K + C) * 2u; }
    const size_t kstep = (size_t)(BK * 2);
    const size_t hstep = (size_t)HALF * K * 2;
    const size_t tstep = 2 * hstep;
    const unsigned ldsw = (unsigned)wid * 1024u;
    const int aoff = lds_byte(wr * 64 + fr, fq * 8), boff = lds_byte(wc * 32 + fr, fq * 8);
#define PG8_SA(b, h) (((b) * 2 + (h)) * HTB)
#define PG8_SB(b, h) ((4 + (b) * 2 + (h)) * HTB)
#define PG8_STAGE(bufoff, gbase, voff) do { _Pragma("unroll") for (int _i = 0; _i < 2; ++_i) \
        __builtin_amdgcn_global_load_lds((const unsigned*)((const char*)(gbase) + (voff)[_i]), (PG8_LAS unsigned*)(lds + (bufoff) + ldsw + _i * 8192), 16, 0, 0); } while (0)
#define PG8_LDA(dst, b, h) do { if constexpr (F8) { _Pragma("unroll") for (int m = 0; m < 4; ++m) dst##8[m] = cat16(*(const PG8_LAS bf16x8*)(lds + PG8_SA(b, h) + aoff + m * 2048), *(const PG8_LAS bf16x8*)(lds + PG8_SA(b, h) + aoff + m * 2048 + 1024)); } \
        else { _Pragma("unroll") for (int m = 0; m < 4; ++m) _Pragma("unroll") for (int k = 0; k < 2; ++k) dst[m][k] = *(const PG8_LAS bf16x8*)(lds + PG8_SA(b, h) + aoff + m * 2048 + k * 1024); } } while (0)
#define PG8_LDB(dst, b, h) do { if constexpr (F8) { _Pragma("unroll") for (int n = 0; n < 2; ++n) dst##8[n] = cat16(*(const PG8_LAS bf16x8*)(lds + PG8_SB(b, h) + boff + n * 2048), *(const PG8_LAS bf16x8*)(lds + PG8_SB(b, h) + boff + n * 2048 + 1024)); } \
        else { _Pragma("unroll") for (int n = 0; n < 2; ++n) _Pragma("unroll") for (int k = 0; k < 2; ++k) dst[n][k] = *(const PG8_LAS bf16x8*)(lds + PG8_SB(b, h) + boff + n * 2048 + k * 1024); } } while (0)
#define PG8_MMA(ai, bj, At, Bt) do { __builtin_amdgcn_s_setprio(1); \
        if constexpr (F8) { _Pragma("unroll") for (int m = 0; m < 4; ++m) _Pragma("unroll") for (int n = 0; n < 2; ++n) \
            asm volatile("v_mfma_f32_16x16x128_f8f6f4 %0, %1, %2, %0" : "+v"(acc[ai][bj][m][n]) : "v"(Bt##8[n]), "v"(At##8[m])); } \
        else { _Pragma("unroll") for (int m = 0; m < 4; ++m) _Pragma("unroll") for (int n = 0; n < 2; ++n) _Pragma("unroll") for (int k = 0; k < 2; ++k) \
            acc[ai][bj][m][n] = __builtin_amdgcn_mfma_f32_16x16x32_bf16(Bt[n][k], At[m][k], acc[ai][bj][m][n], 0, 0, 0); } \
        __builtin_amdgcn_s_setprio(0); } while (0)
#define PG8_WAIT_V(n) asm volatile("s_waitcnt vmcnt(" #n ")" ::: "memory")
#define PG8_WAIT_L(n) asm volatile("s_waitcnt lgkmcnt(" #n ")" ::: "memory")
#define PG8_BAR __builtin_amdgcn_s_barrier()
#define PG8_SCHED __builtin_amdgcn_sched_barrier(0)
    Unit cur, nxt; int ui = 0;
    if (!S.next(0, cur)) return;
    f32x4 acc[2][2][4][2];
#pragma unroll
    for (int a = 0; a < 2; ++a)
#pragma unroll
        for (int b = 0; b < 2; ++b)
#pragma unroll
            for (int m = 0; m < 4; ++m)
#pragma unroll
                for (int n = 0; n < 2; ++n) acc[a][b][m][n] = (f32x4){0.f, 0.f, 0.f, 0.f};
    bf16x8 At[4][2], B0[2][2], B1[2][2]; v8i_t At8[4], B08[2], B18[2];
    const char* cA = (const char*)g.A + (size_t)cur.pm * tstep + (size_t)cur.koff * 2; const char* cB = (const char*)g.Bt + (size_t)cur.pn * tstep + (size_t)cur.koff * 2;
    S.a_ready(cur);
    if constexpr (SP2) {
        PG8_STAGE(PG8_SB(0, 0), cB, voffB); PG8_STAGE(PG8_SB(0, 1), cB + hstep, voffB); PG8_STAGE(PG8_SA(0, 0), cA, voffA); PG8_STAGE(PG8_SA(0, 1), cA + hstep, voffA);
        if (wr == 1) PG8_BAR;
        PG8_WAIT_V(2); PG8_BAR;
        PG8_STAGE(PG8_SB(1, 0), cB + kstep, voffB); PG8_STAGE(PG8_SA(1, 0), cA + kstep, voffA); PG8_STAGE(PG8_SB(1, 1), cB + hstep + kstep, voffB);
        PG8_WAIT_V(6); PG8_BAR;
    } else {
        PG8_STAGE(PG8_SB(0, 0), cB, voffB); PG8_STAGE(PG8_SA(0, 0), cA, voffA); PG8_STAGE(PG8_SB(0, 1), cB + hstep, voffB); PG8_STAGE(PG8_SA(0, 1), cA + hstep, voffA);
        if (wr == 1) PG8_BAR;
        PG8_WAIT_V(4); PG8_BAR;
        PG8_STAGE(PG8_SB(1, 0), cB + kstep, voffB); PG8_STAGE(PG8_SA(1, 0), cA + kstep, voffA); PG8_STAGE(PG8_SB(1, 1), cB + hstep + kstep, voffB);
        PG8_WAIT_V(6); PG8_BAR;
    }
    for (;;) {
        const bool has_next = S.next(ui + 1, nxt);
        const char* nA = has_next ? (const char*)g.A + (size_t)nxt.pm * tstep + (size_t)nxt.koff * 2 : cA; const char* nB = has_next ? (const char*)g.Bt + (size_t)nxt.pn * tstep + (size_t)nxt.koff * 2 : cB;
        const int ntu = cur.kn > 0 ? cur.kn : nt;
        for (int t = 0; t < ntu; t += 2) {
            const bool last = (t == ntu - 2);
            const char* a1 = cA + (size_t)(t + 1) * kstep;
            const char* a2 = last ? nA : cA + (size_t)(t + 2) * kstep; const char* b2 = last ? nB : cB + (size_t)(t + 2) * kstep;
            const char* a3 = a2 + kstep; const char* b3 = b2 + kstep;
            if (last && has_next) S.a_ready(nxt);
            if constexpr (SP2) {
            PG8_LDB(B0, 0, 0); PG8_LDB(B1, 0, 1); PG8_SCHED; PG8_LDA(At, 0, 0); PG8_STAGE(PG8_SA(1, 1), a1 + hstep, voffA);
            PG8_WAIT_V(8); PG8_WAIT_L(0); PG8_BAR; PG8_MMA(0, 0, At, B0); PG8_MMA(0, 1, At, B1); PG8_BAR; PG8_SCHED;
            PG8_LDA(At, 0, 1); PG8_STAGE(PG8_SB(0, 0), b2, voffB); PG8_STAGE(PG8_SB(0, 1), b2 + hstep, voffB); PG8_STAGE(PG8_SA(0, 0), a2, voffA);
            PG8_WAIT_V(8); PG8_WAIT_L(0); PG8_BAR; PG8_MMA(1, 0, At, B0); PG8_MMA(1, 1, At, B1); PG8_BAR; PG8_SCHED;
            PG8_LDB(B0, 1, 0); PG8_LDB(B1, 1, 1); PG8_SCHED; PG8_LDA(At, 1, 0); PG8_STAGE(PG8_SA(0, 1), a2 + hstep, voffA);
            PG8_WAIT_V(8); PG8_WAIT_L(0); PG8_BAR; PG8_MMA(0, 0, At, B0); PG8_MMA(0, 1, At, B1); PG8_BAR; PG8_SCHED;
            PG8_LDA(At, 1, 1); PG8_STAGE(PG8_SB(1, 0), b3, voffB); PG8_STAGE(PG8_SB(1, 1), b3 + hstep, voffB); PG8_STAGE(PG8_SA(1, 0), a3, voffA);
            PG8_WAIT_V(8); PG8_WAIT_L(0); PG8_BAR; PG8_MMA(1, 0, At, B0); PG8_MMA(1, 1, At, B1); PG8_BAR; PG8_SCHED;
            } else {
            PG8_LDB(B0, 0, 0); PG8_SCHED; PG8_LDA(At, 0, 0); PG8_STAGE(PG8_SA(1, 1), a1 + hstep, voffA);
            PG8_WAIT_L(8); PG8_BAR; PG8_WAIT_L(0); PG8_MMA(0, 0, At, B0); PG8_BAR; PG8_SCHED;
            PG8_LDB(B1, 0, 1); PG8_STAGE(PG8_SB(0, 0), b2, voffB);
            PG8_BAR; PG8_WAIT_L(0); PG8_MMA(0, 1, At, B1); PG8_BAR;
            PG8_LDA(At, 0, 1); PG8_STAGE(PG8_SA(0, 0), a2, voffA);
            PG8_BAR; PG8_WAIT_L(0); PG8_MMA(1, 0, At, B0); PG8_BAR; PG8_SCHED;
            PG8_STAGE(PG8_SB(0, 1), b2 + hstep, voffB);
            PG8_WAIT_V(6); PG8_BAR; PG8_MMA(1, 1, At, B1); PG8_BAR;
            PG8_LDB(B0, 1, 0); PG8_SCHED; PG8_LDA(At, 1, 0); PG8_STAGE(PG8_SA(0, 1), a2 + hstep, voffA);
            PG8_WAIT_L(8); PG8_BAR; PG8_WAIT_L(0); PG8_MMA(0, 0, At, B0); PG8_BAR; PG8_SCHED;
            PG8_LDB(B1, 1, 1); PG8_STAGE(PG8_SB(1, 0), b3, voffB);
            PG8_BAR; PG8_WAIT_L(0); PG8_MMA(0, 1, At, B1); PG8_BAR;
            PG8_LDA(At, 1, 1); PG8_STAGE(PG8_SA(1, 0), a3, voffA);
            PG8_BAR; PG8_WAIT_L(0); PG8_MMA(1, 0, At, B0); PG8_BAR; PG8_SCHED;
            PG8_STAGE(PG8_SB(1, 1), b3 + hstep, voffB);
            PG8_WAIT_V(6); PG8_BAR; PG8_MMA(1, 1, At, B1); PG8_BAR;
            }
        }
        if constexpr (F8) asm volatile("s_nop 15\n\ts_nop 15" ::: "memory");
        if constexpr (ALIGN_EPI) { if (wr == 0) PG8_BAR; }
        if constexpr (!Epi::AFTER_DRAIN) { E(acc, cur, wr, wc, fr, fq); S.done(cur); }
        if (!has_next) break;
#pragma unroll
        for (int a = 0; a < 2; ++a)
#pragma unroll
            for (int b = 0; b < 2; ++b)
#pragma unroll
                for (int m = 0; m < 4; ++m)
#pragma unroll
                    for (int n = 0; n < 2; ++n) acc[a][b][m][n] = (f32x4){0.f, 0.f, 0.f, 0.f};
        cur = nxt; cA = nA; cB = nB; ++ui;
        if constexpr (ALIGN_EPI) { if (wr == 1) PG8_BAR; }
    }
    PG8_WAIT_V(0);
    if constexpr (!ALIGN_EPI) { if (wr == 0) PG8_BAR; }
    PG8_BAR;
    if constexpr (Epi::AFTER_DRAIN) { E.fused(acc, cur, wr, wc, fr, fq, lds, wid, lane); S.done(cur); }
#undef PG8_SA
#undef PG8_SB
#undef PG8_STAGE
#undef PG8_LDA
#undef PG8_LDB
#undef PG8_MMA
#undef PG8_WAIT_V
#undef PG8_WAIT_L
#undef PG8_BAR
#undef PG8_SCHED
}
}

#define GAS __attribute__((address_space(1)))
#define LAS __attribute__((address_space(3)))
typedef unsigned short bf16;
typedef unsigned v4u __attribute__((ext_vector_type(4)));
typedef unsigned v2u __attribute__((ext_vector_type(2)));
typedef float f32x4 __attribute__((ext_vector_type(4)));
typedef float f32x2 __attribute__((ext_vector_type(2)));
typedef short bf16x8 __attribute__((ext_vector_type(8)));
typedef GAS unsigned gu32;

constexpr int NWAVES = 8;
constexpr int DM = 4096;
constexpr int NPROW = 16384, NSROW = 2048, MTOK = NPROW + NSROW;
constexpr int PSEQ = 2048, SSEQ = 64, PAST = 1024, NPB = 8, NSB = 32;
#ifndef LDX_PAD
#define LDX_PAD 0
#endif
constexpr int LDX = 4096 + LDX_PAD;
constexpr int LDH = 12544;
constexpr int HQ = 0, HK = 2048, HV = 2560, HIQ = 3072, HQKV = 4096, HZ = 10240, HSM = 12288;
constexpr int NIN = 12400, CQKV = 6144, DFF = 11008, DFF2 = 22016;
constexpr int TOPK = 256;
constexpr float LN_EPS = 1e-5f;
constexpr float ALPHA = 1.189207115002721f;
constexpr float IDX_SCALE = 0.03125f;
constexpr float QSCALE = 0.08838834764831845f;

constexpr size_t O_Y = 0;
constexpr size_t O_PK = (size_t)MTOK * DM;
constexpr size_t O_PV = O_PK + (size_t)NPROW * 512;
constexpr size_t O_PIK = O_PV + (size_t)NPROW * 512;
constexpr size_t O_PDELTA = O_PIK + (size_t)NPROW * 64;
constexpr size_t O_PCONV = O_PDELTA + (size_t)NPB * 16 * 128 * 128;
constexpr size_t O_PFFN = O_PCONV + (size_t)NPB * 3 * CQKV;
constexpr size_t O_SK = O_PFFN + (size_t)NPB * 2 * DFF2;
constexpr size_t O_SV = O_SK + (size_t)NSROW * 512;
constexpr size_t O_SIK = O_SV + (size_t)NSROW * 512;
constexpr size_t O_SDELTA = O_SIK + (size_t)NSROW * 64;
constexpr size_t O_SCONV = O_SDELTA + (size_t)NSB * 16 * 128 * 128;
constexpr size_t O_SFFN = O_SCONV + (size_t)NSB * 3 * CQKV;
constexpr size_t O_END = O_SFFN + (size_t)NSB * 2 * DFF2;
static_assert(O_END == 108535808ull, "d_out map");
constexpr size_t OS_SC = 0;
constexpr size_t OS_SM = (size_t)MTOK * 2048;
constexpr size_t OS_VTP = OS_SM + (size_t)MTOK * 128;
constexpr size_t OS_VTS = OS_VTP + (size_t)NPB * 4 * 128 * PSEQ / 2;
constexpr int SLEN = PAST + SSEQ;
constexpr int NDU = 9216;
constexpr size_t OS_TBF = ((OS_VTS + (size_t)NSB * 4 * 128 * SLEN / 2) + 3) & ~(size_t)3;
constexpr size_t OS_TGF = OS_TBF + (size_t)NDU * 512;
constexpr size_t OS_MFF = OS_TGF + (size_t)NDU * 512;
constexpr size_t OS_GB = OS_MFF + (size_t)NDU * 512;
constexpr size_t OS_MSK = OS_GB + (size_t)MTOK * 16;
static_assert(OS_MSK % 4 == 0 && OS_MSK + (size_t)MTOK * 64 <= O_PK, "scratch in y region");


constexpr size_t MiB = 1u << 20;
constexpr size_t WS_CTL = 0, CTL_ZERO_BYTES = 64 * 1024;
constexpr size_t WS_WO = 1 * MiB;
constexpr size_t WS_XN = WS_WO + 32 * MiB;
constexpr size_t WS_CAT = WS_XN + 150 * MiB;
constexpr size_t WS_WIN = WS_CAT + 144 * MiB;
constexpr size_t WS_H = WS_WIN + 102 * MiB;
constexpr size_t WS_QKVC = WS_H + 441 * MiB;
constexpr size_t WS_END = WS_QKVC + 216 * MiB;
#ifndef WUP_EARLY
#define WUP_EARLY 1
#endif
#if WUP_EARLY
constexpr size_t WS_WUP = WS_CAT + 72 * MiB;
constexpr size_t WS_WDN = WS_CAT;
static_assert((size_t)MTOK * DM <= 72 * MiB && (size_t)DM * DFF <= 72 * MiB && WS_WUP + (size_t)DFF2 * LDX * 2 <= WS_H, "early w_up layout");
#else
constexpr size_t WS_WUP = WS_CAT;
constexpr size_t WS_WDN = WS_WUP + 178 * MiB;
#endif
constexpr size_t WS_ACT = WS_CAT + 264 * MiB;
constexpr size_t WS_P2 = WS_CAT + 706 * MiB;
constexpr size_t WS_PRE1 = WS_ACT;
constexpr size_t WS_PRE2 = WS_WUP;
constexpr size_t WS_P3 = WS_ACT + 194 * MiB;
constexpr size_t WS_UPS = WS_ACT + 388 * MiB;
static_assert((size_t)MTOK * LDH * 2 <= 441 * MiB && (size_t)LDH * LDX * 2 <= 102 * MiB && (size_t)MTOK * LDX * 2 <= 150 * MiB && (size_t)MTOK * CQKV * 2 <= 216 * MiB, "ws sizes");
static_assert((size_t)DFF2 * LDX * 2 <= 178 * MiB && (size_t)DM * DFF * 2 <= 86 * MiB && (size_t)MTOK * DFF * 2 <= 388 * MiB && WS_UPS + (size_t)288 * 4 * DFF2 * 2 <= WS_P2 && WS_P2 + (size_t)128 * 65536 * 4 <= WS_END, "ffn ws sizes");

constexpr int CW_QT1 = 1024, CW_QT6 = 1088, CW_QT5 = 1152, CW_T3 = 13312;
constexpr int CW_Q2 = 64, CW_Q3 = 128;
constexpr int CW_BAR = 4096;
constexpr int CW_XR = 12288;
constexpr int CW_TIX2 = 8192, CW_TIX4 = 8192 + 1152;

constexpr int RING_BYTES = 131072;
constexpr int LDSCTL_OFF = RING_BYTES, MISC_OFF = LDSCTL_OFF + 320;
constexpr int LDS_BYTES = 147456;
constexpr int EPIW_OFF = LDSCTL_OFF + 4096;
static_assert(EPIW_OFF + 8192 <= LDS_BYTES, "lds map");

#define RLX_AGENT __ATOMIC_RELAXED, __HIP_MEMORY_SCOPE_AGENT
#define LDS_WAIT() asm volatile("s_waitcnt lgkmcnt(0)" ::: "memory")
__device__ __forceinline__ unsigned f2bf(float f) { unsigned u = __builtin_bit_cast(unsigned, f); return (u + 0x7fffu + ((u >> 16) & 1u)) >> 16; }
typedef float f32x2_t __attribute__((ext_vector_type(2))); typedef __bf16 bf16x2_t __attribute__((ext_vector_type(2)));
__device__ __forceinline__ unsigned pk2(float lo, float hi) { f32x2_t v = {lo, hi}; bf16x2_t b = __builtin_convertvector(v, bf16x2_t); return __builtin_bit_cast(unsigned, b); }
__device__ __forceinline__ float bflo(unsigned w) { return __uint_as_float(w << 16); }
__device__ __forceinline__ float bfhi(unsigned w) { return __uint_as_float(w & 0xffff0000u); }
#define DPPF(x, ctrl) __int_as_float(__builtin_amdgcn_mov_dpp(__float_as_int(x), (ctrl), 0xf, 0xf, true))
__device__ __forceinline__ float wave_sum(float v) {
    v += DPPF(v, 0xB1); v += DPPF(v, 0x4E); v += DPPF(v, 0x141); v += DPPF(v, 0x140);
    const float s0 = __int_as_float(__builtin_amdgcn_readlane(__float_as_int(v), 0)), s1 = __int_as_float(__builtin_amdgcn_readlane(__float_as_int(v), 16));
    const float s2 = __int_as_float(__builtin_amdgcn_readlane(__float_as_int(v), 32)), s3 = __int_as_float(__builtin_amdgcn_readlane(__float_as_int(v), 48));
    return (s0 + s1) + (s2 + s3);
}
__device__ __forceinline__ float wave_max(float v) {
#pragma unroll
    for (int o = 1; o < 64; o <<= 1) v = fmaxf(v, __shfl_xor(v, o));
    return v;
}
__device__ __forceinline__ int wave_sum_i(int v) {
#pragma unroll
    for (int o = 1; o < 64; o <<= 1) v += __shfl_xor(v, o);
    return v;
}
#define DS_RD128(dst, addr, off) asm volatile("ds_read_b128 %0, %1 offset:%c2" : "=v"(dst) : "v"(addr), "i"(off))
#define DS_RDTR(dst, addr, off) asm volatile("ds_read_b64_tr_b16 %0, %1 offset:%c2" : "=v"(dst) : "v"(addr), "i"(off))
#define DS_RD64(dst, addr, off) asm volatile("ds_read_b64 %0, %1 offset:%c2" : "=v"(dst) : "v"(addr), "i"(off))
__device__ __forceinline__ float silu_f(float x) { return x * __builtin_amdgcn_rcpf(1.f + __expf(-x)); }

#define GLD32(dst, ptr, off) asm volatile("global_load_dword %0, %1, off offset:%c2 sc1" : "=&v"(dst) : "v"(ptr), "i"(off) : "memory")
#define GLD128(dst, ptr) asm volatile("global_load_dwordx4 %0, %1, off" : "=&v"(dst) : "v"(ptr) : "memory")
#define GLD128S(dst, voff, sptr, imm) asm volatile("global_load_dwordx4 %0, %1, %2 offset:%c3" : "=&v"(dst) : "v"(voff), "s"(sptr), "i"(imm) : "memory")
#ifndef FFN_DOWN_FP8
#define FFN_DOWN_FP8 1
#endif
#ifndef MIX_FP8
#define MIX_FP8 1
#endif
constexpr float CAT_Q = 16.f, WO_Q = 512.f;
constexpr float ACT_Q = 2.f, WDN_Q = 1024.f;
__device__ __forceinline__ unsigned pk4_fp8(float a, float b, float c_, float d) {
    a = __builtin_amdgcn_fmed3f(a, -448.f, 448.f); b = __builtin_amdgcn_fmed3f(b, -448.f, 448.f); c_ = __builtin_amdgcn_fmed3f(c_, -448.f, 448.f); d = __builtin_amdgcn_fmed3f(d, -448.f, 448.f);
    int w = 0; w = __builtin_amdgcn_cvt_pk_fp8_f32(a, b, w, false); w = __builtin_amdgcn_cvt_pk_fp8_f32(c_, d, w, true); return (unsigned)w;
}
#ifndef EPI_NT
#define EPI_NT 0
#endif
#if EPI_NT
#define EPI_ST(ptr, val) __builtin_nontemporal_store((val), (ptr))
#else
#define EPI_ST(ptr, val) (*(ptr) = (val))
#endif
__device__ __forceinline__ void st8f(float* p, pg8::f32x4 a, pg8::f32x4 b) { EPI_ST((pg8::f32x4*)p, a); EPI_ST((pg8::f32x4*)(p + 4), b); }
__device__ __forceinline__ void st8b(bf16* p, pg8::f32x4 a, pg8::f32x4 b) { pg8::u32x4 w; w.x = pg8::cvt_pk_bf16(a[0], a[1]); w.y = pg8::cvt_pk_bf16(a[2], a[3]); w.z = pg8::cvt_pk_bf16(b[0], b[1]); w.w = pg8::cvt_pk_bf16(b[2], b[3]); EPI_ST((pg8::u32x4*)p, w); }

struct Epi1 {
    static constexpr bool PERM = true, AFTER_DRAIN = false;
    bf16* H; float* SM; float* out;
    __device__ __forceinline__ void operator()(const pg8::f32x4 (&acc)[2][2][4][2], const pg8::Unit& u, int wr, int wc, int fr, int fq) const {
        const int pn = u.pn;
#pragma unroll
        for (int ai = 0; ai < 2; ++ai)
#pragma unroll
            for (int m = 0; m < 4; ++m) {
                const int row = u.pm * 256 + ai * 128 + wr * 64 + m * 16 + fr;
                const bool prompt = row < NPROW; const int r2 = row - NPROW;
                const int b = prompt ? (row >> 11) : (r2 >> 6), t = prompt ? (row & 2047) : (r2 & 63);
#pragma unroll
                for (int bj = 0; bj < 2; ++bj) {
                    const int col = pn * 256 + bj * 128 + wc * 32 + 8 * fq;
                    const pg8::f32x4 v0 = acc[ai][bj][m][0], v1 = acc[ai][bj][m][1];
                    st8b(H + (size_t)row * LDH + col, v0, v1);
                    if (pn >= 8 && pn < 12) {
                        int c = col - HK; const bool isv = c >= 512; if (isv) c -= 512;
                        float* dst = out + (prompt ? (isv ? O_PV : O_PK) + (size_t)row * 512 : (isv ? O_SV : O_SK) + (size_t)r2 * 512) + c;
                        st8f(dst, v0, v1);
                    } else if (pn >= 16 && pn < 40) {
                        const int tl = prompt ? t - (PSEQ - 3) : t - (SSEQ - 3);
                        if (tl >= 0) st8f(out + (prompt ? O_PCONV : O_SCONV) + (size_t)(b * 3 + tl) * CQKV + (col - HQKV), v0, v1);
                    } else if (pn == 48) {
                        const int c = col - HSM;
                        if (c < 128) st8f(SM + (size_t)row * 128 + c, v0, v1);
                        if (c < 64) st8f(out + (prompt ? O_PIK + (size_t)row * 64 : O_SIK + (size_t)r2 * 64) + c, v0, v1);
                    }
                }
            }
    }
};
struct EpiRes {
    static constexpr bool PERM = true, AFTER_DRAIN = false;
    const bf16* res; bf16* out; int row0; float sc;
    float* p2; unsigned* tix;
    __device__ __forceinline__ void operator()(const pg8::f32x4 (&acc)[2][2][4][2], const pg8::Unit& u, int wr, int wc, int fr, int fq) const {
        const int rowb = row0 + u.pm * 256 + wr * 64 + fr, colb = u.pn * 256 + wc * 32 + 8 * fq;
        if (u.part != 0) {
            float* pt = p2 + (size_t)u.tidx * 65536 + (size_t)(wr * 64 + fr) * 256 + wc * 32 + 8 * fq;
#pragma unroll
            for (int ai = 0; ai < 2; ++ai)
#pragma unroll
                for (int m = 0; m < 4; ++m)
#pragma unroll
                    for (int bj = 0; bj < 2; ++bj) st8f(pt + (size_t)(ai * 128 + m * 16) * 256 + bj * 128, acc[ai][bj][m][0] * sc, acc[ai][bj][m][1] * sc);
            if (wr == 0 && wc == 0 && fr == 0 && fq == 0) tix[u.pm * 16 + u.pn] = (unsigned)u.tidx + 1u;
            return;
        }
        pg8::u32x4 r[2][4][2];
#pragma unroll
        for (int ai = 0; ai < 2; ++ai)
#pragma unroll
            for (int m = 0; m < 4; ++m)
#pragma unroll
                for (int bj = 0; bj < 2; ++bj) GLD128(r[ai][m][bj], res + (size_t)(rowb + ai * 128 + m * 16) * LDX + colb + bj * 128);
        asm volatile("s_waitcnt vmcnt(0)" : "+v"(r[0][0][0]), "+v"(r[0][0][1]), "+v"(r[0][1][0]), "+v"(r[0][1][1]), "+v"(r[0][2][0]), "+v"(r[0][2][1]), "+v"(r[0][3][0]), "+v"(r[0][3][1]),
                                            "+v"(r[1][0][0]), "+v"(r[1][0][1]), "+v"(r[1][1][0]), "+v"(r[1][1][1]), "+v"(r[1][2][0]), "+v"(r[1][2][1]), "+v"(r[1][3][0]), "+v"(r[1][3][1]));
#pragma unroll
        for (int ai = 0; ai < 2; ++ai) {
#pragma unroll
            for (int m = 0; m < 4; ++m) {
                const int row = rowb + ai * 128 + m * 16;
#pragma unroll
                for (int bj = 0; bj < 2; ++bj) {
                    const int col = colb + bj * 128;
                    const pg8::u32x4 rr = r[ai][m][bj];
                    pg8::f32x4 v0 = acc[ai][bj][m][0] * sc, v1 = acc[ai][bj][m][1] * sc;
                    v0[0] += ALPHA * bflo(rr.x); v0[1] += ALPHA * bfhi(rr.x); v0[2] += ALPHA * bflo(rr.y); v0[3] += ALPHA * bfhi(rr.y);
                    v1[0] += ALPHA * bflo(rr.z); v1[1] += ALPHA * bfhi(rr.z); v1[2] += ALPHA * bflo(rr.w); v1[3] += ALPHA * bfhi(rr.w);
                    st8b(out + (size_t)row * DM + col, v0, v1);
                }
            }
        }
    }
};
__device__ __forceinline__ float dpp_ror1(float x) { return __int_as_float(__builtin_amdgcn_mov_dpp(__float_as_int(x), 0x121, 0xf, 0xf, true)); }
__device__ __forceinline__ float dpp_ror2(float x) { return __int_as_float(__builtin_amdgcn_mov_dpp(__float_as_int(x), 0x122, 0xf, 0xf, true)); }
#ifndef UPT_NS
#define UPT_NS 4
#endif
struct EpiUpAct {
    static constexpr bool PERM = true, AFTER_DRAIN = false;
    bf16* ACT; bf16* UPS; float* out; const float* fw; const float* fb; LAS float* wl;
    float* part; unsigned* cnt;
    __device__ __forceinline__ void operator()(const pg8::f32x4 (&acc)[2][2][4][2], const pg8::Unit& u, int wr, int wc, int fr, int fq) const {
        const int colb = u.pn * 128 + wc * 32 + 8 * fq;
        if (u.kn > 0) {
            pg8::f32x4 (&A)[2][2][4][2] = const_cast<pg8::f32x4 (&)[2][2][4][2]>(acc);
            const int lane_ = fq * 16 + fr, ws_ = wr * 4 + wc;
            float* pb = part + (size_t)u.tidx * (UPT_NS * 65536) + ws_ * 8192 + lane_ * 4;
            float* mine = pb + (size_t)u.part * 65536;
#pragma unroll
            for (int ai = 0; ai < 2; ++ai)
#pragma unroll
                for (int bj = 0; bj < 2; ++bj)
#pragma unroll
                    for (int m = 0; m < 4; ++m)
#pragma unroll
                        for (int n = 0; n < 2; ++n) asm volatile("global_store_dwordx4 %0, %1, off sc1" :: "v"(mine + (((ai * 2 + bj) * 4 + m) * 2 + n) * 256), "v"(A[ai][bj][m][n]) : "memory");
            asm volatile("s_waitcnt vmcnt(0)" ::: "memory");
            unsigned old_ = 0u;
            if (lane_ == 0) old_ = __hip_atomic_fetch_add(cnt + u.tidx * 8 + ws_, 1u, __ATOMIC_RELAXED, __HIP_MEMORY_SCOPE_AGENT);
            old_ = __builtin_amdgcn_readfirstlane(old_);
            if (old_ != (unsigned)(UPT_NS - 1)) return;
            __builtin_amdgcn_fence(__ATOMIC_ACQUIRE, "agent");
#pragma unroll 1
            for (int j = 1; j < UPT_NS; ++j) {
                const float* op = pb + (size_t)((u.part + j) % UPT_NS) * 65536;
#pragma unroll
                for (int ai = 0; ai < 2; ++ai)
#pragma unroll
                    for (int bj = 0; bj < 2; ++bj)
#pragma unroll
                        for (int m = 0; m < 4; ++m)
#pragma unroll
                            for (int n = 0; n < 2; ++n) A[ai][bj][m][n] += *(const pg8::f32x4*)(op + (((ai * 2 + bj) * 4 + m) * 2 + n) * 256);
            }
        }
        LAS float* wl_ = wl + (wr * 4 + wc) * 256;
        {
            const int lane_ = fq * 16 + fr, k = lane_ >> 3, c4 = lane_ & 7;
            const float* src = ((k & 3) == 3 ? fb : fw + (k & 3) * DFF2) + (k >> 2) * DFF + u.pn * 128 + wc * 32 + 4 * c4;
            const pg8::f32x4 wv_ = *(const pg8::f32x4*)src * ((FFN_DOWN_FP8 && k >= 4) ? ACT_Q : 1.f);
            *(LAS pg8::f32x4*)(wl_ + lane_ * 4) = wv_;
            LDS_WAIT(); asm volatile("" ::: "memory");
        }
#pragma unroll
        for (int n = 0; n < 2; ++n) {
            const int cg = colb + 4 * n;
            pg8::f32x4 W[1][8];
#pragma unroll
            for (int k = 0; k < 8; ++k) W[0][k] = *(const LAS pg8::f32x4*)(wl_ + (k * 8 + 2 * fq + n) * 4);
            const pg8::f32x4 wg0 = W[0][0], wg1 = W[0][1], wg2 = W[0][2], bg = W[0][3], wv0 = W[0][4], wv1 = W[0][5], wv2 = W[0][6], bv = W[0][7];
#pragma unroll
            for (int ai = 0; ai < 2; ++ai) {
                pg8::f32x4 g1p = {0.f, 0.f, 0.f, 0.f}, g2p = g1p, v1p = g1p, v2p = g1p;
#pragma unroll
                for (int m = 0; m < 4; ++m) {
                    const int row = u.pm * 256 + ai * 128 + wr * 64 + m * 16 + fr;
                    const pg8::f32x4 G = acc[ai][0][m][n], V = acc[ai][1][m][n];
                    pg8::f32x4 g1, g2, v1, v2, a;
#pragma unroll
                    for (int e2 = 0; e2 < 4; e2 += 2) {
                        typedef float f2_t __attribute__((ext_vector_type(2)));
                        f2_t pg1, pg2, pv1, pv2;
#pragma unroll
                        for (int q = 0; q < 2; ++q) { const int e = e2 + q;
                            g1[e] = dpp_ror1(G[e]); g2[e] = dpp_ror2(G[e]); v1[e] = dpp_ror1(V[e]); v2[e] = dpp_ror2(V[e]);
                            pg1[q] = fr == 0 ? g1p[e] : g1[e]; pg2[q] = fr < 2 ? g2p[e] : g2[e]; pv1[q] = fr == 0 ? v1p[e] : v1[e]; pv2[q] = fr < 2 ? v2p[e] : v2[e]; }
                        const f2_t G2 = {G[e2], G[e2 + 1]}, V2 = {V[e2], V[e2 + 1]};
                        const f2_t cg2 = (f2_t){bg[e2], bg[e2 + 1]} + (f2_t){wg0[e2], wg0[e2 + 1]} * pg2 + (f2_t){wg1[e2], wg1[e2 + 1]} * pg1 + (f2_t){wg2[e2], wg2[e2 + 1]} * G2;
                        const f2_t cv2 = (f2_t){bv[e2], bv[e2 + 1]} + (f2_t){wv0[e2], wv0[e2 + 1]} * pv2 + (f2_t){wv1[e2], wv1[e2 + 1]} * pv1 + (f2_t){wv2[e2], wv2[e2 + 1]} * V2;
#pragma unroll
                        for (int q = 0; q < 2; ++q) a[e2 + q] = cg2[q] * __builtin_amdgcn_rcpf(1.f + __expf(-cg2[q])) * cv2[q];
                    }
                    g1p = g1; g2p = g2; v1p = v1; v2p = v2;
                    const bool first2 = (m == 0) && fr < 2;
#if FFN_DOWN_FP8
                    if (!first2) *(unsigned*)((unsigned char*)ACT + (size_t)row * DFF + cg) = pk4_fp8(a[0], a[1], a[2], a[3]);
#else
                    if (!first2) { pg8::u32x4 t; t.x = pg8::cvt_pk_bf16(a[0], a[1]); t.y = pg8::cvt_pk_bf16(a[2], a[3]); *(unsigned long long*)(ACT + (size_t)row * DFF + cg) = (unsigned long long)t.x | ((unsigned long long)t.y << 32); }
#endif
                    if (first2 || ((m == 3) && fr >= 14)) {
                        bf16* us = UPS + (size_t)((row >> 6) * 4 + (((row & 63) + 2) & 63)) * DFF2;
                        *(unsigned long long*)(us + cg) = (unsigned long long)pg8::cvt_pk_bf16(G[0], G[1]) | ((unsigned long long)pg8::cvt_pk_bf16(G[2], G[3]) << 32);
                        *(unsigned long long*)(us + DFF + cg) = (unsigned long long)pg8::cvt_pk_bf16(V[0], V[1]) | ((unsigned long long)pg8::cvt_pk_bf16(V[2], V[3]) << 32);
                    }
                    {
                        const bool prompt = row < NPROW; const int r2 = row - NPROW;
                        const int b = prompt ? (row >> 11) : (r2 >> 6), t = prompt ? (row & 2047) : (r2 & 63);
                        const int tl = prompt ? t - (PSEQ - 2) : t - (SSEQ - 2);
                        if (tl >= 0) { float* so = out + (prompt ? O_PFFN : O_SFFN) + (size_t)(b * 2 + tl) * DFF2; *(pg8::f32x4*)(so + cg) = G; *(pg8::f32x4*)(so + DFF + cg) = V; }
                    }
                }
            }
        }
    }
};

#define XB_TMO      128
#define XB_XCNT(j)  (256  + 64 * (j))
#define XB_XSUB(j)  (1280 + 64 * (j))
#define XB_XGEN(j)  (2304 + 64 * (j))
#define XB_TOP      3328
#define XB_TOPGEN   3392
#define XCD_BAR_WORDS 3456
#define XB_SPIN_CAP (1u << 18)

__device__ __forceinline__ unsigned xb_ld(unsigned* p)              { return __hip_atomic_load(p, __ATOMIC_RELAXED, __HIP_MEMORY_SCOPE_AGENT); }
__device__ __forceinline__ unsigned xb_add(unsigned* p, unsigned v) { return __hip_atomic_fetch_add(p, v, __ATOMIC_RELAXED, __HIP_MEMORY_SCOPE_AGENT); }
__device__ __forceinline__ unsigned xb_xcc_id() { return (unsigned)__builtin_amdgcn_s_getreg((3 << 11) | 20) & 0xFu; }
#define XB_SPIN(cond, bar) do { unsigned _sp = 0; while (cond) { __builtin_amdgcn_s_sleep(1); \
    if ((++_sp & 255u) == 0u) { if (xb_ld(&(bar)[XB_TMO])) break; if (_sp > XB_SPIN_CAP) { atomicAdd(&(bar)[XB_TMO], 1u); break; } } } } while (0)

struct XcdBarrier {
    unsigned* bar; unsigned x;
    volatile LAS unsigned* st;
};

__device__ __forceinline__ XcdBarrier xcd_barrier_post(unsigned* bar, volatile LAS unsigned* st) {
    XcdBarrier b; b.bar = bar; b.x = xb_xcc_id(); b.st = st;
    if (threadIdx.x == 0) (void)xb_add(&bar[XB_XCNT(b.x)], 1u);
    return b;
}
__device__ __forceinline__ void xcd_barrier_complete(unsigned* bar, unsigned x, unsigned& nloc, unsigned& nx) {
    const unsigned G = gridDim.x * gridDim.y * gridDim.z;
    unsigned sum, cnt, mine, sp = 0u;
    for (;;) {
        sum = 0u; cnt = 0u; mine = 0u;
#pragma unroll
        for (unsigned j = 0; j < 16; ++j) { const unsigned c = xb_ld(&bar[XB_XCNT(j)]); sum += c; cnt += (c > 0u) ? 1u : 0u; mine = (j == x) ? c : mine; }
        if (sum == G) break;
        __builtin_amdgcn_s_sleep(1);
        if ((++sp & 255u) == 0u) { if (xb_ld(&bar[XB_TMO])) break; if (sp > XB_SPIN_CAP) { atomicAdd(&bar[XB_TMO], 1u); break; } }
    }
    nloc = mine > 0u ? mine : 1u; nx = cnt > 0u ? cnt : 1u;
}

__device__ __forceinline__ void xcd_barrier(const XcdBarrier& b) {
    asm volatile("s_waitcnt vmcnt(0)" ::: "memory");
    __syncthreads();
    if (threadIdx.x == 0) {
        unsigned* bar = b.bar;
        __builtin_amdgcn_s_waitcnt(0);
        unsigned nloc = b.st[0], nx = b.st[1];
        if (nloc == 0u) { xcd_barrier_complete(bar, b.x, nloc, nx); b.st[0] = nloc; b.st[1] = nx; }
        const unsigned old = xb_add(&bar[XB_XSUB(b.x)], 1u);
        const unsigned gen = old / nloc;
        if (old + 1u == (gen + 1u) * nloc) {
            __builtin_amdgcn_fence(__ATOMIC_RELEASE, "agent");
            asm volatile("s_waitcnt vmcnt(0)" ::: "memory");
            const unsigned og = xb_add(&bar[XB_TOP], 1u);
            const unsigned tg = og / nx;
            if (og + 1u == (tg + 1u) * nx) xb_add(&bar[XB_TOPGEN], 1u);
            else XB_SPIN(xb_ld(&bar[XB_TOPGEN]) == tg, bar);
            __builtin_amdgcn_fence(__ATOMIC_ACQUIRE, "agent");
            xb_add(&bar[XB_XGEN(b.x)], 1u);
            asm volatile("s_waitcnt vmcnt(0)" ::: "memory");
        } else {
            XB_SPIN(xb_ld(&bar[XB_XGEN(b.x)]) == gen, bar);
            __builtin_amdgcn_fence(__ATOMIC_ACQUIRE, "agent");
            asm volatile("s_waitcnt vmcnt(0)" ::: "memory");
        }
    }
    __syncthreads();
}

struct Ctx {
    float* out; unsigned char* ws;
    LAS unsigned char* lds; gu32* ctl;
    int tid, lane, wave, G, bid;
};
enum { I_XP = 0, I_XS, I_CK, I_CV, I_CIK, I_SDELTA, I_SCONV, I_SFFN, I_LNG, I_LNB, I_WIN, I_CQW, I_CQB, I_ALOG, I_DTB, I_DNG, I_RELB, I_WO, I_LN1G, I_LN1B, I_WUP, I_FCW, I_FCB, I_WDN, I_LN2G, I_LN2B };

constexpr int PTAB_OFF = LDSCTL_OFF + 1024;
__device__ __forceinline__ const float* inp(const Ctx& C, int i) {
    const unsigned long long v = ((const LAS unsigned long long*)(C.lds + PTAB_OFF))[i];
    const unsigned lo = __builtin_amdgcn_readfirstlane((unsigned)v), hi = __builtin_amdgcn_readfirstlane((unsigned)(v >> 32));
    return (const float*)(const GAS float*)(size_t)(((unsigned long long)hi << 32) | lo);
}
__device__ __forceinline__ int q_next(const Ctx& C, int cw) {
    volatile LAS unsigned* slot = (volatile LAS unsigned*)(C.lds + MISC_OFF) + 16;
    __syncthreads();
    if (C.tid == 0) *slot = __hip_atomic_fetch_add((unsigned*)(C.ctl + cw), 1u, __ATOMIC_RELAXED, __HIP_MEMORY_SCOPE_AGENT);
    __syncthreads();
    return (int)*slot;
}

template <int MODE> __device__ __forceinline__ int dst_row_map(int n) {
    if (MODE == 0 || MODE == 3 || MODE == 4) return n;
    if (MODE == 2) { const int v = n >= DFF, j = v ? n - DFF : n; return (j >> 7) * 256 + v * 128 + (j & 127); }
    if (n < 4096) return n;
    if (n < 4160) return HSM + (n - 4096);
    if (n < 4176) return HSM + 64 + (n - 4160);
    if (n < 12368) return n - 80;
    return n;
}
__device__ __forceinline__ void tr_load(const float* W, int K, int N, int item, int lane, float (&v)[32]) {
    const int nblk = (N + 31) / 32, kb = item / nblk, nb = item % nblk, k0 = 64 * kb, n0 = 32 * nb;
    const int nn = min(n0 + (lane & 31), N - 1);
    const float* src = W + (size_t)(k0 + (lane >> 5)) * N + nn;
#pragma unroll
    for (int i = 0; i < 32; ++i) v[i] = src[(size_t)(2 * i) * N];
}
template <int MODE> __device__ __forceinline__ void tr_store(int K, int N, bf16* WT, LAS float* scr, int item, int lane, const float (&v)[32]) {
    const int ldw = (MODE == 1 || MODE == 2) ? LDX : K;
    const int nblk = (N + 31) / 32, kb = item / nblk, nb = item % nblk, k0 = 64 * kb, n0 = 32 * nb;
#pragma unroll
    for (int i = 0; i < 32; ++i) scr[(2 * i + (lane >> 5)) * 33 + (lane & 31)] = v[i];
    LDS_WAIT(); asm volatile("" ::: "memory");
    const int c = lane & 7;
#pragma unroll
    for (int j = 0; j < 4; ++j) { const int n = (lane >> 3) + 8 * j; const LAS float* s = scr + (8 * c) * 33 + n;
        v4u o; o.x = pk2(s[0 * 33], s[1 * 33]); o.y = pk2(s[2 * 33], s[3 * 33]); o.z = pk2(s[4 * 33], s[5 * 33]); o.w = pk2(s[6 * 33], s[7 * 33]);
        if (MODE == 3 || MODE == 4) { const float WQ_ = MODE == 3 ? WDN_Q : WO_Q; if (n0 + n < N) { v2u q; q.x = pk4_fp8(s[0 * 33] * WQ_, s[1 * 33] * WQ_, s[2 * 33] * WQ_, s[3 * 33] * WQ_); q.y = pk4_fp8(s[4 * 33] * WQ_, s[5 * 33] * WQ_, s[6 * 33] * WQ_, s[7 * 33] * WQ_);
                                          *(v2u*)((unsigned char*)WT + (size_t)(n0 + n) * K + k0 + 8 * c) = q; } }
        else if (n0 + n < N) *(v4u*)(WT + (size_t)dst_row_map<MODE>(n0 + n) * ldw + k0 + 8 * c) = o; }
    LDS_WAIT(); asm volatile("" ::: "memory");
}
template <int MODE> __device__ __forceinline__ void transpose_static(const float* W, int K, int N, bf16* WT, int total, LAS float* scr, int gw, int NGW, int lane) {
    float a[32], b[32];
    int it = gw;
    if (it >= total) return;
    tr_load(W, K, N, it, lane, a);
#pragma unroll 1
    for (;;) {
        const int it1 = it + NGW, it2 = it1 + NGW;
        tr_load(W, K, N, min(it1, total - 1), lane, b);
        tr_store<MODE>(K, N, WT, scr, it, lane, a);
        if (it1 >= total) break;
        tr_load(W, K, N, min(it2, total - 1), lane, a);
        tr_store<MODE>(K, N, WT, scr, it1, lane, b);
        if (it2 >= total) break;
        it = it2;
    }
}
__device__ __forceinline__ int wup_item(int v) {
    if (v < 18432) { const int kb = v / 288, e = v - kb * 288; return kb * 688 + (e < 144 ? e : e + 200); }
    const int w = v - 18432, kb = w / 400, e = w - kb * 400; return kb * 688 + (e < 200 ? e + 144 : e + 288);
}
template <int MODE, bool UPMAP = false> __device__ __forceinline__ void transpose_queue(const Ctx& C, const float* W, int K, int N, bf16* WT, int nitems, int cw, int g_lo = 0, int g_hi = 1 << 30, int scr_base = 0, int scr_stride = 16384) {
    LAS float* scr = (LAS float*)(C.lds + scr_base + C.wave * scr_stride);
    volatile LAS unsigned* slot = (volatile LAS unsigned*)(C.lds + MISC_OFF) + 16;
    const int ngrab = min((nitems + 15) / 16, g_hi);
    int g = g_lo + q_next(C, cw);
    if (g >= ngrab) return;
    float a[32], b[32];
    tr_load(W, K, N, UPMAP ? wup_item(min(g * 16 + C.wave, nitems - 1)) : min(g * 16 + C.wave, nitems - 1), C.lane, a);
#pragma unroll 1
    for (;;) {
        const int i0 = g * 16 + C.wave, i1 = i0 + 8;
        unsigned tk = 0u;
        if (C.tid == 0) tk = __hip_atomic_fetch_add((unsigned*)(C.ctl + cw), 1u, __ATOMIC_RELAXED, __HIP_MEMORY_SCOPE_AGENT);
        tr_load(W, K, N, UPMAP ? wup_item(min(i1, nitems - 1)) : min(i1, nitems - 1), C.lane, b);
        if (i0 < nitems) tr_store<MODE>(K, N, WT, scr, UPMAP ? wup_item(i0) : i0, C.lane, a);
        __syncthreads();
        if (C.tid == 0) *slot = tk;
        __syncthreads();
        const int gn = g_lo + (int)*slot;
        tr_load(W, K, N, UPMAP ? wup_item(min(gn * 16 + C.wave, nitems - 1)) : min(gn * 16 + C.wave, nitems - 1), C.lane, a);
        if (i1 < nitems) tr_store<MODE>(K, N, WT, scr, UPMAP ? wup_item(i1) : i1, C.lane, b);
        if (gn >= ngrab) break;
        g = gn;
    }
}
template <int MODE> __device__ __forceinline__ bool transpose_grabs(const Ctx& C, const float* W, int K, int N, bf16* WT, int nitems, int cw, int g_lo, int g_hi, int scr_base, int scr_stride, int ngr) {
    LAS float* scr = (LAS float*)(C.lds + scr_base + C.wave * scr_stride);
    const int ngrab = min((nitems + 15) / 16, g_hi);
#pragma unroll 1
    for (int j = 0; j < ngr; ++j) {
        const int g = g_lo + q_next(C, cw); if (g >= ngrab) return false;
        const int i0 = g * 16 + C.wave, i1 = i0 + 8;
        float a[32], b[32];
        tr_load(W, K, N, min(i0, nitems - 1), C.lane, a);
        tr_load(W, K, N, min(i1, nitems - 1), C.lane, b);
        if (i0 < nitems) tr_store<MODE>(K, N, WT, scr, i0, C.lane, a);
        if (i1 < nitems) tr_store<MODE>(K, N, WT, scr, i1, C.lane, b);
    }
    return true;
}
struct LnP { f32x4 g[16], b[16]; };
__device__ __forceinline__ void ln_params(LnP& P, const float* g, const float* bta, int lane) {
#pragma unroll
    for (int j = 0; j < 16; ++j) { P.g[j] = ((const f32x4*)g)[lane + 64 * j]; P.b[j] = ((const f32x4*)bta)[lane + 64 * j]; }
}
template <bool F32OUT, bool TAIL = false, bool INBF = false> __device__ __forceinline__ void ln_row(const void* xrow, const LnP& P, void* orow, int lane, const unsigned* tix16 = nullptr, const float* p2 = nullptr, int rin = 0) {
    f32x4 v[16]; float s = 0.f;
    if (INBF) {
        const v2u* xr = (const v2u*)xrow + lane;
#pragma unroll
        for (int j = 0; j < 16; ++j) { const v2u w = xr[64 * j]; v[j] = (f32x4){bflo(w.x), bfhi(w.x), bflo(w.y), bfhi(w.y)}; }
    } else {
        const f32x4* xr = (const f32x4*)xrow + lane;
#pragma unroll
        for (int j = 0; j < 16; ++j) v[j] = xr[64 * j];
    }
    if (TAIL) {
        unsigned tt[16], any = 0u;
#pragma unroll
        for (int j = 0; j < 16; ++j) { tt[j] = __builtin_amdgcn_readfirstlane(tix16[j]); any |= tt[j]; }
        if (any) {
#pragma unroll
            for (int h = 0; h < 4; ++h) {
                f32x4 pv[4];
#pragma unroll
                for (int j = 0; j < 4; ++j) { const unsigned t = tt[4 * h + j]; pv[j] = *(const f32x4*)(p2 + (size_t)(t ? t - 1u : 0u) * 65536 + (size_t)rin * 256 + lane * 4); }
#pragma unroll
                for (int j = 0; j < 4; ++j) { const float on = tt[4 * h + j] ? 1.f : 0.f; v[4 * h + j] += pv[j] * on; }
            }
        }
    }
#pragma unroll
    for (int j = 0; j < 16; ++j) s += (v[j].x + v[j].y) + (v[j].z + v[j].w);
    const float mean = wave_sum(s) * (1.f / DM); float s2 = 0.f;
#pragma unroll
    for (int j = 0; j < 16; ++j) { v[j] = v[j] - mean; s2 += (v[j].x * v[j].x + v[j].y * v[j].y) + (v[j].z * v[j].z + v[j].w * v[j].w); }
    const float rstd = 1.f / sqrtf(wave_sum(s2) * (1.f / DM) + LN_EPS);
#pragma unroll
    for (int j = 0; j < 16; ++j) {
        const f32x4 y = v[j] * rstd * P.g[j] + P.b[j];
        if (F32OUT) ((f32x4*)orow)[lane + 64 * j] = y;
        else { v2u w; w.x = pk2(y.x, y.y); w.y = pk2(y.z, y.w); ((v2u*)orow)[lane + 64 * j] = w; }
    }
}

#ifndef LN_PIPE
#define LN_PIPE 0
#endif
__device__ __forceinline__ void ln_ld(f32x4 (&v)[16], const float* xrow, int lane) {
    const unsigned vo = 16u * (unsigned)lane;
#pragma unroll
    for (int j = 0; j < 16; ++j) GLD128S(v[j], vo + 4096u * (j >> 2), xrow, 1024 * (j & 3));
}
#define LN_WAIT(N, v) asm volatile("s_waitcnt vmcnt(" #N ")" : "+v"(v[0]), "+v"(v[1]), "+v"(v[2]), "+v"(v[3]), "+v"(v[4]), "+v"(v[5]), "+v"(v[6]), "+v"(v[7]), "+v"(v[8]), "+v"(v[9]), "+v"(v[10]), "+v"(v[11]), "+v"(v[12]), "+v"(v[13]), "+v"(v[14]), "+v"(v[15]))
__device__ __forceinline__ void ln_fin(f32x4 (&v)[16], const LAS f32x4* gl, const LAS f32x4* bl, bf16* orow, int lane) {
    float s = 0.f;
#pragma unroll
    for (int j = 0; j < 16; ++j) s += (v[j].x + v[j].y) + (v[j].z + v[j].w);
    const float mean = wave_sum(s) * (1.f / DM); float s2 = 0.f;
#pragma unroll
    for (int j = 0; j < 16; ++j) { v[j] = v[j] - mean; s2 += (v[j].x * v[j].x + v[j].y * v[j].y) + (v[j].z * v[j].z + v[j].w * v[j].w); }
    const float rstd = 1.f / sqrtf(wave_sum(s2) * (1.f / DM) + LN_EPS);
    const unsigned ga = (unsigned)(size_t)gl + 16u * lane;
#pragma unroll
    for (int q = 0; q < 4; ++q) {
        f32x4 g4[4], b4[4];
#pragma unroll
        for (int j = 0; j < 4; ++j) { DS_RD128(g4[j], ga, 1024 * (4 * q + j)); DS_RD128(b4[j], ga, 16384 + 1024 * (4 * q + j)); }
        asm volatile("s_waitcnt lgkmcnt(0)" : "+v"(g4[0]), "+v"(g4[1]), "+v"(g4[2]), "+v"(g4[3]), "+v"(b4[0]), "+v"(b4[1]), "+v"(b4[2]), "+v"(b4[3]));
#pragma unroll
        for (int j = 0; j < 4; ++j) {
            const f32x4 y = v[4 * q + j] * rstd * g4[j] + b4[j];
            v2u w; w.x = pk2(y.x, y.y); w.y = pk2(y.z, y.w); ((v2u*)orow)[lane + 64 * (4 * q + j)] = w;
        }
    }
    (void)bl;
}
__device__ __forceinline__ void phase0(const Ctx& C) {
    LAS float* scr = (LAS float*)(C.lds + C.wave * 16384);
    const int gw = C.bid * NWAVES + C.wave, NGW = C.G * NWAVES;
    bf16* WinT = (bf16*)(C.ws + WS_WIN); bf16* WoT = (bf16*)(C.ws + WS_WO); bf16* XN = (bf16*)(C.ws + WS_XN);
    constexpr int I_IN = (DM / 64) * ((NIN + 31) / 32), I_O = (DM / 64) * (DM / 32);
    transpose_static<1>(inp(C, I_WIN), DM, NIN, WinT, I_IN, scr, gw, NGW, C.lane);
    (void)WoT; (void)I_O;
    for (int i = gw * 64 + C.lane; i < 144 * (LDX / 8); i += NGW * 64) ((v4u*)(WinT + (size_t)NIN * LDX))[i] = (v4u){0u, 0u, 0u, 0u};
#if defined(PROBE_DUP) && PROBE_DUP == 13
    transpose_static<1>(inp(C, I_WIN), DM, NIN, WinT, I_IN, scr, gw, NGW, C.lane);
#endif
#if LN_PIPE
    {
        __syncthreads();
        LAS f32x4* gl = (LAS f32x4*)C.lds; LAS f32x4* bl = gl + DM / 4;
        for (int i = C.tid; i < DM / 4; i += NWAVES * 64) { gl[i] = ((const f32x4*)inp(C, I_LNG))[i]; bl[i] = ((const f32x4*)inp(C, I_LNB))[i]; }
        __syncthreads();
        const float* xp = inp(C, I_XP); const float* xs = inp(C, I_XS);
        f32x4 va[16], vb[16];
        int m = gw;
        if (m < MTOK) {
            ln_ld(va, m < NPROW ? xp + (size_t)m * DM : xs + (size_t)(m - NPROW) * DM, C.lane);
            LN_WAIT(0, va);
#pragma unroll 1
            for (;;) {
                const int m1 = m + NGW, m1c = min(m1, MTOK - 1), m2 = m1 + NGW, m2c = min(m2, MTOK - 1);
                ln_ld(vb, m1c < NPROW ? xp + (size_t)m1c * DM : xs + (size_t)(m1c - NPROW) * DM, C.lane);
                LN_WAIT(32, va);
                ln_fin(va, gl, bl, XN + (size_t)m * LDX, C.lane);
                if (m1 >= MTOK) break;
                ln_ld(va, m2c < NPROW ? xp + (size_t)m2c * DM : xs + (size_t)(m2c - NPROW) * DM, C.lane);
                LN_WAIT(32, vb);
                ln_fin(vb, gl, bl, XN + (size_t)m1 * LDX, C.lane);
                if (m2 >= MTOK) break;
                m = m2;
            }
            asm volatile("s_waitcnt vmcnt(0)" ::: "memory");
        }
    }
#else
    LnP P; ln_params(P, inp(C, I_LNG), inp(C, I_LNB), C.lane);
#pragma unroll 1
    for (int m = gw; m < MTOK; m += NGW) {
        const float* xr = m < NPROW ? inp(C, I_XP) + (size_t)m * DM : inp(C, I_XS) + (size_t)(m - NPROW) * DM;
        ln_row<false>(xr, P, XN + (size_t)m * LDX, C.lane);
    }
#endif
#if defined(PROBE_DUP) && PROBE_DUP == 14
#pragma unroll 1
    for (int m = gw; m < MTOK; m += NGW) {
        const float* xr = m < NPROW ? inp(C, I_XP) + (size_t)m * DM : inp(C, I_XS) + (size_t)(m - NPROW) * DM;
        ln_row<false>(xr, P, XN + (size_t)m * LDX, C.lane);
    }
#endif
}

__device__ __forceinline__ void select_row(const Ctx& C, int row, int L, unsigned long long* msk, int lane) {
    const float* SC = C.out + OS_SC;
    if (L <= TOPK) { if (lane < 32) msk[lane] = (64 * lane < L) ? ~0ull : 0ull; return; }
    unsigned v[32];
    {
        const float* p0 = SC + (size_t)row * 2048 + lane; const float* p1 = p0 + 1024;
#pragma unroll
        for (int i = 0; i < 16; ++i) { GLD32(v[i], p0, i * 256); GLD32(v[16 + i], p1, i * 256); }
        asm volatile("s_waitcnt vmcnt(0)" : "+v"(v[0]), "+v"(v[1]), "+v"(v[2]), "+v"(v[3]), "+v"(v[4]), "+v"(v[5]), "+v"(v[6]), "+v"(v[7]), "+v"(v[8]), "+v"(v[9]), "+v"(v[10]), "+v"(v[11]), "+v"(v[12]), "+v"(v[13]), "+v"(v[14]), "+v"(v[15]));
        asm volatile("" : "+v"(v[16]), "+v"(v[17]), "+v"(v[18]), "+v"(v[19]), "+v"(v[20]), "+v"(v[21]), "+v"(v[22]), "+v"(v[23]), "+v"(v[24]), "+v"(v[25]), "+v"(v[26]), "+v"(v[27]), "+v"(v[28]), "+v"(v[29]), "+v"(v[30]), "+v"(v[31]));
        int Lr = L; asm volatile("" : "+s"(Lr));
#pragma unroll
        for (int i = 0; i < 32; ++i) { unsigned u = v[i]; u = (u & 0x80000000u) ? ~u : (u | 0x80000000u); v[i] = (lane + 64 * i < Lr) ? u : 0u; }
    }
    unsigned T = 0u;
    for (int bit = 31; bit >= 0; --bit) {
        const unsigned cand = T | (1u << bit); int cnt = 0;
#pragma unroll
        for (int i = 0; i < 32; ++i) cnt += __popcll(__ballot(v[i] >= cand));
        if (cnt >= TOPK) { T = cand; if (cnt == TOPK) break; }
    }
    int cgt = 0;
#pragma unroll
    for (int i = 0; i < 32; ++i) cgt += __popcll(__ballot(v[i] > T));
    const int need = TOPK - cgt;
    const unsigned long long ltm = (1ull << lane) - 1ull;
    int eqb = 0;
#pragma unroll
    for (int i = 0; i < 32; ++i) {
        const bool gt = v[i] > T, eq = v[i] == T;
        const unsigned long long eqm = __ballot(eq);
        const int myeq = eqb + __popcll(eqm & ltm);
        const unsigned long long sm = __ballot(gt || (eq && myeq < need));
        if (lane == 0) msk[i] = sm;
        eqb += __popcll(eqm);
    }
}
__device__ __forceinline__ float relu_i(float x) { const int b = __builtin_bit_cast(int, x); return __builtin_bit_cast(float, b > 0 ? b : 0); }
__device__ __forceinline__ float relu_f(float x) { return __builtin_amdgcn_fmed3f(x, 0.f, __builtin_inff()); }
template <bool DOSEL = true> __device__ __forceinline__ void idx_unit(const Ctx& C, int item) {
    bool prompt; int b, c;
    if (item < 120) { prompt = true; c = 31 - item / 8; b = item % 8; }
    else if (item < 152) { prompt = false; c = 0; b = item - 120; }
    else { prompt = true; const int j = item - 152; c = 16 - j / 8; b = j % 8; }
    const bf16* H = (const bf16*)(C.ws + WS_H);
    const float* SM = C.out + OS_SM; float* SC = C.out + OS_SC;
    const int row0 = prompt ? b * PSEQ + c * 64 : NPROW + b * SSEQ;
    const int nkt = prompt ? c + 1 : (PAST + SSEQ) / 64;
    int lane_ = C.lane; asm volatile("" : "+v"(lane_));
    const int lane = lane_, l15 = lane & 15, l4 = lane >> 4;
    LAS float* wl = (LAS float*)(C.lds + EPIW_OFF);
    LAS unsigned char* QL = C.lds;
    __syncthreads();
    for (int i = C.tid; i < 1024; i += NWAVES * 64) wl[i] = SM[(size_t)(row0 + (i >> 4)) * 128 + 64 + (i & 15)] * IDX_SCALE;
    {
        const bf16* qsrc = H + (size_t)(row0 + (C.tid >> 7)) * LDH + HIQ + (C.tid & 127) * 8;
        v4u qv[16];
#pragma unroll
        for (int k = 0; k < 16; ++k) qv[k] = *(const v4u*)(qsrc + (size_t)(4 * k) * LDH);
#pragma unroll
        for (int k = 0; k < 16; ++k) { const int row = (C.tid >> 7) + 4 * k, p = C.tid & 127; *(LAS v4u*)(QL + row * 2048 + ((p ^ (row & 15)) << 4)) = qv[k]; }
    }
    __syncthreads();
    const unsigned qrb = (unsigned)(size_t)QL + (unsigned)l15 * 2048u;
    const unsigned qlo00 = qrb + (unsigned)(((0 + l4) ^ l15) << 4), qlo01 = qrb + (unsigned)(((4 + l4) ^ l15) << 4), qlo10 = qrb + (unsigned)(((8 + l4) ^ l15) << 4), qlo11 = qrb + (unsigned)(((12 + l4) ^ l15) << 4);
#define IDX_QRD(dst, a0, a1) do { const unsigned b0_ = (a0) + 65536u, b1_ = (a1) + 65536u; \
        DS_RD128(dst[0][0], a0, 0); DS_RD128(dst[0][1], a1, 0); DS_RD128(dst[1][0], a0, 32768); DS_RD128(dst[1][1], a1, 32768); \
        DS_RD128(dst[2][0], b0_, 0); DS_RD128(dst[2][1], b1_, 0); DS_RD128(dst[3][0], b0_, 32768); DS_RD128(dst[3][1], b1_, 32768); } while (0)
#define IDX_QWAIT(f) asm volatile("s_waitcnt lgkmcnt(0)" : "+v"(f[0][0]), "+v"(f[0][1]), "+v"(f[1][0]), "+v"(f[1][1]), "+v"(f[2][0]), "+v"(f[2][1]), "+v"(f[3][0]), "+v"(f[3][1]))
#define IDX_HEAD(f, HH) do { float w[4]; \
        _Pragma("unroll") for (int qb = 0; qb < 4; ++qb) w[qb] = wl[(qb * 16 + l15) * 16 + (HH)]; \
        _Pragma("unroll") for (int kb = 0; kb < 4; ++kb) {     \
            f32x4 a[4]; \
            _Pragma("unroll") for (int qb = 0; qb < 4; ++qb) a[qb] = __builtin_amdgcn_mfma_f32_16x16x32_bf16(afr[kb][0], f[qb][0], (f32x4){0.f, 0.f, 0.f, 0.f}, 0, 0, 0); \
            _Pragma("unroll") for (int qb = 0; qb < 4; ++qb) a[qb] = __builtin_amdgcn_mfma_f32_16x16x32_bf16(afr[kb][1], f[qb][1], a[qb], 0, 0, 0); \
            __builtin_amdgcn_sched_barrier(0); \
            _Pragma("unroll") for (int qb = 0; qb < 4; ++qb) { const f32x4 av = a[qb]; \
                  \
                const f32x4 rv = (f32x4){relu_i(av[0]), relu_i(av[1]), relu_i(av[2]), relu_i(av[3])}; \
                idx[kb][qb] += rv * w[qb]; } \
            __builtin_amdgcn_sched_barrier(0); } } while (0)
    for (int kt = C.wave; kt < nkt; kt += NWAVES) {
        bf16x8 afr[4][2];
        if (prompt || kt == nkt - 1) {
            const int krow0 = prompt ? b * PSEQ + kt * 64 : NPROW + b * SSEQ;
#pragma unroll
            for (int kb = 0; kb < 4; ++kb)
#pragma unroll
                for (int ks = 0; ks < 2; ++ks) afr[kb][ks] = *(const bf16x8*)(H + (size_t)(krow0 + kb * 16 + l15) * LDH + HSM + ks * 32 + l4 * 8);
        } else {
            const float* ck = inp(C, I_CIK) + ((size_t)b * PAST + kt * 64) * 64;
#pragma unroll
            for (int kb = 0; kb < 4; ++kb)
#pragma unroll
                for (int ks = 0; ks < 2; ++ks) {
                    const f32x4* p = (const f32x4*)(ck + (size_t)(kb * 16 + l15) * 64 + ks * 32 + l4 * 8);
                    const f32x4 x0 = p[0], x1 = p[1]; v4u w; w.x = pk2(x0.x, x0.y); w.y = pk2(x0.z, x0.w); w.z = pk2(x1.x, x1.y); w.w = pk2(x1.z, x1.w);
                    afr[kb][ks] = __builtin_bit_cast(bf16x8, w);
                }
        }
        f32x4 idx[4][4];
#pragma unroll
        for (int kb = 0; kb < 4; ++kb)
#pragma unroll
            for (int qb = 0; qb < 4; ++qb) idx[kb][qb] = (f32x4){0.f, 0.f, 0.f, 0.f};
        bf16x8 bfr[4][2], bnx[4][2];
        IDX_QRD(bfr, qlo00, qlo01); IDX_QWAIT(bfr);
#pragma unroll 1
        for (int hp = 0; hp < 8; ++hp) {
            const unsigned ho = (unsigned)hp * 256u, hn = (unsigned)(hp < 7 ? hp + 1 : 7) * 256u;
            IDX_QRD(bnx, qlo10 + ho, qlo11 + ho);
            __builtin_amdgcn_sched_barrier(0);
            IDX_HEAD(bfr, 2 * hp);
            __builtin_amdgcn_sched_barrier(0);
            IDX_QWAIT(bnx);
            IDX_QRD(bfr, qlo00 + hn, qlo01 + hn);
            __builtin_amdgcn_sched_barrier(0);
            IDX_HEAD(bnx, 2 * hp + 1);
            __builtin_amdgcn_sched_barrier(0);
            IDX_QWAIT(bfr);
        }
#pragma unroll
        for (int kb = 0; kb < 4; ++kb)
#pragma unroll
            for (int qb = 0; qb < 4; ++qb)
                *(f32x4*)(SC + (size_t)(row0 + qb * 16 + l15) * 2048 + kt * 64 + kb * 16 + l4 * 4) = idx[kb][qb];
    }
#undef IDX_QRD
#undef IDX_QWAIT
#undef IDX_HEAD
    __syncthreads();
    if (DOSEL) {
        unsigned long long* MG = (unsigned long long*)(C.out + OS_MSK);
        const int Lq = prompt ? (c + 1) * 64 : SLEN;
#pragma unroll 1
        for (int j = 0; j < 8; ++j) { const int row = row0 + C.wave * 8 + j; select_row(C, row, Lq, MG + (size_t)row * 32, lane); }
    }
}
__device__ __forceinline__ void prep_unit(const Ctx& C, int tb) {
    const bf16* H = (const bf16*)(C.ws + WS_H); bf16* QKVC = (bf16*)(C.ws + WS_QKVC);
    const int R0 = tb * 16; const bool prompt = R0 < NPROW; const int r2 = R0 - NPROW;
    const int b = prompt ? (R0 >> 11) : (r2 >> 6), t0 = prompt ? (R0 & 2047) : (r2 & 63);
    const float* cw = inp(C, I_CQW); const float* cb = inp(C, I_CQB); const float* st = inp(C, I_SCONV);
    for (int seg = C.wave; seg < 48; seg += NWAVES) {
        const int c = seg * 128 + 2 * C.lane;
        const f32x2 w0 = *(const f32x2*)(cw + c), w1 = *(const f32x2*)(cw + CQKV + c), w2 = *(const f32x2*)(cw + 2 * CQKV + c), w3 = *(const f32x2*)(cw + 3 * CQKV + c), bi = *(const f32x2*)(cb + c);
        f32x2 xm3, xm2, xm1;
        if (t0 > 0) {
            const unsigned a = *(const unsigned*)(H + (size_t)(R0 - 3) * LDH + HQKV + c), bq = *(const unsigned*)(H + (size_t)(R0 - 2) * LDH + HQKV + c), cq = *(const unsigned*)(H + (size_t)(R0 - 1) * LDH + HQKV + c);
            xm3 = (f32x2){bflo(a), bfhi(a)}; xm2 = (f32x2){bflo(bq), bfhi(bq)}; xm1 = (f32x2){bflo(cq), bfhi(cq)};
        } else if (prompt) { xm3 = xm2 = xm1 = (f32x2){0.f, 0.f}; }
        else { xm3 = *(const f32x2*)(st + (size_t)(b * 3 + 0) * CQKV + c); xm2 = *(const f32x2*)(st + (size_t)(b * 3 + 1) * CQKV + c); xm1 = *(const f32x2*)(st + (size_t)(b * 3 + 2) * CQKV + c); }
        const float post = seg < 16 ? QSCALE : 1.f;
#pragma unroll 4
        for (int i = 0; i < 16; ++i) {
            const unsigned xw = *(const unsigned*)(H + (size_t)(R0 + i) * LDH + HQKV + c);
            const f32x2 x0 = (f32x2){bflo(xw), bfhi(xw)};
            f32x2 y = bi + w0 * xm3 + w1 * xm2 + w2 * xm1 + w3 * x0;
            y.x = silu_f(y.x); y.y = silu_f(y.y);
            if (seg < 32) { const float ss = wave_sum(y.x * y.x + y.y * y.y); const float sc = post / sqrtf(ss + 1e-6f); y.x *= sc; y.y *= sc; }
            *(unsigned*)(QKVC + (size_t)(R0 + i) * CQKV + c) = pk2(y.x, y.y);
            xm3 = xm2; xm2 = xm1; xm1 = x0;
        }
    }
}

constexpr int DCH = 32;
__device__ __forceinline__ void delta_unit(const Ctx& C, int item) {
    const bool prompt = item < 128; const int j2 = item - 128;
    const int b = prompt ? item >> 4 : j2 >> 4, h = item & 15;
    const int T = prompt ? PSEQ : SSEQ, rowbase = prompt ? b * PSEQ : NPROW + b * SSEQ;
    const bf16* H = (const bf16*)(C.ws + WS_H); const bf16* QKVC = (const bf16*)(C.ws + WS_QKVC); bf16* CAT = (bf16*)(C.ws + WS_CAT);
    const float* SM = C.out + OS_SM;
    LAS float* qs = (LAS float*)(C.lds + 16384);
    LAS float* ks = qs + DCH * 128;
    LAS float* vs = ks + DCH * 128;
    LAS float* os = vs + DCH * 128;
    LAS float* xch = os + DCH * 128;
    LAS float* sc = xch + 2 * 4 * 128 * 2;
    int tid_ = C.tid; asm volatile("" : "+v"(tid_));
    const int tid = tid_, e = tid & 127, part = __builtin_amdgcn_readfirstlane(tid >> 7), lane = tid & 63, wave = __builtin_amdgcn_readfirstlane(tid >> 6);
    float S[32];
    if (prompt) {
#pragma unroll
        for (int i = 0; i < 32; ++i) S[i] = 0.f;
    } else {
        const float* s0 = inp(C, I_SDELTA) + ((size_t)(b * 16 + h) * 128 + part * 32) * 128 + e;
#pragma unroll
        for (int i = 0; i < 32; ++i) S[i] = s0[(size_t)i * 128];
    }
    const float Aexp = expf(inp(C, I_ALOG)[h]), dtb = inp(C, I_DTB)[h];
    const f32x2 gn = *(const f32x2*)(inp(C, I_DNG) + 2 * lane);
    for (int c0 = 0; c0 < T; c0 += DCH) {
        __syncthreads();
        for (int idx = tid; idx < DCH * 192; idx += NWAVES * 64) {
            const int r = idx / 192, p = idx % 192, which = p >> 6, pp = p & 63;
            const unsigned w = *(const unsigned*)(QKVC + (size_t)(rowbase + c0 + r) * CQKV + which * 2048 + h * 128 + 2 * pp);
            LAS float* dst = (which == 0 ? qs : which == 1 ? ks : vs) + r * 128 + 2 * pp;
            dst[0] = bflo(w); dst[1] = bfhi(w);
        }
        if (tid < DCH) {
            const size_t row = (size_t)(rowbase + c0 + tid);
            const float a_in = SM[row * 128 + 96 + h], b_in = SM[row * 128 + 80 + h];
            const float x = a_in + dtb; const float sp = x > 20.f ? x : log1pf(expf(x));
            sc[tid * 4 + 0] = expf(-Aexp * sp); sc[tid * 4 + 1] = 1.f / (1.f + expf(-b_in));
        }
        __syncthreads();
        for (int r = wave; r < DCH; r += NWAVES) {
            const float d = qs[r * 128 + 2 * lane] * ks[r * 128 + 2 * lane] + qs[r * 128 + 2 * lane + 1] * ks[r * 128 + 2 * lane + 1];
            const float s = wave_sum(d); if (lane == 0) sc[r * 4 + 2] = s;
        }
        __syncthreads();
        for (int t = 0; t < DCH; ++t) {
            const LAS float* kt = ks + t * 128 + part * 32; const LAS float* qt = qs + t * 128 + part * 32;
            float kreg[32]; float pk = 0.f, pq = 0.f;
#pragma unroll
            for (int i = 0; i < 32; ++i) { kreg[i] = kt[i]; pk += kreg[i] * S[i]; pq += qt[i] * S[i]; }
            LAS f32x2* xb = (LAS f32x2*)xch + (t & 1) * 512;
            xb[part * 128 + e] = (f32x2){pk, pq};
            __syncthreads();
            const f32x2 x0 = xb[e], x1 = xb[128 + e], x2 = xb[256 + e], x3 = xb[384 + e];
            const float kS = (x0.x + x1.x) + (x2.x + x3.x), qS = (x0.y + x1.y) + (x2.y + x3.y);
            const float eg = sc[t * 4 + 0], beta = sc[t * 4 + 1], qk = sc[t * 4 + 2];
            const float vn = beta * (vs[t * 128 + e] - eg * kS);
            const float o = eg * qS + qk * vn;
#pragma unroll
            for (int i = 0; i < 32; ++i) S[i] = eg * S[i] + kreg[i] * vn;
            if (part == 0) os[t * 128 + e] = o;
        }
        __syncthreads();
        for (int r = wave; r < DCH; r += NWAVES) {
            const size_t row = (size_t)(rowbase + c0 + r);
            const float o0 = os[r * 128 + 2 * lane], o1 = os[r * 128 + 2 * lane + 1];
            const float ss = wave_sum(o0 * o0 + o1 * o1);
            const float rs = 1.f / sqrtf(ss * (1.f / 128.f) + LN_EPS);
            const unsigned zw = *(const unsigned*)(H + row * LDH + HZ + h * 128 + 2 * lane);
            const float y0 = o0 * rs * gn.x * silu_f(bflo(zw)), y1 = o1 * rs * gn.y * silu_f(bfhi(zw));
            *(unsigned*)(CAT + row * DM + 2048 + h * 128 + 2 * lane) = pk2(y0, y1);
        }
    }
    float* so = C.out + (prompt ? O_PDELTA : O_SDELTA) + ((size_t)(b * 16 + h) * 128 + part * 32) * 128 + e;
#pragma unroll
    for (int i = 0; i < 32; ++i) so[(size_t)i * 128] = S[i];
    __syncthreads();
}

__device__ __forceinline__ void vt_item(const Ctx& C, int item) {
    const bf16* H = (const bf16*)(C.ws + WS_H);
    LAS unsigned char* scr = C.lds + C.wave * 16384;
    int lane_ = C.lane; asm volatile("" : "+v"(lane_)); const int lane = lane_;
    bool prompt; int b, n, kt;
    if (item < NPB * 4 * 32) { prompt = true; b = item >> 7; n = (item >> 5) & 3; kt = item & 31; }
    else { prompt = false; const int j = item - NPB * 4 * 32; b = j / 68; n = (j % 68) / 17; kt = j % 17; }
    if (prompt || kt == 16) {
        const bf16* src = H + (size_t)(prompt ? b * PSEQ + kt * 64 + lane : NPROW + b * SSEQ + lane) * LDH + HV + n * 128;
#pragma unroll
        for (int c = 0; c < 16; ++c) *(LAS v4u*)(scr + lane * 256 + c * 16) = *(const v4u*)(src + c * 8);
    } else {
        const float* src = inp(C, I_CV) + ((size_t)(b * PAST + kt * 64 + lane) * 4 + n) * 128;
#pragma unroll
        for (int c = 0; c < 16; ++c) { const f32x4 x0 = *(const f32x4*)(src + c * 8), x1 = *(const f32x4*)(src + c * 8 + 4);
            v4u w; w.x = pk2(x0.x, x0.y); w.y = pk2(x0.z, x0.w); w.z = pk2(x1.x, x1.y); w.w = pk2(x1.z, x1.w); *(LAS v4u*)(scr + lane * 256 + c * 16) = w; }
    }
    LDS_WAIT(); asm volatile("" ::: "memory");
    bf16* VT = (bf16*)(C.out + (prompt ? OS_VTP : OS_VTS));
    const int ntile = prompt ? PSEQ / 64 : SLEN / 64;
#pragma unroll 4
    for (int c = 0; c < 16; ++c) {
        const int cid = lane + 64 * c, d = cid >> 3, kc = cid & 7;
        const LAS unsigned short* s = (const LAS unsigned short*)(scr + (kc * 8) * 256 + d * 2);
        v4u w;
        w.x = (unsigned)s[0 * 128] | ((unsigned)s[1 * 128] << 16); w.y = (unsigned)s[2 * 128] | ((unsigned)s[3 * 128] << 16);
        w.z = (unsigned)s[4 * 128] | ((unsigned)s[5 * 128] << 16); w.w = (unsigned)s[6 * 128] | ((unsigned)s[7 * 128] << 16);
        *(v4u*)(VT + ((size_t)(((b * 4 + n) * ntile + kt) * 128 + d)) * 64 + kc * 8) = w;
    }
    LDS_WAIT(); asm volatile("" ::: "memory");
}

typedef float f32x16 __attribute__((ext_vector_type(16)));
constexpr int A_LUT = 0, A_MSK = 16384, A_KS = 32768, A_VS = A_KS + 64 * 272, A_BUF = 2 * 64 * 272, A_END = A_KS + 2 * A_BUF;
static_assert(A_END <= RING_BYTES, "attention LDS map");
constexpr float LOG2E = 1.4426950408889634f;
__device__ __forceinline__ int t5_bucket(int rel) {
    const int n = rel < 0 ? -rel : rel; int bk;
    if (n < 8) bk = n; else bk = n < 12 ? 8 : n < 16 ? 9 : n < 23 ? 10 : n < 32 ? 11 : n < 46 ? 12 : n < 64 ? 13 : n < 91 ? 14 : 15;
    return (rel > 0 ? 16 : 0) + bk;
}
__device__ __forceinline__ void attn_lut(const Ctx& C) {
    LAS float* lut = (LAS float*)(C.lds + A_LUT);
    for (int i = C.tid; i < 16 * 256; i += NWAVES * 64) { const int head = i >> 8, rel = (i & 255) - 191; lut[i] = inp(C, I_RELB)[t5_bucket(rel) * 16 + head] * LOG2E; }
}
__device__ __forceinline__ float max3f(float a, float b, float c) { float r; asm("v_max3_f32 %0, %1, %2, %3" : "=v"(r) : "v"(a), "v"(b), "v"(c)); return r; }
#ifndef ATT_PP
#define ATT_PP 1
#endif
#ifndef ATT_DEFER
#define ATT_DEFER 8.f
#endif
#if !ATT_PP
__device__ __forceinline__ void attn_unit_seq(const Ctx& C, int item) {
    bool prompt; int b, c, n;
    if (item < 480) { prompt = true; c = 31 - (item >> 5); b = (item & 31) >> 2; n = item & 3; }
    else if (item < 608) { prompt = false; c = 0; const int j = item - 480; b = j >> 2; n = j & 3; }
    else { prompt = true; const int j = item - 608; c = 16 - (j >> 5); b = (j & 31) >> 2; n = j & 3; }
    const bf16* H = (const bf16*)(C.ws + WS_H); bf16* CAT = (bf16*)(C.ws + WS_CAT);
    int tid_ = C.tid; asm volatile("" : "+v"(tid_));
    const int tid = tid_, lane = tid & 63, wave = __builtin_amdgcn_readfirstlane(tid >> 6);
    const int row0 = prompt ? b * PSEQ + c * 64 : NPROW + b * SSEQ;
    const int past = prompt ? 0 : PAST, t0 = prompt ? c * 64 : 0;
    const int L = prompt ? (c + 1) * 64 : SLEN, nkt = L / 64;
    const int ntile = prompt ? PSEQ / 64 : SLEN / 64;
    LAS unsigned long long* MSK = (LAS unsigned long long*)(C.lds + A_MSK);
    LAS unsigned char* KS = C.lds + A_KS; LAS unsigned char* VS = C.lds + A_VS;
    const LAS float* LUT = (const LAS float*)(C.lds + A_LUT);
    __syncthreads();
    {
        const v4u* mg = (const v4u*)(C.out + OS_MSK + (size_t)row0 * 64);
        ((LAS v4u*)MSK)[tid] = mg[tid]; ((LAS v4u*)MSK)[tid + 512] = mg[tid + 512];
    }
    const int g = wave & 3, qh = wave >> 2, h = lane >> 5, l31 = lane & 31;
    const int ql = qh * 32 + l31, qpos = past + t0 + ql, qpos_min = past + t0 + qh * 32;
    const float SC2 = QSCALE * LOG2E;
    const int head = n * 4 + g;
    bf16x8 qf[8];
#pragma unroll
    for (int s = 0; s < 8; ++s) qf[s] = *(const bf16x8*)(H + (size_t)(row0 + ql) * LDH + HQ + head * 128 + 16 * s + 8 * h);
    f32x16 oacc[4];
#pragma unroll
    for (int db = 0; db < 4; ++db)
#pragma unroll
        for (int r = 0; r < 16; ++r) oacc[db][r] = 0.f;
    float m_run = -INFINITY, l_run = 0.f;
    const float bfar = inp(C, I_RELB)[15 * 16 + head] * LOG2E;
    const LAS float* lut = LUT + head * 256;
    v4u kreg[2], vreg[2];
    const unsigned koffH0 = (unsigned)(tid >> 4) * LDH + (unsigned)(tid & 15) * 8u, koffH1 = koffH0 + 32u * LDH;
    const unsigned koffC0 = (unsigned)(tid >> 4) * 512u + (unsigned)(tid & 15) * 8u, koffC1 = koffC0 + 32u * 512u;
#define ATT_LOAD(KT) do { const int kt_ = (KT); \
        if (prompt || kt_ == 16) { const bf16* kb_ = H + (size_t)(prompt ? b * PSEQ + kt_ * 64 : NPROW + b * SSEQ) * LDH + HK + n * 128; kreg[0] = *(const v4u*)(kb_ + koffH0); kreg[1] = *(const v4u*)(kb_ + koffH1); } \
        else { const float* cb_ = inp(C, I_CK) + ((size_t)(b * PAST + kt_ * 64) * 4 + n) * 128; \
               const f32x4 x0 = *(const f32x4*)(cb_ + koffC0), x1 = *(const f32x4*)(cb_ + koffC0 + 4), y0 = *(const f32x4*)(cb_ + koffC1), y1 = *(const f32x4*)(cb_ + koffC1 + 4); \
               kreg[0].x = pk2(x0.x, x0.y); kreg[0].y = pk2(x0.z, x0.w); kreg[0].z = pk2(x1.x, x1.y); kreg[0].w = pk2(x1.z, x1.w); \
               kreg[1].x = pk2(y0.x, y0.y); kreg[1].y = pk2(y0.z, y0.w); kreg[1].z = pk2(y1.x, y1.y); kreg[1].w = pk2(y1.z, y1.w); } \
        if (prompt || kt_ == 16) { const bf16* vb_ = H + (size_t)(prompt ? b * PSEQ + kt_ * 64 : NPROW + b * SSEQ) * LDH + HV + n * 128; vreg[0] = *(const v4u*)(vb_ + koffH0); vreg[1] = *(const v4u*)(vb_ + koffH1); } \
        else { const float* cb_ = inp(C, I_CV) + ((size_t)(b * PAST + kt_ * 64) * 4 + n) * 128; \
               const f32x4 x0 = *(const f32x4*)(cb_ + koffC0), x1 = *(const f32x4*)(cb_ + koffC0 + 4), y0 = *(const f32x4*)(cb_ + koffC1), y1 = *(const f32x4*)(cb_ + koffC1 + 4); \
               vreg[0].x = pk2(x0.x, x0.y); vreg[0].y = pk2(x0.z, x0.w); vreg[0].z = pk2(x1.x, x1.y); vreg[0].w = pk2(x1.z, x1.w); \
               vreg[1].x = pk2(y0.x, y0.y); vreg[1].y = pk2(y0.z, y0.w); vreg[1].z = pk2(y1.x, y1.y); vreg[1].w = pk2(y1.z, y1.w); } } while (0)
    ATT_LOAD(0);
#pragma unroll 1
    for (int kt = 0; kt < nkt; ++kt) {
        __syncthreads();
#pragma unroll
        for (int i = 0; i < 2; ++i) { const int cid = tid + 512 * i;
            *(LAS v4u*)(KS + (cid >> 4) * 272 + (cid & 15) * 16) = kreg[i];
            *(LAS v4u*)(VS + (cid >> 4) * 272 + (cid & 15) * 16) = vreg[i]; }
        __syncthreads();
        if (kt + 1 < nkt) ATT_LOAD(kt + 1);
        f32x16 s0, s1;
#pragma unroll
        for (int r = 0; r < 16; ++r) { s0[r] = 0.f; s1[r] = 0.f; }
        {
            const unsigned kaddr = (unsigned)(size_t)(KS + l31 * 272 + 16 * h);
            asm volatile("" ::: "memory");
#pragma unroll
            for (int s4 = 0; s4 < 2; ++s4) {
                bf16x8 kA[4], kB[4];
#pragma unroll
                for (int s = 0; s < 4; ++s) { DS_RD128(kA[s], kaddr, 32 * (4 * s4 + s)); DS_RD128(kB[s], kaddr, 32 * 272 + 32 * (4 * s4 + s)); }
                asm volatile("s_waitcnt lgkmcnt(0)" : "+v"(kA[0]), "+v"(kA[1]), "+v"(kA[2]), "+v"(kA[3]), "+v"(kB[0]), "+v"(kB[1]), "+v"(kB[2]), "+v"(kB[3]));
#pragma unroll
                for (int s = 0; s < 4; ++s) {
                    s0 = __builtin_amdgcn_mfma_f32_32x32x16_bf16(kA[s], qf[4 * s4 + s], s0, 0, 0, 0);
                    s1 = __builtin_amdgcn_mfma_f32_32x32x16_bf16(kB[s], qf[4 * s4 + s], s1, 0, 0, 0);
                }
            }
        }
        asm volatile("s_nop 7\n\ts_nop 7\n\ts_nop 3" : "+v"(s0), "+v"(s1));
        const unsigned long long mw = MSK[ql * 32 + kt];
        const unsigned wlo = (unsigned)mw >> (4 * h), whi = (unsigned)(mw >> 32) >> (4 * h);
        const bool far = (kt * 64 + 63 - qpos_min) <= -91;
        float mx;
        if (far) {
            float a = max3f(s0[0], s0[1], s0[2]), bq = max3f(s1[0], s1[1], s1[2]);
#pragma unroll
            for (int r = 3; r < 15; r += 2) { a = max3f(a, s0[r], s0[r + 1]); bq = max3f(bq, s1[r], s1[r + 1]); }
            mx = fmaf(max3f(a, bq, fmaxf(s0[15], s1[15])), SC2, bfar);
        } else {
            const int relb0 = kt * 64 + 4 * h - qpos + 191;
#pragma unroll
            for (int r = 0; r < 16; ++r) { const int cr = (r & 3) + 8 * (r >> 2);
                s0[r] = fmaf(s0[r], SC2, lut[relb0 + cr]); s1[r] = fmaf(s1[r], SC2, lut[relb0 + 32 + cr]); }
            float a = max3f(s0[0], s0[1], s0[2]), bq = max3f(s1[0], s1[1], s1[2]);
#pragma unroll
            for (int r = 3; r < 15; r += 2) { a = max3f(a, s0[r], s0[r + 1]); bq = max3f(bq, s1[r], s1[r + 1]); }
            mx = max3f(a, bq, fmaxf(s0[15], s1[15]));
        }
        mx = fmaxf(mx, __shfl_xor(mx, 32));
        float m_new = m_run;
        if (__any(mx > m_run + ATT_DEFER)) {
            m_new = fmaxf(m_run, mx);
            const float alpha = __builtin_amdgcn_exp2f(m_run - m_new);
            l_run *= alpha;
#pragma unroll
            for (int db = 0; db < 4; ++db)
#pragma unroll
                for (int r = 0; r < 16; ++r) oacc[db][r] *= alpha;
        }
        m_run = m_new;
        const float sc = far ? SC2 : 1.f, sb = far ? bfar - m_new : -m_new;
        float psum = 0.f;
#pragma unroll
        for (int r = 0; r < 16; ++r) { const int cr = (r & 3) + 8 * (r >> 2);
            const float p0 = __builtin_amdgcn_exp2f(fmaf(s0[r], sc, sb)), p1 = __builtin_amdgcn_exp2f(fmaf(s1[r], sc, sb));
            unsigned m0, m1;
            asm("v_bfe_i32 %0, %1, %c2, 1" : "=v"(m0) : "v"(wlo), "i"(cr)); asm("v_bfe_i32 %0, %1, %c2, 1" : "=v"(m1) : "v"(whi), "i"(cr));
            s0[r] = __uint_as_float(__float_as_uint(p0) & m0); s1[r] = __uint_as_float(__float_as_uint(p1) & m1);
            psum += s0[r] + s1[r]; }
        l_run += psum;
        bf16x8 pb[2][2];
#pragma unroll
        for (int s = 0; s < 2; ++s) {
            v4u w0, w1;
            w0.x = pk2(s0[8 * s + 0], s0[8 * s + 1]); w0.y = pk2(s0[8 * s + 2], s0[8 * s + 3]); w0.z = pk2(s0[8 * s + 4], s0[8 * s + 5]); w0.w = pk2(s0[8 * s + 6], s0[8 * s + 7]);
            w1.x = pk2(s1[8 * s + 0], s1[8 * s + 1]); w1.y = pk2(s1[8 * s + 2], s1[8 * s + 3]); w1.z = pk2(s1[8 * s + 4], s1[8 * s + 5]); w1.w = pk2(s1[8 * s + 6], s1[8 * s + 7]);
            pb[0][s] = __builtin_bit_cast(bf16x8, w0); pb[1][s] = __builtin_bit_cast(bf16x8, w1);
        }
        {
            const unsigned vaddr = (unsigned)(size_t)(VS + (4 * h + ((lane & 15) >> 2)) * 272 + (16 * ((lane >> 4) & 1) + 4 * (lane & 3)) * 2);
#pragma unroll
            for (int d2 = 0; d2 < 2; ++d2) {
                v2u vlo[8], vhi[8];
#pragma unroll
                for (int dd = 0; dd < 2; ++dd)
#pragma unroll
                    for (int ks = 0; ks < 4; ++ks) { DS_RDTR(vlo[dd * 4 + ks], vaddr, ks * 4352 + (2 * d2 + dd) * 64); DS_RDTR(vhi[dd * 4 + ks], vaddr, ks * 4352 + 2176 + (2 * d2 + dd) * 64); }
                asm volatile("s_waitcnt lgkmcnt(0)" : "+v"(vlo[0]), "+v"(vlo[1]), "+v"(vlo[2]), "+v"(vlo[3]), "+v"(vlo[4]), "+v"(vlo[5]), "+v"(vlo[6]), "+v"(vlo[7]),
                                                      "+v"(vhi[0]), "+v"(vhi[1]), "+v"(vhi[2]), "+v"(vhi[3]), "+v"(vhi[4]), "+v"(vhi[5]), "+v"(vhi[6]), "+v"(vhi[7]));
#pragma unroll
                for (int dd = 0; dd < 2; ++dd)
#pragma unroll
                    for (int ks = 0; ks < 4; ++ks) {
                        const bf16x8 a = __builtin_bit_cast(bf16x8, (v4u){vlo[dd * 4 + ks].x, vlo[dd * 4 + ks].y, vhi[dd * 4 + ks].x, vhi[dd * 4 + ks].y});
                        oacc[2 * d2 + dd] = __builtin_amdgcn_mfma_f32_32x32x16_bf16(a, pb[ks >> 1][ks & 1], oacc[2 * d2 + dd], 0, 0, 0);
                    }
            }
        }
    }
#undef ATT_LOAD
    const float inv = 1.f / (l_run + __shfl_xor(l_run, 32));
    bf16* op = CAT + (size_t)(row0 + ql) * DM + head * 128 + 4 * h;
#pragma unroll
    for (int db = 0; db < 4; ++db)
#pragma unroll
        for (int q4 = 0; q4 < 4; ++q4) {
#if MIX_FP8
            *(unsigned*)((unsigned char*)CAT + (size_t)(row0 + ql) * DM + head * 128 + 4 * h + 32 * db + 8 * q4) = pk4_fp8(oacc[db][4 * q4 + 0] * (inv * CAT_Q), oacc[db][4 * q4 + 1] * (inv * CAT_Q), oacc[db][4 * q4 + 2] * (inv * CAT_Q), oacc[db][4 * q4 + 3] * (inv * CAT_Q));
#else
            v2u w; w.x = pk2(oacc[db][4 * q4 + 0] * inv, oacc[db][4 * q4 + 1] * inv); w.y = pk2(oacc[db][4 * q4 + 2] * inv, oacc[db][4 * q4 + 3] * inv);
            *(v2u*)(op + 32 * db + 8 * q4) = w;
#endif
        }
}
#define attn_unit attn_unit_seq
#else
__device__ __forceinline__ void attn_unit(const Ctx& C, int item) {
    bool prompt; int b, c, n;
    if (item < 480) { prompt = true; c = 31 - (item >> 5); b = (item & 31) >> 2; n = item & 3; }
    else if (item < 608) { prompt = false; c = 0; const int j = item - 480; b = j >> 2; n = j & 3; }
    else { prompt = true; const int j = item - 608; c = 16 - (j >> 5); b = (j & 31) >> 2; n = j & 3; }
    const bf16* H = (const bf16*)(C.ws + WS_H); bf16* CAT = (bf16*)(C.ws + WS_CAT);
    int tid_ = C.tid; asm volatile("" : "+v"(tid_));
    const int tid = tid_, lane = tid & 63, wave = __builtin_amdgcn_readfirstlane(tid >> 6);
    const int row0 = prompt ? b * PSEQ + c * 64 : NPROW + b * SSEQ;
    const int past = prompt ? 0 : PAST, t0 = prompt ? c * 64 : 0;
    const int L = prompt ? (c + 1) * 64 : SLEN, nkt = L / 64;
    const int ntile = prompt ? PSEQ / 64 : SLEN / 64;
    LAS unsigned long long* MSK = (LAS unsigned long long*)(C.lds + A_MSK);
    LAS unsigned char* KS = C.lds + A_KS; LAS unsigned char* VS = C.lds + A_VS;
    const LAS float* LUT = (const LAS float*)(C.lds + A_LUT);
    __syncthreads();
    {
        const v4u* mg = (const v4u*)(C.out + OS_MSK + (size_t)row0 * 64);
        ((LAS v4u*)MSK)[tid] = mg[tid]; ((LAS v4u*)MSK)[tid + 512] = mg[tid + 512];
    }
    const int g = wave & 3, qh = wave >> 2, h = lane >> 5, l31 = lane & 31;
    const int ql = qh * 32 + l31, qpos = past + t0 + ql, qpos_min = past + t0 + qh * 32;
    const float SC2 = QSCALE * LOG2E;
    const int head = n * 4 + g;
    bf16x8 qf[8];
#pragma unroll
    for (int s = 0; s < 8; ++s) qf[s] = *(const bf16x8*)(H + (size_t)(row0 + ql) * LDH + HQ + head * 128 + 16 * s + 8 * h);
    f32x16 oacc[4];
#pragma unroll
    for (int db = 0; db < 4; ++db)
#pragma unroll
        for (int r = 0; r < 16; ++r) oacc[db][r] = 0.f;
    float m_run = -INFINITY, l_run = 0.f;
    const float bfar = inp(C, I_RELB)[15 * 16 + head] * LOG2E;
    const LAS float* lut = LUT + head * 256;
    v4u kreg[2], vreg[2];
    const unsigned koffH0 = (unsigned)(tid >> 4) * LDH + (unsigned)(tid & 15) * 8u, koffH1 = koffH0 + 32u * LDH;
    const unsigned koffC0 = (unsigned)(tid >> 4) * 512u + (unsigned)(tid & 15) * 8u, koffC1 = koffC0 + 32u * 512u;
#define ATT_LOADK(KT) do { const int kt_ = (KT); \
        if (prompt || kt_ == 16) { const bf16* kb_ = H + (size_t)(prompt ? b * PSEQ + kt_ * 64 : NPROW + b * SSEQ) * LDH + HK + n * 128; kreg[0] = *(const v4u*)(kb_ + koffH0); kreg[1] = *(const v4u*)(kb_ + koffH1); } \
        else { const float* cb_ = inp(C, I_CK) + ((size_t)(b * PAST + kt_ * 64) * 4 + n) * 128; \
               const f32x4 x0 = *(const f32x4*)(cb_ + koffC0), x1 = *(const f32x4*)(cb_ + koffC0 + 4), y0 = *(const f32x4*)(cb_ + koffC1), y1 = *(const f32x4*)(cb_ + koffC1 + 4); \
               kreg[0].x = pk2(x0.x, x0.y); kreg[0].y = pk2(x0.z, x0.w); kreg[0].z = pk2(x1.x, x1.y); kreg[0].w = pk2(x1.z, x1.w); \
               kreg[1].x = pk2(y0.x, y0.y); kreg[1].y = pk2(y0.z, y0.w); kreg[1].z = pk2(y1.x, y1.y); kreg[1].w = pk2(y1.z, y1.w); } } while (0)
#define ATT_LOADV(KT) do { const int kt_ = (KT); \
        if (prompt || kt_ == 16) { const bf16* vb_ = H + (size_t)(prompt ? b * PSEQ + kt_ * 64 : NPROW + b * SSEQ) * LDH + HV + n * 128; vreg[0] = *(const v4u*)(vb_ + koffH0); vreg[1] = *(const v4u*)(vb_ + koffH1); } \
        else { const float* cb_ = inp(C, I_CV) + ((size_t)(b * PAST + kt_ * 64) * 4 + n) * 128; \
               const f32x4 x0 = *(const f32x4*)(cb_ + koffC0), x1 = *(const f32x4*)(cb_ + koffC0 + 4), y0 = *(const f32x4*)(cb_ + koffC1), y1 = *(const f32x4*)(cb_ + koffC1 + 4); \
               vreg[0].x = pk2(x0.x, x0.y); vreg[0].y = pk2(x0.z, x0.w); vreg[0].z = pk2(x1.x, x1.y); vreg[0].w = pk2(x1.z, x1.w); \
               vreg[1].x = pk2(y0.x, y0.y); vreg[1].y = pk2(y0.z, y0.w); vreg[1].z = pk2(y1.x, y1.y); vreg[1].w = pk2(y1.z, y1.w); } } while (0)
    f32x16 s0, s1; bf16x8 pb[2][2];
    auto STK = [&](const int slot) __attribute__((always_inline)) {
#pragma unroll
        for (int i = 0; i < 2; ++i) { const int cid = tid + 512 * i; *(LAS v4u*)(KS + slot * A_BUF + (cid >> 4) * 272 + (cid & 15) * 16) = kreg[i]; } };
    auto STV = [&](const int slot) __attribute__((always_inline)) {
#pragma unroll
        for (int i = 0; i < 2; ++i) { const int cid = tid + 512 * i; *(LAS v4u*)(VS + slot * A_BUF + (cid >> 4) * 272 + (cid & 15) * 16) = vreg[i]; } };
    auto QK = [&](const int kt) __attribute__((always_inline)) {
        LAS unsigned char* KSk = KS + (kt & 1) * A_BUF;
#pragma unroll
        for (int r = 0; r < 16; ++r) { s0[r] = 0.f; s1[r] = 0.f; }
        {
            const unsigned kaddr = (unsigned)(size_t)(KSk + l31 * 272 + 16 * h);
            asm volatile("" ::: "memory");
#pragma unroll
            for (int s4 = 0; s4 < 2; ++s4) {
                bf16x8 kA[4], kB[4];
#pragma unroll
                for (int s = 0; s < 4; ++s) { DS_RD128(kA[s], kaddr, 32 * (4 * s4 + s)); DS_RD128(kB[s], kaddr, 32 * 272 + 32 * (4 * s4 + s)); }
                asm volatile("s_waitcnt lgkmcnt(0)" : "+v"(kA[0]), "+v"(kA[1]), "+v"(kA[2]), "+v"(kA[3]), "+v"(kB[0]), "+v"(kB[1]), "+v"(kB[2]), "+v"(kB[3]));
#pragma unroll
                for (int s = 0; s < 4; ++s) {
                    s0 = __builtin_amdgcn_mfma_f32_32x32x16_bf16(kA[s], qf[4 * s4 + s], s0, 0, 0, 0);
                    s1 = __builtin_amdgcn_mfma_f32_32x32x16_bf16(kB[s], qf[4 * s4 + s], s1, 0, 0, 0);
                }
            }
        }
        asm volatile("s_nop 7\n\ts_nop 7\n\ts_nop 3" : "+v"(s0), "+v"(s1));
    };
    auto SM = [&](const int kt) __attribute__((always_inline)) {
        const unsigned long long mw = MSK[ql * 32 + kt];
        const unsigned wlo = (unsigned)mw >> (4 * h), whi = (unsigned)(mw >> 32) >> (4 * h);
        const bool far = (kt * 64 + 63 - qpos_min) <= -91;
        float mx;
        if (far) {
            float a = max3f(s0[0], s0[1], s0[2]), bq = max3f(s1[0], s1[1], s1[2]);
#pragma unroll
            for (int r = 3; r < 15; r += 2) { a = max3f(a, s0[r], s0[r + 1]); bq = max3f(bq, s1[r], s1[r + 1]); }
            mx = fmaf(max3f(a, bq, fmaxf(s0[15], s1[15])), SC2, bfar);
        } else {
            const int relb0 = kt * 64 + 4 * h - qpos + 191;
#pragma unroll
            for (int r = 0; r < 16; ++r) { const int cr = (r & 3) + 8 * (r >> 2);
                s0[r] = fmaf(s0[r], SC2, lut[relb0 + cr]); s1[r] = fmaf(s1[r], SC2, lut[relb0 + 32 + cr]); }
            float a = max3f(s0[0], s0[1], s0[2]), bq = max3f(s1[0], s1[1], s1[2]);
#pragma unroll
            for (int r = 3; r < 15; r += 2) { a = max3f(a, s0[r], s0[r + 1]); bq = max3f(bq, s1[r], s1[r + 1]); }
            mx = max3f(a, bq, fmaxf(s0[15], s1[15]));
        }
        mx = fmaxf(mx, __shfl_xor(mx, 32));
        float m_new = m_run;
        if (__any(mx > m_run + ATT_DEFER)) {
            m_new = fmaxf(m_run, mx);
            const float alpha = __builtin_amdgcn_exp2f(m_run - m_new);
            l_run *= alpha;
#pragma unroll
            for (int db = 0; db < 4; ++db)
#pragma unroll
                for (int r = 0; r < 16; ++r) oacc[db][r] *= alpha;
        }
        m_run = m_new;
        const float sc = far ? SC2 : 1.f, sb = far ? bfar - m_new : -m_new;
        float psum = 0.f;
#pragma unroll
        for (int r = 0; r < 16; ++r) { const int cr = (r & 3) + 8 * (r >> 2);
            const float p0 = __builtin_amdgcn_exp2f(fmaf(s0[r], sc, sb)), p1 = __builtin_amdgcn_exp2f(fmaf(s1[r], sc, sb));
            unsigned m0, m1;
            asm("v_bfe_i32 %0, %1, %c2, 1" : "=v"(m0) : "v"(wlo), "i"(cr)); asm("v_bfe_i32 %0, %1, %c2, 1" : "=v"(m1) : "v"(whi), "i"(cr));
            s0[r] = __uint_as_float(__float_as_uint(p0) & m0); s1[r] = __uint_as_float(__float_as_uint(p1) & m1);
            psum += s0[r] + s1[r]; }
        l_run += psum;
#pragma unroll
        for (int s = 0; s < 2; ++s) {
            v4u w0, w1;
            w0.x = pk2(s0[8 * s + 0], s0[8 * s + 1]); w0.y = pk2(s0[8 * s + 2], s0[8 * s + 3]); w0.z = pk2(s0[8 * s + 4], s0[8 * s + 5]); w0.w = pk2(s0[8 * s + 6], s0[8 * s + 7]);
            w1.x = pk2(s1[8 * s + 0], s1[8 * s + 1]); w1.y = pk2(s1[8 * s + 2], s1[8 * s + 3]); w1.z = pk2(s1[8 * s + 4], s1[8 * s + 5]); w1.w = pk2(s1[8 * s + 6], s1[8 * s + 7]);
            pb[0][s] = __builtin_bit_cast(bf16x8, w0); pb[1][s] = __builtin_bit_cast(bf16x8, w1);
        }
    };
    auto PV = [&](const int kt) __attribute__((always_inline)) {
        LAS unsigned char* VSk = VS + (kt & 1) * A_BUF;
        {
            const unsigned vaddr = (unsigned)(size_t)(VSk + (4 * h + ((lane & 15) >> 2)) * 272 + (16 * ((lane >> 4) & 1) + 4 * (lane & 3)) * 2);
#pragma unroll
            for (int d2 = 0; d2 < 2; ++d2) {
                v2u vlo[8], vhi[8];
#pragma unroll
                for (int dd = 0; dd < 2; ++dd)
#pragma unroll
                    for (int ks = 0; ks < 4; ++ks) { DS_RDTR(vlo[dd * 4 + ks], vaddr, ks * 4352 + (2 * d2 + dd) * 64); DS_RDTR(vhi[dd * 4 + ks], vaddr, ks * 4352 + 2176 + (2 * d2 + dd) * 64); }
                asm volatile("s_waitcnt lgkmcnt(0)" : "+v"(vlo[0]), "+v"(vlo[1]), "+v"(vlo[2]), "+v"(vlo[3]), "+v"(vlo[4]), "+v"(vlo[5]), "+v"(vlo[6]), "+v"(vlo[7]),
                                                      "+v"(vhi[0]), "+v"(vhi[1]), "+v"(vhi[2]), "+v"(vhi[3]), "+v"(vhi[4]), "+v"(vhi[5]), "+v"(vhi[6]), "+v"(vhi[7]));
#pragma unroll
                for (int dd = 0; dd < 2; ++dd)
#pragma unroll
                    for (int ks = 0; ks < 4; ++ks) {
                        const bf16x8 a = __builtin_bit_cast(bf16x8, (v4u){vlo[dd * 4 + ks].x, vlo[dd * 4 + ks].y, vhi[dd * 4 + ks].x, vhi[dd * 4 + ks].y});
                        oacc[2 * d2 + dd] = __builtin_amdgcn_mfma_f32_32x32x16_bf16(a, pb[ks >> 1][ks & 1], oacc[2 * d2 + dd], 0, 0, 0);
                    }
            }
        }
    };
    ATT_LOADK(0); STK(0);
    ATT_LOADK(nkt > 1 ? 1 : 0); ATT_LOADV(0);
#define ATT_STAGE(t) do { if ((t) + 1 < nkt) STK(((t) + 1) & 1); STV((t) & 1); if ((t) + 2 < nkt) ATT_LOADK((t) + 2); if ((t) + 1 < nkt) ATT_LOADV((t) + 1); } while (0)
    if (qh == 0) {
#pragma unroll 1
        for (int t = 0; t < nkt; ++t) {
            __syncthreads(); ATT_STAGE(t);
            __builtin_amdgcn_s_setprio(2);
            if (t > 0) PV(t - 1);
            QK(t);
            __builtin_amdgcn_s_setprio(0);
            __syncthreads();
            SM(t);
        }
        __syncthreads();
        PV(nkt - 1);
        __syncthreads();
    } else {
#pragma unroll 1
        for (int t = 0; t < nkt; ++t) {
            __syncthreads(); ATT_STAGE(t);
            if (t > 0) SM(t - 1);
            __syncthreads();
            __builtin_amdgcn_s_setprio(2);
            if (t > 0) PV(t - 1);
            QK(t);
            __builtin_amdgcn_s_setprio(0);
        }
        __syncthreads();
        SM(nkt - 1);
        __syncthreads();
        PV(nkt - 1);
    }
#undef ATT_STAGE
#undef ATT_LOADK
#undef ATT_LOADV
    const float inv = 1.f / (l_run + __shfl_xor(l_run, 32));
    bf16* op = CAT + (size_t)(row0 + ql) * DM + head * 128 + 4 * h;
#pragma unroll
    for (int db = 0; db < 4; ++db)
#pragma unroll
        for (int q4 = 0; q4 < 4; ++q4) {
#if MIX_FP8
            *(unsigned*)((unsigned char*)CAT + (size_t)(row0 + ql) * DM + head * 128 + 4 * h + 32 * db + 8 * q4) = pk4_fp8(oacc[db][4 * q4 + 0] * (inv * CAT_Q), oacc[db][4 * q4 + 1] * (inv * CAT_Q), oacc[db][4 * q4 + 2] * (inv * CAT_Q), oacc[db][4 * q4 + 3] * (inv * CAT_Q));
#else
            v2u w; w.x = pk2(oacc[db][4 * q4 + 0] * inv, oacc[db][4 * q4 + 1] * inv); w.y = pk2(oacc[db][4 * q4 + 2] * inv, oacc[db][4 * q4 + 3] * inv);
            *(v2u*)(op + 32 * db + 8 * q4) = w;
#endif
        }
}
#endif

__device__ __forceinline__ void phase5(const Ctx& C) {
    LAS float* scr = (LAS float*)(C.lds + C.wave * 16384);
    const int gw = C.bid * NWAVES + C.wave, NGW = C.G * NWAVES;
    bf16* WupT = (bf16*)(C.ws + WS_WUP); bf16* WdnT = (bf16*)(C.ws + WS_WDN); bf16* X1 = (bf16*)(C.ws + WS_XN);
    { LnP P; ln_params(P, inp(C, I_LN1G), inp(C, I_LN1B), C.lane);
#pragma unroll 1
      for (int m = gw; m < MTOK; m += NGW) ln_row<false, true, true>((const bf16*)(C.ws + WS_PRE1) + (size_t)m * DM, P, X1 + (size_t)m * LDX, C.lane, (const unsigned*)(C.ctl + CW_TIX2) + (m >> 8) * 16, (const float*)(C.ws + WS_P2), m & 255); }
#if defined(PROBE_DUP) && PROBE_DUP == 9
    { LnP P; ln_params(P, inp(C, I_LN1G), inp(C, I_LN1B), C.lane);
#pragma unroll 1
      for (int m = gw; m < MTOK; m += NGW) ln_row<false, true, true>((const bf16*)(C.ws + WS_PRE1) + (size_t)m * DM, P, X1 + (size_t)m * LDX, C.lane, (const unsigned*)(C.ctl + CW_TIX2) + (m >> 8) * 16, (const float*)(C.ws + WS_P2), m & 255); }
#endif
    constexpr int I_UP = (DM / 64) * (DFF2 / 32), I_DN = (DFF / 64) * (DM / 32);
#if !WUP_EARLY
    transpose_static<2>(inp(C, I_WUP), DM, DFF2, WupT, I_UP, scr, gw, NGW, C.lane); (void)WdnT; (void)I_DN;
#else
    (void)scr; (void)WupT; (void)WdnT; (void)I_UP; (void)I_DN;
#endif
}
__device__ __forceinline__ void ffn_fixup(const Ctx& C) {
    const bf16* UPS = (const bf16*)(C.ws + WS_UPS); bf16* ACT = (bf16*)(C.ws + WS_ACT);
    const float* fw = inp(C, I_FCW); const float* fb = inp(C, I_FCB); const float* st = inp(C, I_SFFN);
    const int gt = C.bid * (NWAVES * 64) + C.tid, NGT = C.G * NWAVES * 64;
    for (int it = gt; it < 576 * (DFF / 4); it += NGT) {
        const int ri = it / (DFF / 4), j = (it % (DFF / 4)) * 4, blk = ri >> 1, w = ri & 1, row = blk * 64 + w;
        const bool prompt = row < NPROW; const int r2 = row - NPROW;
        const int b = prompt ? (row >> 11) : (r2 >> 6), t = prompt ? (row & 2047) : (r2 & 63);
        f32x4 g[3], v[3];
        v2u ua[3], uc[3]; f32x4 sg[3], sv[3];
#pragma unroll
        for (int k = 0; k < 3; ++k) {
            const int dt = k - 2, tt = t + dt;
            const int rr = max(row + dt, 0), bb = rr >> 6, idx = ((rr & 63) + 2) & 63;
            ua[k] = *(const v2u*)(UPS + (size_t)(bb * 4 + idx) * DFF2 + j); uc[k] = *(const v2u*)(UPS + (size_t)(bb * 4 + idx) * DFF2 + DFF + j);
            const int si = min(max(2 + tt, 0), 1), bs = prompt ? 0 : b;
            sg[k] = *(const f32x4*)(st + (size_t)(bs * 2 + si) * DFF2 + j); sv[k] = *(const f32x4*)(st + (size_t)(bs * 2 + si) * DFF2 + DFF + j);
        }
        asm volatile("" : "+v"(ua[0]), "+v"(ua[1]), "+v"(ua[2]), "+v"(uc[0]), "+v"(uc[1]), "+v"(uc[2]), "+v"(sg[0]), "+v"(sg[1]), "+v"(sg[2]), "+v"(sv[0]), "+v"(sv[1]), "+v"(sv[2]));
#pragma unroll
        for (int k = 0; k < 3; ++k) {
            const int tt = t + k - 2;
            const float ks = (tt < 0 && !prompt) ? 1.f : 0.f;
            const f32x4 gu = (f32x4){bflo(ua[k].x), bfhi(ua[k].x), bflo(ua[k].y), bfhi(ua[k].y)}, vu = (f32x4){bflo(uc[k].x), bfhi(uc[k].x), bflo(uc[k].y), bfhi(uc[k].y)};
            g[k] = tt >= 0 ? gu : sg[k] * ks; v[k] = tt >= 0 ? vu : sv[k] * ks;
        }
        f32x4 G = *(const f32x4*)(fb + j), V = *(const f32x4*)(fb + DFF + j);
#pragma unroll
        for (int k = 0; k < 3; ++k) { G += *(const f32x4*)(fw + (size_t)k * DFF2 + j) * g[k]; V += *(const f32x4*)(fw + (size_t)k * DFF2 + DFF + j) * v[k]; }
#if FFN_DOWN_FP8
        *(unsigned*)((unsigned char*)ACT + (size_t)row * DFF + j) = pk4_fp8(silu_f(G.x) * V.x * ACT_Q, silu_f(G.y) * V.y * ACT_Q, silu_f(G.z) * V.z * ACT_Q, silu_f(G.w) * V.w * ACT_Q);
#else
        v2u o; o.x = pk2(silu_f(G.x) * V.x, silu_f(G.y) * V.y); o.y = pk2(silu_f(G.z) * V.z, silu_f(G.w) * V.w);
        *(v2u*)(ACT + (size_t)row * DFF + j) = o;
#endif
    }
}

__device__ __forceinline__ int crow16(int r, int h) { return (r & 3) + 8 * (r >> 2) + 4 * h; }
__device__ __forceinline__ bf16x8 pack8(float a0, float a1, float a2, float a3, float a4, float a5, float a6, float a7) {
    v4u w; w.x = pk2(a0, a1); w.y = pk2(a2, a3); w.z = pk2(a4, a5); w.w = pk2(a6, a7); return __builtin_bit_cast(bf16x8, w);
}
typedef short v4i16_t __attribute__((ext_vector_type(4)));
__device__ __forceinline__ v2u tr4(LAS unsigned char* tile, int row0, int col0, int lane) {
    const int q = (lane & 15) >> 2, p = lane & 3, blk = (lane >> 4) & 1;
    const v4i16_t r = __builtin_amdgcn_ds_read_tr16_b64_v4i16((LAS v4i16_t*)(tile + (row0 + q) * 272 + (col0 + 16 * blk + 4 * p) * 2));
    return __builtin_bit_cast(v2u, r);
}

template <int SIDX> __device__ __forceinline__ void dprep_pass(const Ctx& C, const bf16* H, bf16* QKVC, const float* cw, const float* cb, const float* st, LAS unsigned char* tile, int R0, int t0, bool prompt, int b, int h, int lane) {
    const int cch = SIDX * 2048 + h * 128 + 2 * lane;
    const f32x2 w0 = *(const f32x2*)(cw + cch), w1 = *(const f32x2*)(cw + CQKV + cch), w2 = *(const f32x2*)(cw + 2 * CQKV + cch), w3 = *(const f32x2*)(cw + 3 * CQKV + cch), bi = *(const f32x2*)(cb + cch);
    f32x2 xm3, xm2, xm1;
    const int Rh = R0 >= 3 ? R0 - 3 : 0, bs = prompt ? 0 : b;
    unsigned ha = *(const unsigned*)(H + (size_t)Rh * LDH + HQKV + cch), hb = *(const unsigned*)(H + (size_t)(Rh + 1) * LDH + HQKV + cch), hc = *(const unsigned*)(H + (size_t)(Rh + 2) * LDH + HQKV + cch);
    f32x2 s3 = *(const f32x2*)(st + (size_t)(bs * 3 + 0) * CQKV + cch), s2 = *(const f32x2*)(st + (size_t)(bs * 3 + 1) * CQKV + cch), s1 = *(const f32x2*)(st + (size_t)(bs * 3 + 2) * CQKV + cch);
    const float post = SIDX == 0 ? QSCALE : 1.f;
    unsigned xws[32];
#pragma unroll
    for (int i = 0; i < 32; ++i) xws[i] = *(const unsigned*)(H + (size_t)(R0 + i) * LDH + HQKV + cch);
    asm volatile("" : "+v"(ha), "+v"(hb), "+v"(hc), "+v"(s3), "+v"(s2), "+v"(s1));
    {
        const bool fromH = t0 > 0; const float ks = (!fromH && !prompt) ? 1.f : 0.f;
        xm3 = fromH ? (f32x2){bflo(ha), bfhi(ha)} : s3 * ks; xm2 = fromH ? (f32x2){bflo(hb), bfhi(hb)} : s2 * ks; xm1 = fromH ? (f32x2){bflo(hc), bfhi(hc)} : s1 * ks;
    }
#pragma unroll
    for (int i0 = 0; i0 < 32; i0 += 8) {
        f32x2 y[8];
#pragma unroll
        for (int j = 0; j < 8; ++j) {
            const unsigned xw = xws[i0 + j];
            const f32x2 x0 = (f32x2){bflo(xw), bfhi(xw)};
            y[j] = bi + w0 * xm3 + w1 * xm2 + w2 * xm1 + w3 * x0;
            xm3 = xm2; xm2 = xm1; xm1 = x0;
        }
#pragma unroll
        for (int j = 0; j < 8; ++j) { y[j].x = silu_f(y[j].x); y[j].y = silu_f(y[j].y); }
        if (SIDX < 2) {
            float ss[8];
#pragma unroll
            for (int j = 0; j < 8; ++j) ss[j] = wave_sum(y[j].x * y[j].x + y[j].y * y[j].y);
#pragma unroll
            for (int j = 0; j < 8; ++j) { const float sc = post * __builtin_amdgcn_rsqf(ss[j] + 1e-6f); y[j].x *= sc; y[j].y *= sc; }
        }
#pragma unroll
        for (int j = 0; j < 8; ++j) {
            const unsigned pw = pk2(y[j].x, y[j].y);
            *(unsigned*)(QKVC + (size_t)(R0 + i0 + j) * CQKV + cch) = pw;
            if (SIDX < 2) *(LAS unsigned*)(tile + (i0 + j) * 272 + 4 * lane) = pw;
        }
    }
}

__device__ __forceinline__ void dprep_unit(const Ctx& C, int u, int lane_in, LAS unsigned char* scr, const int pmode = 0) {
    int lane = lane_in; asm volatile("" : "+v"(lane));
    const bool prompt = u < 8192; const int u2 = u - 8192;
    const int bh = prompt ? (u >> 6) : (u2 >> 1), c = prompt ? (u & 63) : (u2 & 1), b = bh >> 4, h = bh & 15;
    const int R0 = (prompt ? b * PSEQ : NPROW + b * SSEQ) + c * 32, t0 = c * 32;
    const bf16* H = (const bf16*)(C.ws + WS_H); bf16* QKVC = (bf16*)(C.ws + WS_QKVC);
    const float* SM = C.out + OS_SM;
    const float* cw = inp(C, I_CQW); const float* cb = inp(C, I_CQB); const float* st = inp(C, I_SCONV);
    LAS unsigned char* tile = scr;
    LAS float* LT = (LAS float*)(scr + 8704);
    LAS float* Gs = LT + 32 * 36;
    LAS float* Bs = Gs + 32;
    const int l31 = lane & 31, hh = lane >> 5;
    bf16x8 kf[8], qf[8];
    if (pmode != 2)
    dprep_pass<1>(C, H, QKVC, cw, cb, st, tile, R0, t0, prompt, b, h, lane);
#pragma unroll
    for (int s = 0; s < 8; ++s) kf[s] = *(const LAS bf16x8*)(tile + l31 * 272 + 32 * s + 16 * hh);
    LDS_WAIT(); asm volatile("" ::: "memory");
    if (pmode != 2)
    dprep_pass<0>(C, H, QKVC, cw, cb, st, tile, R0, t0, prompt, b, h, lane);
#pragma unroll
    for (int s = 0; s < 8; ++s) qf[s] = *(const LAS bf16x8*)(tile + l31 * 272 + 32 * s + 16 * hh);
    LDS_WAIT(); asm volatile("" ::: "memory");
    if (pmode != 2)
    dprep_pass<2>(C, H, QKVC, cw, cb, st, tile, R0, t0, prompt, b, h, lane);
    LDS_WAIT(); asm volatile("" ::: "memory");
    if (pmode == 1) return;
    const size_t grow = (size_t)(R0 + l31);
    const float Aexp = expf(inp(C, I_ALOG)[h]), dtb = inp(C, I_DTB)[h];
    const float xg = SM[grow * 128 + 96 + h] + dtb; const float sp = xg > 20.f ? xg : log1pf(expf(xg));
    float G = -Aexp * sp;
#pragma unroll
    for (int off = 1; off < 32; off <<= 1) { const float t = __shfl_up(G, off, 32); if (l31 >= off) G += t; }
    const float beta = 1.f / (1.f + expf(-SM[grow * 128 + 80 + h]));
    if (lane < 32) { Gs[lane] = G; Bs[lane] = beta; (C.out + OS_GB)[grow * 16 + h] = G; }
    f32x16 KK, KQ;
#pragma unroll
    for (int r = 0; r < 16; ++r) { KK[r] = 0.f; KQ[r] = 0.f; }
#pragma unroll
    for (int s = 0; s < 8; ++s) { KK = __builtin_amdgcn_mfma_f32_32x32x16_bf16(kf[s], kf[s], KK, 0, 0, 0); KQ = __builtin_amdgcn_mfma_f32_32x32x16_bf16(kf[s], qf[s], KQ, 0, 0, 0); }
    LDS_WAIT(); asm volatile("" ::: "memory");
    float mfv[16];
#pragma unroll
    for (int q4 = 0; q4 < 4; ++q4) {
        const f32x4 Gm = *(const LAS f32x4*)(Gs + 8 * q4 + 4 * hh), Bm = *(const LAS f32x4*)(Bs + 8 * q4 + 4 * hh);
        f32x4 lv;
#pragma unroll
        for (int e = 0; e < 4; ++e) {
            const int r = 4 * q4 + e, m = 8 * q4 + 4 * hh + e;
            lv[e] = (m > l31) ? Bm[e] * KK[r] * __expf(Gm[e] - G) : 0.f;
            mfv[r] = (l31 >= m) ? KQ[r] * __expf(G - Gm[e]) : 0.f;
        }
        *(LAS f32x4*)(LT + l31 * 36 + 8 * q4 + 4 * hh) = lv;
    }
    {
        float* mff = C.out + OS_MFF + (size_t)u * 512;
        *(bf16x8*)(mff + (0 * 64 + lane) * 4) = pack8(mfv[0], mfv[1], mfv[2], mfv[3], mfv[4], mfv[5], mfv[6], mfv[7]);
        *(bf16x8*)(mff + (1 * 64 + lane) * 4) = pack8(mfv[8], mfv[9], mfv[10], mfv[11], mfv[12], mfv[13], mfv[14], mfv[15]);
    }
    LDS_WAIT(); asm volatile("" ::: "memory");
    LAS float* Tm = (LAS float*)scr + l31 * 33;
    {
        const LAS float* Th = Tm + hh; const LAS float* Lh = LT + hh;
#pragma unroll
        for (int j = 31; j >= 0; --j) {
            float p0 = 0.f, p1 = 0.f;
#pragma unroll
            for (int k = 0; k < (32 - j) / 2; ++k) {
                const int i0 = j + 1 + 2 * k;
                float t;
                if (i0 + 1 > 31) t = hh ? 0.f : Tm[i0] * LT[j * 36 + i0];
                else t = Th[i0] * Lh[j * 36 + i0];
                if (k & 1) p1 += t; else p0 += t;
            }
            const float p = p0 + p1;
            const auto rr = __builtin_amdgcn_permlane32_swap(__float_as_uint(p), __float_as_uint(p), false, false);
            Tm[j] = ((l31 == j) ? 1.f : 0.f) - (__uint_as_float(rr[0]) + __uint_as_float(rr[1]));
        }
    }
    const float eG = __expf(G);
    if (lane < 32) Gs[lane] = beta * eG;
    LDS_WAIT(); asm volatile("" ::: "memory");
    float* tbf = C.out + OS_TBF + (size_t)u * 512; float* tgf = C.out + OS_TGF + (size_t)u * 512;
#pragma unroll
    for (int s = 0; s < 2; ++s) {
        float a[8], g8[8];
#pragma unroll
        for (int jj = 0; jj < 8; ++jj) {
            const int jn = 16 * s + 8 * hh + jj;
            const int jk = 16 * s + 8 * (jj >> 2) + 4 * hh + (jj & 3);
            a[jj] = Tm[jn] * Bs[jn]; g8[jj] = Tm[jk] * Gs[jk];
        }
        *(bf16x8*)(tbf + (s * 64 + lane) * 4) = pack8(a[0], a[1], a[2], a[3], a[4], a[5], a[6], a[7]);
        *(bf16x8*)(tgf + (s * 64 + lane) * 4) = pack8(g8[0], g8[1], g8[2], g8[3], g8[4], g8[5], g8[6], g8[7]);
    }
    LDS_WAIT(); asm volatile("" ::: "memory");
}

constexpr int DS_BASE = 16384, DS_TILE = 32 * 272, DS_FR = 3 * DS_TILE, DS_SCL = DS_FR + 6144, DS_OB = DS_SCL + 320, DS_HALF = DS_OB + 32 * 132 * 4;
static_assert(DS_BASE + 2 * DS_HALF <= RING_BYTES && DS_HALF % 16 == 0, "dscan LDS map");
__device__ __forceinline__ void dscan_unit(const Ctx& C, int item, const int HOT = 0) {
    int tid_ = C.tid; asm volatile("" : "+v"(tid_));
    const int tid = tid_, lane = tid & 63, wave = __builtin_amdgcn_readfirstlane(tid >> 6);
    const bool prompt = item < 64;
    const int half = wave >> 2, eb = wave & 3, ht = tid & 255;
    const int bh = prompt ? item * 2 + half : (item - 64) * 2 + half, b = bh >> 4, h = bh & 15;
    const int nch = prompt ? 64 : 2, rowbase = prompt ? b * PSEQ : NPROW + b * SSEQ, ubase = prompt ? bh * 64 : 8192 + bh * 2;
    const bf16* H = (const bf16*)(C.ws + WS_H); const bf16* QKVC = (const bf16*)(C.ws + WS_QKVC); bf16* CAT = (bf16*)(C.ws + WS_CAT);
    LAS unsigned char* hb = C.lds + DS_BASE + half * DS_HALF;
    LAS unsigned char* QT = hb; LAS unsigned char* KT = hb + DS_TILE; LAS unsigned char* VT_ = hb + 2 * DS_TILE;
    LAS unsigned char* FR = hb + DS_FR; LAS float* SCL = (LAS float*)(hb + DS_SCL); LAS float* OB = (LAS float*)(hb + DS_OB);
    const int l31 = lane & 31, hh = lane >> 5;
    f32x16 S[4];
    if (prompt) {
#pragma unroll
        for (int db = 0; db < 4; ++db)
#pragma unroll
            for (int r = 0; r < 16; ++r) S[db][r] = 0.f;
    } else {
        const float* s0 = inp(C, I_SDELTA) + (size_t)bh * 128 * 128 + 32 * eb + l31;
#pragma unroll
        for (int db = 0; db < 4; ++db)
#pragma unroll
            for (int r = 0; r < 16; ++r) S[db][r] = s0[(size_t)(32 * db + crow16(r, hh)) * 128];
    }
    const f32x2 gn = *(const f32x2*)(inp(C, I_DNG) + 2 * lane);
    v4u sreg[8]; float gi = 0.f, gl_ = 0.f;
#define DS_REQ(CH) do { const int R0_ = rowbase + (HOT ? 0 : (CH)) * 32, u_ = ubase + (HOT ? 0 : (CH)); \
        const bf16* qb_ = QKVC + (size_t)R0_ * CQKV + h * 128; const float* fb_ = C.out + (size_t)u_ * 512;     \
        _Pragma("unroll") for (int k_ = 0; k_ < 6; ++k_) { const unsigned idx = (unsigned)ht + 256u * k_, which = idx >> 9, r = (idx & 511u) >> 4, pc = idx & 15u; \
            sreg[k_] = *(const v4u*)(qb_ + (r * (unsigned)CQKV + which * 2048u + pc * 8u)); } \
        _Pragma("unroll") for (int k_ = 0; k_ < 2; ++k_) { const unsigned idx = (unsigned)ht + 256u * k_; if (idx < 384u) { const unsigned f = idx >> 7, rest = idx & 127u; \
            sreg[6 + k_] = *(const v4u*)(fb_ + ((f == 0 ? OS_TBF : f == 1 ? OS_TGF : OS_MFF) + rest * 4u)); } } \
        if (ht < 32) { const float* gb = C.out + OS_GB + (size_t)R0_ * 16 + h; gi = gb[ht * 16]; gl_ = gb[31 * 16]; } } while (0)
    DS_REQ(0);
#pragma unroll 1
    for (int ch = 0; ch < nch; ++ch) {
        const int R0 = rowbase + ch * 32;
#pragma unroll
        for (int k_ = 0; k_ < 6; ++k_) { const int idx = ht + 256 * k_, which = idx >> 9, r = (idx & 511) >> 4, pc = idx & 15; *(LAS v4u*)(hb + which * DS_TILE + r * 272 + pc * 16) = sreg[k_]; }
#pragma unroll
        for (int k_ = 0; k_ < 2; ++k_) { const int idx = ht + 256 * k_; if (idx < 384) *(LAS v4u*)(FR + idx * 16) = sreg[6 + k_]; }
        if (ht < 32) { SCL[ht] = __expf(gi); SCL[32 + ht] = __expf(gl_ - gi); if (ht == 0) SCL[64] = __expf(gl_); }
        __syncthreads();
        if (ch + 1 < nch) DS_REQ(ch + 1);
        f32x16 un;
#pragma unroll
        for (int r = 0; r < 16; ++r) un[r] = 0.f;
        {
            const bf16x8 tb0 = *(const LAS bf16x8*)(FR + lane * 16), tb1 = *(const LAS bf16x8*)(FR + (64 + lane) * 16);
            const v2u a0 = tr4(VT_, 8 * hh, 32 * eb, lane), a1 = tr4(VT_, 8 * hh + 4, 32 * eb, lane), b0 = tr4(VT_, 16 + 8 * hh, 32 * eb, lane), b1 = tr4(VT_, 16 + 8 * hh + 4, 32 * eb, lane);
            un = __builtin_amdgcn_mfma_f32_32x32x16_bf16(tb0, __builtin_bit_cast(bf16x8, (v4u){a0.x, a0.y, a1.x, a1.y}), un, 0, 0, 0);
            un = __builtin_amdgcn_mfma_f32_32x32x16_bf16(tb1, __builtin_bit_cast(bf16x8, (v4u){b0.x, b0.y, b1.x, b1.y}), un, 0, 0, 0);
        }
        {
            const bf16x8 tg0 = *(const LAS bf16x8*)(FR + 2048 + lane * 16), tg1 = *(const LAS bf16x8*)(FR + 2048 + (64 + lane) * 16);
#pragma unroll
            for (int db = 0; db < 4; ++db) {
                const v2u l0 = tr4(KT, 4 * hh, 32 * db, lane), h0 = tr4(KT, 8 + 4 * hh, 32 * db, lane), l1 = tr4(KT, 16 + 4 * hh, 32 * db, lane), h1 = tr4(KT, 24 + 4 * hh, 32 * db, lane);
                f32x16 w;
#pragma unroll
                for (int r = 0; r < 16; ++r) w[r] = 0.f;
                w = __builtin_amdgcn_mfma_f32_32x32x16_bf16(__builtin_bit_cast(bf16x8, (v4u){l0.x, l0.y, h0.x, h0.y}), tg0, w, 0, 0, 0);
                w = __builtin_amdgcn_mfma_f32_32x32x16_bf16(__builtin_bit_cast(bf16x8, (v4u){l1.x, l1.y, h1.x, h1.y}), tg1, w, 0, 0, 0);
                const bf16x8 wA0 = pack8(-w[0], -w[1], -w[2], -w[3], -w[4], -w[5], -w[6], -w[7]), wA1 = pack8(-w[8], -w[9], -w[10], -w[11], -w[12], -w[13], -w[14], -w[15]);
                const bf16x8 SB0 = pack8(S[db][0], S[db][1], S[db][2], S[db][3], S[db][4], S[db][5], S[db][6], S[db][7]);
                const bf16x8 SB1 = pack8(S[db][8], S[db][9], S[db][10], S[db][11], S[db][12], S[db][13], S[db][14], S[db][15]);
                un = __builtin_amdgcn_mfma_f32_32x32x16_bf16(wA0, SB0, un, 0, 0, 0);
                un = __builtin_amdgcn_mfma_f32_32x32x16_bf16(wA1, SB1, un, 0, 0, 0);
            }
        }
        bf16x8 vnB0, vnB1, vnS0, vnS1;
        {
            float vn[16], dc[16];
#pragma unroll
            for (int q4 = 0; q4 < 4; ++q4) {
                const f32x4 d4 = *(const LAS f32x4*)(SCL + 32 + 8 * q4 + 4 * hh);
#pragma unroll
                for (int e = 0; e < 4; ++e) { dc[4 * q4 + e] = d4[e]; vn[4 * q4 + e] = un[4 * q4 + e]; }
            }
            vnB0 = pack8(vn[0], vn[1], vn[2], vn[3], vn[4], vn[5], vn[6], vn[7]); vnB1 = pack8(vn[8], vn[9], vn[10], vn[11], vn[12], vn[13], vn[14], vn[15]);
            vnS0 = pack8(vn[0] * dc[0], vn[1] * dc[1], vn[2] * dc[2], vn[3] * dc[3], vn[4] * dc[4], vn[5] * dc[5], vn[6] * dc[6], vn[7] * dc[7]);
            vnS1 = pack8(vn[8] * dc[8], vn[9] * dc[9], vn[10] * dc[10], vn[11] * dc[11], vn[12] * dc[12], vn[13] * dc[13], vn[14] * dc[14], vn[15] * dc[15]);
        }
        unsigned zreg[8];
#pragma unroll
        for (int jr = 0; jr < 8; ++jr) zreg[jr] = *(const unsigned*)(H + (size_t)((HOT ? rowbase : R0) + eb * 8 + jr) * LDH + HZ + h * 128 + 2 * lane);
        f32x16 qs, o2;
#pragma unroll
        for (int r = 0; r < 16; ++r) { qs[r] = 0.f; o2[r] = 0.f; }
        const float gl = SCL[64];
#pragma unroll
        for (int db = 0; db < 4; ++db) {
            const bf16x8 SB0 = pack8(S[db][0], S[db][1], S[db][2], S[db][3], S[db][4], S[db][5], S[db][6], S[db][7]);
            const bf16x8 SB1 = pack8(S[db][8], S[db][9], S[db][10], S[db][11], S[db][12], S[db][13], S[db][14], S[db][15]);
            const LAS unsigned char* qp = QT + l31 * 272 + (32 * db + 4 * hh) * 2;
            const v2u ql0 = *(const LAS v2u*)qp, qh0 = *(const LAS v2u*)(qp + 16), ql1 = *(const LAS v2u*)(qp + 32), qh1 = *(const LAS v2u*)(qp + 48);
            qs = __builtin_amdgcn_mfma_f32_32x32x16_bf16(__builtin_bit_cast(bf16x8, (v4u){ql0.x, ql0.y, qh0.x, qh0.y}), SB0, qs, 0, 0, 0);
            qs = __builtin_amdgcn_mfma_f32_32x32x16_bf16(__builtin_bit_cast(bf16x8, (v4u){ql1.x, ql1.y, qh1.x, qh1.y}), SB1, qs, 0, 0, 0);
            const v2u l0 = tr4(KT, 4 * hh, 32 * db, lane), h0 = tr4(KT, 8 + 4 * hh, 32 * db, lane), l1 = tr4(KT, 16 + 4 * hh, 32 * db, lane), h1 = tr4(KT, 24 + 4 * hh, 32 * db, lane);
#pragma unroll
            for (int r = 0; r < 16; ++r) S[db][r] *= gl;
            S[db] = __builtin_amdgcn_mfma_f32_32x32x16_bf16(__builtin_bit_cast(bf16x8, (v4u){l0.x, l0.y, h0.x, h0.y}), vnS0, S[db], 0, 0, 0);
            S[db] = __builtin_amdgcn_mfma_f32_32x32x16_bf16(__builtin_bit_cast(bf16x8, (v4u){l1.x, l1.y, h1.x, h1.y}), vnS1, S[db], 0, 0, 0);
        }
        {
            const bf16x8 mf0 = *(const LAS bf16x8*)(FR + 4096 + lane * 16), mf1 = *(const LAS bf16x8*)(FR + 4096 + (64 + lane) * 16);
            o2 = __builtin_amdgcn_mfma_f32_32x32x16_bf16(mf0, vnB0, o2, 0, 0, 0);
            o2 = __builtin_amdgcn_mfma_f32_32x32x16_bf16(mf1, vnB1, o2, 0, 0, 0);
        }
        float eg[16];
#pragma unroll
        for (int q4 = 0; q4 < 4; ++q4) { const f32x4 e4 = *(const LAS f32x4*)(SCL + 8 * q4 + 4 * hh); eg[4 * q4] = e4[0]; eg[4 * q4 + 1] = e4[1]; eg[4 * q4 + 2] = e4[2]; eg[4 * q4 + 3] = e4[3]; }
#pragma unroll
        for (int r = 0; r < 16; ++r) OB[crow16(r, hh) * 132 + 32 * eb + l31] = qs[r] * eg[r] + o2[r];
        __syncthreads();
        f32x2 ovv[8]; float ssq[8];
#pragma unroll
        for (int jr = 0; jr < 8; ++jr) ovv[jr] = *(const LAS f32x2*)(OB + (eb * 8 + jr) * 132 + 2 * lane);
#pragma unroll
        for (int jr = 0; jr < 8; ++jr) ssq[jr] = wave_sum(ovv[jr].x * ovv[jr].x + ovv[jr].y * ovv[jr].y);
#pragma unroll
        for (int jr = 0; jr < 8; ++jr) {
            const int i = eb * 8 + jr; const size_t row = (size_t)(R0 + i);
            const f32x2 ov = ovv[jr];
            const float rs = __builtin_amdgcn_rsqf(ssq[jr] * (1.f / 128.f) + LN_EPS);
            const unsigned zw = zreg[jr];
#if MIX_FP8
            *(unsigned short*)((unsigned char*)(HOT ? (bf16*)(C.ws + 427 * MiB) : CAT) + (HOT ? (size_t)i : row) * DM + 2048 + h * 128 + 2 * lane) = (unsigned short)pk4_fp8(ov.x * rs * gn.x * silu_f(bflo(zw)) * CAT_Q, ov.y * rs * gn.y * silu_f(bfhi(zw)) * CAT_Q, 0.f, 0.f);
#else
            *(unsigned*)(CAT + row * DM + 2048 + h * 128 + 2 * lane) = pk2(ov.x * rs * gn.x * silu_f(bflo(zw)), ov.y * rs * gn.y * silu_f(bfhi(zw)));
#endif
        }
    }
#undef DS_REQ
    float* so = HOT ? (float*)(C.ws + 427 * MiB + 262144) + (size_t)(bh & 15) * 128 * 128 + 32 * eb + l31 : C.out + (prompt ? O_PDELTA : O_SDELTA) + (size_t)bh * 128 * 128 + 32 * eb + l31;
#pragma unroll
    for (int db = 0; db < 4; ++db)
#pragma unroll
        for (int r = 0; r < 16; ++r) so[(size_t)(32 * db + crow16(r, hh)) * 128] = S[db][r];
}

#ifndef MK_PER_PHASE
#define MK_PER_PHASE 0
#endif
constexpr int N_PHASES = 10;
#ifndef GEMM_XS
#define GEMM_XS 0
#endif
#ifndef UP_TAIL_SPLIT
#define UP_TAIL_SPLIT 0
#endif
#ifndef WUP_P1
#define WUP_P1 0
#endif
static_assert(WUP_P1 <= 1152, "only the first 1152 grabs avoid the w_in^T region");
#ifndef WUP_MIX
#define WUP_MIX 0
#endif
#ifndef WUP_SPLIT
#define WUP_SPLIT 0
#endif
#ifndef GEMM_WGM_UP
#define GEMM_WGM_UP GEMM_WGM
#endif
#ifndef GEMM_WGM_RES
#define GEMM_WGM_RES 4
#endif
#ifndef GEMM_WGM
#define GEMM_WGM 4
#endif
struct Args { const float* in[26]; float* out; unsigned char* ws; int ph_lo, ph_hi; };
static_assert(sizeof(Args) == 26 * 8 + 8 + 8 + 8, "Args has no padding");

struct HotOrder { pg8::StaticOrder S; __device__ bool next(int i, pg8::Unit& u) const { pg8::Unit t; if (!S.next(i, t)) return false; u.pm = S.c & 3; u.pn = (S.c >> 2) & 7; u.koff = 0; u.part = 0; u.kn = 0; u.tidx = 0; return true; }
                  __device__ void a_ready(const pg8::Unit&) const {} __device__ void done(const pg8::Unit&) const {} };
struct EpiNull { static constexpr bool PERM = true, AFTER_DRAIN = false; float* sink;
                 __device__ __forceinline__ void operator()(const pg8::f32x4 (&acc)[2][2][4][2], const pg8::Unit& u, int wr, int wc, int fr, int fq) const {
                     float s = 0.f;
#pragma unroll
                     for (int a = 0; a < 2; ++a)
#pragma unroll
                         for (int b = 0; b < 2; ++b)
#pragma unroll
                             for (int m = 0; m < 4; ++m) s += acc[a][b][m][0][0] + acc[a][b][m][1][3];
                     if (s == 123456.789f) sink[0] = s; } };
__global__ void __launch_bounds__(NWAVES * 64, 2) fwd_kernel(Args args) {
    extern __shared__ __attribute__((aligned(16))) unsigned char lds_raw[];
    Ctx C;
    C.out = args.out; C.ws = args.ws;
    C.lds = (LAS unsigned char*)lds_raw; C.ctl = (gu32*)(args.ws + WS_CTL);
    C.tid = threadIdx.x; C.lane = C.tid & 63; C.wave = __builtin_amdgcn_readfirstlane(C.tid >> 6); C.G = gridDim.x; C.bid = blockIdx.x;
    for (int u = C.tid; u < (LDS_BYTES - LDSCTL_OFF) / 4; u += NWAVES * 64) ((LAS unsigned*)(C.lds + LDSCTL_OFF))[u] = 0u;
    __syncthreads();
    if (C.tid < 26) ((LAS unsigned long long*)(C.lds + PTAB_OFF))[C.tid] = (unsigned long long)(size_t)args.in[C.tid];
    __syncthreads();
    XcdBarrier bar; bar.bar = (unsigned*)(C.ctl + CW_BAR); bar.x = 0; bar.st = nullptr;
    if (!MK_PER_PHASE) bar = xcd_barrier_post((unsigned*)(C.ctl + CW_BAR), (volatile LAS unsigned*)(C.lds + MISC_OFF) + 8);
    const int lo = args.ph_lo, hi = args.ph_hi;
#define IN(k) (lo <= (k) && (k) < hi)
#define SEAM(k) do { if (IN(k) && IN((k) + 1)) xcd_barrier(bar); REFRESH_IDS(); } while (0)
#define REFRESH_IDS() do { int t_ = threadIdx.x; asm volatile("" : "+v"(t_)); C.tid = t_; C.lane = t_ & 63; C.wave = __builtin_amdgcn_readfirstlane(t_ >> 6); } while (0)

#ifndef PROBE_DUP
#define PROBE_DUP 0
#endif
    if (IN(0)) { phase0(C); if (PROBE_DUP == 1) { xcd_barrier(bar); phase0(C); } } SEAM(0);

    if (IN(1)) {
        pg8::Gemm g{(const pg8::bf16_t*)(C.ws + WS_XN), (const pg8::bf16_t*)(C.ws + WS_WIN), MTOK, LDH, DM, LDX};
        pg8::StaticOrder S; S.init(MTOK, LDH, C.G, C.bid); S.wgm = GEMM_WGM; S.xs = GEMM_XS;
        Epi1 E{(bf16*)(C.ws + WS_H), C.out + OS_SM, C.out};
#if defined(GEMM_STAGGER) && GEMM_STAGGER
        for (int d = 0; d < ((C.bid >> 5) & 7) * GEMM_STAGGER; ++d) __builtin_amdgcn_s_sleep(127);
#endif
        pg8::gemm_phase<Epi1, pg8::StaticOrder, true, true>(C.lds, g, S, E);
        REFRESH_IDS();
        transpose_queue<MIX_FP8 ? 4 : 0>(C, inp(C, I_WO), DM, DM, (bf16*)(C.ws + WS_WO), (DM / 64) * (DM / 32), CW_QT1);
#if WUP_EARLY && WUP_P1 > 0
        transpose_queue<2, true>(C, inp(C, I_WUP), DM, DFF2, (bf16*)(C.ws + WS_WUP), (DM / 64) * (DFF2 / 32), CW_QT5 + 128, 0, WUP_P1, 0, 16384);
#endif
        if (PROBE_DUP == 4) { xcd_barrier(bar); pg8::gemm_phase<Epi1, pg8::StaticOrder, true, true>(C.lds, g, S, E); }
        if (PROBE_DUP == 21) { xcd_barrier(bar); EpiNull EN{(float*)(C.ws + WS_P2)}; pg8::gemm_phase<EpiNull, pg8::StaticOrder, true, true>(C.lds, g, S, EN); }
        if (PROBE_DUP == 20) {
            xcd_barrier(bar);
            HotOrder HO{S}; EpiNull EN{(float*)(C.ws + WS_P2)};
            pg8::gemm_phase<EpiNull, HotOrder, true, true>(C.lds, g, HO, EN);
        }
    } SEAM(1);

    if (IN(2)) {
#if PROBE_DUP == 32 || PROBE_DUP == 33
        { const int pm = __builtin_amdgcn_readfirstlane(PROBE_DUP - 31); for (;;) { const int it = q_next(C, CW_Q2 + 256); if (it >= NDU / 8) break; dprep_unit(C, it * 8 + C.wave, C.lane, C.lds + C.wave * 13824, pm); } xcd_barrier(bar); REFRESH_IDS(); }
#endif
        for (;;) { const int it = q_next(C, CW_Q2); if (it >= 288 + NDU / 8) break; if (it < 288) idx_unit(C, it); else dprep_unit(C, (it - 288) * 8 + C.wave, C.lane, C.lds + C.wave * 13824); }
#if WUP_EARLY
        REFRESH_IDS();
        transpose_queue<2, true>(C, inp(C, I_WUP), DM, DFF2, (bf16*)(C.ws + WS_WUP), (DM / 64) * (DFF2 / 32), CW_QT5, WUP_P1, WUP_P1 + WUP_SPLIT, 16384, 8704);
#endif
        if (PROBE_DUP == 2) { xcd_barrier(bar); for (;;) { const int it = q_next(C, CW_Q2 + 256); if (it >= 288 + NDU / 8) break; if (it < 288) idx_unit(C, it); else dprep_unit(C, (it - 288) * 8 + C.wave, C.lane, C.lds + C.wave * 13824); } }
        if (PROBE_DUP == 12) { xcd_barrier(bar); for (;;) { const int it = q_next(C, CW_Q2 + 256); if (it >= 288) break; idx_unit<false>(C, it); } }
        if (PROBE_DUP == 10) { xcd_barrier(bar); for (;;) { const int it = q_next(C, CW_Q2 + 256); if (it >= 288) break; idx_unit(C, it); } }
        if (PROBE_DUP == 11) { xcd_barrier(bar); for (;;) { const int it = q_next(C, CW_Q2 + 256); if (it >= NDU / 8) break; dprep_unit(C, it * 8 + C.wave, C.lane, C.lds + C.wave * 13824); } }
    } SEAM(2);

    if (IN(3)) {
        attn_lut(C);
#if PROBE_DUP == 31
#pragma unroll 1
        for (int hot = 1; hot >= 0; --hot) { const int hv = __builtin_amdgcn_readfirstlane(hot); for (;;) { const int it = q_next(C, CW_Q3 + 256 * hv); if (it >= 320) break; dscan_unit(C, it, hv); } xcd_barrier(bar); }
#else
        for (;;) { const int it = q_next(C, CW_Q3); if (it >= 320) break; dscan_unit(C, it); }
#endif
        REFRESH_IDS();
#if WUP_EARLY && WUP_MIX > 0 && WUP_P1 == 0
        {
            bool more = true;
            for (;;) { const int it = q_next(C, CW_Q3 + 64); if (it >= 1152) break; attn_unit(C, it);
                if (more) { REFRESH_IDS(); more = transpose_grabs<2>(C, inp(C, I_WUP), DM, DFF2, (bf16*)(C.ws + WS_WUP), (DM / 64) * (DFF2 / 32), CW_QT5 + 64, WUP_SPLIT, 1 << 30, 16384, 8704, WUP_MIX); REFRESH_IDS(); } }
        }
#else
        for (;;) { const int it = q_next(C, CW_Q3 + 64); if (it >= 1152) break; attn_unit(C, it); }
#endif
#if WUP_EARLY
        REFRESH_IDS();
        transpose_queue<2, true>(C, inp(C, I_WUP), DM, DFF2, (bf16*)(C.ws + WS_WUP), (DM / 64) * (DFF2 / 32), CW_QT5 + 64, WUP_P1 + WUP_SPLIT, 1 << 30, 16384, 8704);
#endif
        if (PROBE_DUP == 3) { xcd_barrier(bar); for (;;) { const int it = q_next(C, CW_Q3 + 256); if (it >= 320) break; dscan_unit(C, it); } }
        if (PROBE_DUP == 6) { xcd_barrier(bar); for (;;) { const int it = q_next(C, CW_Q3 + 320); if (it >= 1152) break; attn_unit(C, it); } }
    } SEAM(3);

    if (IN(4)) {
        pg8::StaticOrder S; S.init(MTOK, DM, C.G, C.bid); S.wgm = GEMM_WGM_RES; S.xs = GEMM_XS;
#if MIX_FP8
        pg8::Gemm g{(const pg8::bf16_t*)(C.ws + WS_CAT), (const pg8::bf16_t*)(C.ws + WS_WO), MTOK, DM, DM / 2, DM / 2};
        EpiRes E{(const bf16*)(C.ws + WS_XN), (bf16*)(C.ws + WS_PRE1), 0, 1.f / (CAT_Q * WO_Q), (float*)(C.ws + WS_P2), (unsigned*)(C.ctl + CW_TIX2)};
        S.lim = 1024;
        pg8::gemm_phase<EpiRes, pg8::StaticOrder, true, true, true>(C.lds, g, S, E);
        { pg8::TailOrder T{S, 1024, 2, 16, 16}; pg8::gemm_phase<EpiRes, pg8::TailOrder, true, true, true>(C.lds, g, T, E); }
#else
        pg8::Gemm g{(const pg8::bf16_t*)(C.ws + WS_CAT), (const pg8::bf16_t*)(C.ws + WS_WO), MTOK, DM, DM, DM};
        EpiRes E{(const bf16*)(C.ws + WS_XN), (bf16*)(C.ws + WS_PRE1), 0, 1.f, nullptr, nullptr};
        pg8::gemm_phase<EpiRes, pg8::StaticOrder, true, true>(C.lds, g, S, E);
#endif
    } SEAM(4);

    if (IN(5)) { phase5(C); if (PROBE_DUP == 1) { xcd_barrier(bar); phase5(C); } } SEAM(5);

    if (IN(6)) {
        pg8::Gemm g{(const pg8::bf16_t*)(C.ws + WS_XN), (const pg8::bf16_t*)(C.ws + WS_WUP), MTOK, DFF2, DM, LDX};
        pg8::StaticOrder S; S.init(MTOK, DFF2, C.G, C.bid); S.wgm = GEMM_WGM_UP; S.xs = GEMM_XS;
        EpiUpAct E{(bf16*)(C.ws + WS_ACT), (bf16*)(C.ws + WS_UPS), C.out, inp(C, I_FCW), inp(C, I_FCB), (LAS float*)(C.lds + EPIW_OFF), (float*)(C.ws + WS_P3), (unsigned*)(C.ctl + CW_T3)};
#if UP_TAIL_SPLIT
        S.lim = 6144;
        pg8::gemm_phase<EpiUpAct, pg8::StaticOrder, true, true>(C.lds, g, S, E);
        { pg8::TailOrder T{S, 6144, UPT_NS, 64 / UPT_NS, 64 / UPT_NS}; pg8::gemm_phase<EpiUpAct, pg8::TailOrder, true, true>(C.lds, g, T, E); }
#else
        pg8::gemm_phase<EpiUpAct, pg8::StaticOrder, true, true>(C.lds, g, S, E);
#endif
        REFRESH_IDS();
        if (PROBE_DUP == 40) { xcd_barrier(bar); pg8::gemm_phase<EpiUpAct, pg8::StaticOrder, true, true>(C.lds, g, S, E); REFRESH_IDS(); }
        if (PROBE_DUP == 41) { xcd_barrier(bar); EpiNull EN{(float*)(C.ws + WS_P2)}; pg8::gemm_phase<EpiNull, pg8::StaticOrder, true, true>(C.lds, g, S, EN); REFRESH_IDS(); }
        transpose_queue<FFN_DOWN_FP8 ? 3 : 0>(C, inp(C, I_WDN), DFF, DM, (bf16*)(C.ws + WS_WDN), (DFF / 64) * (DM / 32), CW_QT6);
    } SEAM(6);
    if (IN(7)) { ffn_fixup(C); } SEAM(7);
    if (IN(8)) {
#if FFN_DOWN_FP8
        pg8::Gemm g{(const pg8::bf16_t*)(C.ws + WS_ACT), (const pg8::bf16_t*)(C.ws + WS_WDN), MTOK, DM, DFF / 2, DFF / 2};
        pg8::StaticOrder S; S.init(MTOK, DM, C.G, C.bid); S.wgm = GEMM_WGM_RES; S.xs = GEMM_XS;
        EpiRes E{(const bf16*)(C.ws + WS_XN), (bf16*)(C.ws + WS_PRE2), 0, 1.f / (ACT_Q * WDN_Q), (float*)(C.ws + WS_P2), (unsigned*)(C.ctl + CW_TIX4)};
        S.lim = 1024;
        pg8::gemm_phase<EpiRes, pg8::StaticOrder, true, true, true>(C.lds, g, S, E);
        { pg8::TailOrder T{S, 1024, 2, 44, 42}; pg8::gemm_phase<EpiRes, pg8::TailOrder, true, true, true>(C.lds, g, T, E); }
#else
        pg8::Gemm g{(const pg8::bf16_t*)(C.ws + WS_ACT), (const pg8::bf16_t*)(C.ws + WS_WDN), MTOK, DM, DFF, DFF};
        pg8::StaticOrder S; S.init(MTOK, DM, C.G, C.bid); S.wgm = GEMM_WGM_RES; S.xs = GEMM_XS;
        EpiRes E{(const bf16*)(C.ws + WS_XN), (bf16*)(C.ws + WS_PRE2), 0, 1.f, nullptr, nullptr};
        pg8::gemm_phase<EpiRes, pg8::StaticOrder, true, true>(C.lds, g, S, E);
#endif
    } SEAM(8);

    if (IN(9)) {
        const int gw = C.bid * NWAVES + C.wave, NGW = C.G * NWAVES;
        LnP P; ln_params(P, inp(C, I_LN2G), inp(C, I_LN2B), C.lane);
#pragma unroll 1
        for (int m = gw; m < MTOK; m += NGW) ln_row<true, true, true>((const bf16*)(C.ws + WS_PRE2) + (size_t)m * DM, P, C.out + O_Y + (size_t)m * DM, C.lane, (const unsigned*)(C.ctl + CW_TIX4) + (m >> 8) * 16, (const float*)(C.ws + WS_P2), m & 255);
    }
#undef IN
#undef SEAM
}

extern "C" void kernel_launch(void* const* d_in, const int* in_sizes, int n_in, void* d_out, int out_size, void* d_ws, size_t ws_size, hipStream_t stream) {
    static int grid = 0;
    if (grid == 0) {
        if (n_in != 26 || (size_t)out_size != O_END || ws_size < WS_END) { fprintf(stderr, "kernel_launch: unexpected shapes: n_in %d out %d ws %zu (need %zu)\n", n_in, out_size, ws_size, (size_t)WS_END); grid = -1; return; }
        int dev = 0, cus = 0, per_cu = 0;
        if (hipGetDevice(&dev) != hipSuccess || hipDeviceGetAttribute(&cus, hipDeviceAttributeMultiprocessorCount, dev) != hipSuccess) { grid = -1; return; }
        if (hipFuncSetAttribute((const void*)fwd_kernel, hipFuncAttributeMaxDynamicSharedMemorySize, LDS_BYTES) != hipSuccess) { fprintf(stderr, "kernel_launch: hipFuncSetAttribute failed\n"); grid = -1; return; }
        if (hipOccupancyMaxActiveBlocksPerMultiprocessor(&per_cu, (const void*)fwd_kernel, NWAVES * 64, LDS_BYTES) != hipSuccess || per_cu < 1) { fprintf(stderr, "kernel_launch: occupancy query says %d\n", per_cu); }
        (void)hipGetLastError();
        grid = cus;
    }
    if (grid < 0) return;
    if (hipMemsetAsync((char*)d_ws + WS_CTL, 0, CTL_ZERO_BYTES, stream) != hipSuccess) return;
    Args a{};
    for (int i = 0; i < 26; ++i) a.in[i] = (const float*)d_in[i];
    a.out = (float*)d_out; a.ws = (unsigned char*)d_ws;
#if MK_PER_PHASE
    for (int p = 0; p < N_PHASES; ++p) { a.ph_lo = p; a.ph_hi = p + 1; hipLaunchKernelGGL(fwd_kernel, dim3(grid), dim3(NWAVES * 64), LDS_BYTES, stream, a); }
#else
    a.ph_lo = 0; a.ph_hi = N_PHASES;
    hipLaunchKernelGGL(fwd_kernel, dim3(grid), dim3(NWAVES * 64), LDS_BYTES, stream, a);
#endif
    const hipError_t le = hipPeekAtLastError();
    if (le != hipSuccess) fprintf(stderr, "kernel_launch: launch failed: %s\n", hipGetErrorName(le));
}
```
